# Optimizing an MI355X kernel written in HIP

```python
import math
import jax, jax.numpy as jnp
from jax import lax
import numpy as np

D_MODEL = 1024
BATCH = 8
SEQ = 2048
DEPTH = 1

MIX_WIDTH = D_MODEL
SSM_WIDTH = MIX_WIDTH // 2
SSM_GROUP = 16
SSM_GROUPS = SSM_WIDTH // SSM_GROUP
SSM_STATE = 64
ATTN_WIDTH = MIX_WIDTH - SSM_WIDTH
HEAD_DIM = 64
N_Q_HEADS = ATTN_WIDTH // HEAD_DIM
N_KV_HEADS = 2
Q_PER_KV = N_Q_HEADS // N_KV_HEADS
KV_WIDTH = N_KV_HEADS * HEAD_DIM
IN_WIDTH = SSM_WIDTH + ATTN_WIDTH + 2 * KV_WIDTH
WINDOW = 128
BLOCK = 128
ROPE_DIM = HEAD_DIM // 4
ROPE_THETA = 500000.0
D_FF = -(-8 * D_MODEL // (3 * 256)) * 256
NORM_EPS = 1e-6
DT_MIN = 1e-3
DT_MAX = 1e-1
MASK_VALUE = -1e30

kernel_name = "hymba_s5_swa_sink_hybrid"


def rms_norm(x, g):
    xf = x.astype(jnp.float32)
    y = xf * lax.rsqrt(jnp.mean(xf * xf, axis=-1, keepdims=True) + NORM_EPS)
    return (y * g.astype(jnp.float32)).astype(x.dtype)


def _s5_combine(e1, e2):
    a1r, a1i, b1r, b1i = e1
    a2r, a2i, b2r, b2i = e2
    ar = a2r * a1r - a2i * a1i
    ai = a2r * a1i + a2i * a1r
    br = a2r * b1r - a2i * b1i + b2r
    bi = a2r * b1i + a2i * b1r + b2i
    return (ar, ai, br, bi)


def s5_mixer(u, lam_re, lam_im, log_dt, b_re, b_im, c_re, c_im, d, w_glu, b_glu):
    bsz, L, _ = u.shape
    uf = u.astype(jnp.float32).reshape(bsz, L, SSM_GROUPS, SSM_GROUP)
    lr = jnp.minimum(lam_re.astype(jnp.float32), -1e-4)
    li = lam_im.astype(jnp.float32)
    dt = jnp.exp(log_dt.astype(jnp.float32))[:, None]
    mag = jnp.exp(lr * dt)
    ar = mag * jnp.cos(li * dt)
    ai = mag * jnp.sin(li * dt)
    den = lr * lr + li * li
    fr = ((ar - 1.0) * lr + ai * li) / den
    fi = (ai * lr - (ar - 1.0) * li) / den
    br = b_re.astype(jnp.float32)
    bi = b_im.astype(jnp.float32)
    bbar_re = fr[..., None] * br - fi[..., None] * bi
    bbar_im = fr[..., None] * bi + fi[..., None] * br
    bu_re = jnp.einsum('blgh,gph->blgp', uf, bbar_re)
    bu_im = jnp.einsum('blgh,gph->blgp', uf, bbar_im)
    a_re = jnp.broadcast_to(ar, (1, L, SSM_GROUPS, SSM_STATE))
    a_im = jnp.broadcast_to(ai, (1, L, SSM_GROUPS, SSM_STATE))
    _, _, xr, xi = lax.associative_scan(_s5_combine, (a_re, a_im, bu_re, bu_im), axis=1)
    y = (jnp.einsum('blgp,ghp->blgh', xr, c_re.astype(jnp.float32))
         - jnp.einsum('blgp,ghp->blgh', xi, c_im.astype(jnp.float32))
         + d.astype(jnp.float32) * uf)
    y = jax.nn.gelu(y.reshape(bsz, L, SSM_WIDTH))
    z = y @ w_glu.astype(jnp.float32) + b_glu.astype(jnp.float32)
    out = z[..., :SSM_WIDTH] * jax.nn.sigmoid(z[..., SSM_WIDTH:])
    return out.astype(u.dtype)


def partial_rotary(t, positions):
    half = ROPE_DIM // 2
    inv_freq = ROPE_THETA ** (-jnp.arange(half, dtype=jnp.float32) * 2.0 / ROPE_DIM)
    ang = positions.astype(jnp.float32)[..., None] * inv_freq
    cos = jnp.cos(ang)[:, :, None, :]
    sin = jnp.sin(ang)[:, :, None, :]
    tf = t.astype(jnp.float32)
    t1 = tf[..., :half]
    t2 = tf[..., half:ROPE_DIM]
    rot = jnp.concatenate([t1 * cos - t2 * sin, t2 * cos + t1 * sin, tf[..., ROPE_DIM:]], axis=-1)
    return rot.astype(t.dtype)


def sliding_window_sink_attention(q, k, v, sinks):
    bsz, L = q.shape[0], q.shape[1]
    nb = L // BLOCK
    qb = q.reshape(bsz, nb, BLOCK, N_KV_HEADS, Q_PER_KV, HEAD_DIM).transpose(1, 0, 2, 3, 4, 5)

    def windows(t):
        tb = t.reshape(bsz, nb, BLOCK, N_KV_HEADS, HEAD_DIM)
        prev = jnp.pad(tb, ((0, 0), (1, 0), (0, 0), (0, 0), (0, 0)))[:, :-1]
        return jnp.concatenate([prev, tb], axis=2).transpose(1, 0, 2, 3, 4)

    kw = windows(k)
    vw = windows(v)
    qi = jnp.arange(BLOCK)[:, None]
    kj = jnp.arange(2 * BLOCK)[None, :]
    rel = qi + BLOCK - kj
    band = (rel >= 0) & (rel < WINDOW)
    sink = sinks.astype(jnp.float32).reshape(N_KV_HEADS, Q_PER_KV)[None, :, :, None, None]
    scale = HEAD_DIM ** -0.5

    def one_block(args):
        q_blk, k_blk, v_blk, blk = args
        valid = band & (blk * BLOCK - BLOCK + kj >= 0)
        s = jnp.einsum('bqhgd,bkhd->bhgqk', q_blk, k_blk).astype(jnp.float32) * scale
        s = jnp.where(valid, s, MASK_VALUE)
        m = jnp.maximum(jnp.max(s, axis=-1, keepdims=True), sink)
        p = jnp.exp(s - m)
        p = p / (jnp.sum(p, axis=-1, keepdims=True) + jnp.exp(sink - m))
        return jnp.einsum('bhgqk,bkhd->bqhgd', p.astype(v_blk.dtype), v_blk)

    o = lax.map(one_block, (qb, kw, vw, jnp.arange(nb)))
    return o.transpose(1, 0, 2, 3, 4, 5).reshape(bsz, L, ATTN_WIDTH)


def setup_inputs(seed: int = 0) -> dict:
    key = jax.random.key(seed)
    ks = jax.random.split(key, 24)
    f32 = jnp.float32

    def nrm(k, shape, std):
        return jax.random.normal(k, shape, f32) * std

    def gain(k, n):
        return 1.0 + 0.05 * jax.random.normal(k, (DEPTH, n), f32)

    n_idx = jnp.arange(SSM_STATE, dtype=f32)
    lam_re = -0.5 + 0.01 * jax.random.normal(ks[3], (DEPTH, SSM_GROUPS, SSM_STATE), f32)
    lam_im = math.pi * n_idx + 0.01 * jax.random.normal(ks[4], (DEPTH, SSM_GROUPS, SSM_STATE), f32)
    log_dt = jax.random.uniform(ks[5], (DEPTH, SSM_GROUPS), f32, math.log(DT_MIN), math.log(DT_MAX))
    return {
        "x": jax.random.normal(ks[0], (BATCH, SEQ, D_MODEL), f32),
        "positions": jnp.broadcast_to(jnp.arange(SEQ, dtype=jnp.int32), (BATCH, SEQ)),
        "g_pre_mix": gain(ks[1], D_MODEL),
        "w_in": nrm(ks[2], (DEPTH, D_MODEL, IN_WIDTH), D_MODEL ** -0.5),
        "ssm_lambda_re": lam_re,
        "ssm_lambda_im": lam_im,
        "ssm_log_dt": log_dt,
        "ssm_b_re": nrm(ks[6], (DEPTH, SSM_GROUPS, SSM_STATE, SSM_GROUP), (2 * SSM_GROUP) ** -0.5),
        "ssm_b_im": nrm(ks[7], (DEPTH, SSM_GROUPS, SSM_STATE, SSM_GROUP), (2 * SSM_GROUP) ** -0.5),
        "ssm_c_re": nrm(ks[8], (DEPTH, SSM_GROUPS, SSM_GROUP, SSM_STATE), (2 * SSM_STATE) ** -0.5),
        "ssm_c_im": nrm(ks[9], (DEPTH, SSM_GROUPS, SSM_GROUP, SSM_STATE), (2 * SSM_STATE) ** -0.5),
        "ssm_d": nrm(ks[10], (DEPTH, SSM_GROUPS, SSM_GROUP), 1.0),
        "w_glu": nrm(ks[11], (DEPTH, SSM_WIDTH, 2 * SSM_WIDTH), SSM_WIDTH ** -0.5),
        "b_glu": nrm(ks[12], (DEPTH, 2 * SSM_WIDTH), 0.01),
        "attn_sinks": nrm(ks[13], (DEPTH, N_Q_HEADS), 0.5),
        "g_ssm_out": gain(ks[14], SSM_WIDTH),
        "g_attn_out": gain(ks[15], ATTN_WIDTH),
        "w_out": nrm(ks[16], (DEPTH, MIX_WIDTH, D_MODEL), MIX_WIDTH ** -0.5),
        "g_post_mix": gain(ks[17], D_MODEL),
        "g_pre_ffn": gain(ks[18], D_MODEL),
        "w_gate_up": nrm(ks[19], (DEPTH, D_MODEL, 2 * D_FF), D_MODEL ** -0.5),
        "w_down": nrm(ks[20], (DEPTH, D_FF, D_MODEL), D_FF ** -0.5),
        "g_post_ffn": gain(ks[21], D_MODEL),
    }


def reference(x, positions, g_pre_mix, w_in, ssm_lambda_re, ssm_lambda_im, ssm_log_dt,
              ssm_b_re, ssm_b_im, ssm_c_re, ssm_c_im, ssm_d, w_glu, b_glu, attn_sinks,
              g_ssm_out, g_attn_out, w_out, g_post_mix, g_pre_ffn, w_gate_up, w_down, g_post_ffn):
    bsz, L, _ = x.shape
    h = x
    for l in range(DEPTH):
        hn = rms_norm(h, g_pre_mix[l])
        proj = hn @ w_in[l]
        u = proj[..., :SSM_WIDTH]
        q = proj[..., SSM_WIDTH:SSM_WIDTH + ATTN_WIDTH]
        k = proj[..., SSM_WIDTH + ATTN_WIDTH:SSM_WIDTH + ATTN_WIDTH + KV_WIDTH]
        v = proj[..., SSM_WIDTH + ATTN_WIDTH + KV_WIDTH:]

        y_ssm = s5_mixer(u, ssm_lambda_re[l], ssm_lambda_im[l], ssm_log_dt[l],
                         ssm_b_re[l], ssm_b_im[l], ssm_c_re[l], ssm_c_im[l], ssm_d[l],
                         w_glu[l], b_glu[l])

        q = partial_rotary(q.reshape(bsz, L, N_Q_HEADS, HEAD_DIM), positions)
        k = partial_rotary(k.reshape(bsz, L, N_KV_HEADS, HEAD_DIM), positions)
        v = v.reshape(bsz, L, N_KV_HEADS, HEAD_DIM)
        y_attn = sliding_window_sink_attention(q, k, v, attn_sinks[l])

        merged = jnp.concatenate([rms_norm(y_ssm, g_ssm_out[l]), rms_norm(y_attn, g_attn_out[l])], axis=-1)
        h = h + rms_norm(merged @ w_out[l], g_post_mix[l])

        hn = rms_norm(h, g_pre_ffn[l])
        gu = hn @ w_gate_up[l]
        ff = (jax.nn.silu(gu[..., :D_FF]) * gu[..., D_FF:]) @ w_down[l]
        h = h + rms_norm(ff, g_post_ffn[l])
    return h
```

```cpp
#include <hip/hip_runtime.h>
#include <hip/hip_cooperative_groups.h>
#include <cstdio>
#include <cstdint>
namespace cg = cooperative_groups;
namespace pg8 {
#define PG8_LAS __attribute__((address_space(3)))
typedef unsigned short bf16_t;
typedef short bf16x8 __attribute__((ext_vector_type(8)));
typedef float f32x4 __attribute__((ext_vector_type(4)));
typedef unsigned u32x4 __attribute__((ext_vector_type(4)));
constexpr int BM = 256, BK = 64, HALF = 128, HTB = HALF * BK * 2  , STAGE_BYTES = 8 * HTB, NXCD = 8, WGM = 8;

__host__ __device__ __forceinline__ int lds_byte(int r, int c) { const int st = (r >> 4) * 2 + (c >> 5), rr = r & 15, cc = c & 31, ob = rr * 64 + cc * 2; return st * 1024 + (ob ^ (((ob >> 9) & 1) << 5)); }
__host__ __device__ __forceinline__ void stage_rc(int b, int& R, int& C) { const int st = b / 1024, sb = b % 1024, swz = sb ^ (((sb >> 9) & 1) << 5); R = (st >> 1) * 16 + swz / 64; C = (st & 1) * 32 + (swz % 64) / 2; }
__host__ __device__ __forceinline__ int perm32(int rho) { const int n = rho >> 4, i = rho & 15; return 8 * (i >> 2) + 4 * n + (i & 3); }

struct Unit { int pm, pn; };
struct Gemm { const bf16_t* A; const bf16_t* Bt; int M, N, K, lda, ldb; };

struct StaticOrder {
    int nM, nN, nwg, G, c;
    __host__ __device__ void init(int M, int N, int G_, int c_) { nM = M / BM; nN = N / BM; nwg = nM * nN; G = G_; c = c_; }
    __host__ __device__ bool next(int i, Unit& u) const {
        const long L = (long)i * G + c; if (L >= nwg) return false;
        int wgid = (int)L; { const int q = nwg / NXCD, r = nwg % NXCD, xcd = wgid % NXCD, off = wgid / NXCD; wgid = (xcd < r ? xcd * (q + 1) : r * (q + 1) + (xcd - r) * q) + off; }
        const int nig = WGM * nN, gid = wgid / nig, fm = gid * WGM, gsz = (nM - fm) < WGM ? (nM - fm) : WGM;
        u.pm = fm + ((wgid % nig) % gsz); u.pn = (wgid % nig) / gsz; return true;
    }
    __device__ __forceinline__ void a_ready(const Unit&) const {}
    __device__ __forceinline__ void done(const Unit&) const {}
};

__device__ __forceinline__ unsigned cvt_pk_bf16(float lo, float hi) { unsigned r; asm volatile("v_cvt_pk_bf16_f32 %0, %1, %2" : "=v"(r) : "v"(lo), "v"(hi)); return r; }
template <class Epi, class Sched, bool ALIGN_EPI = false, bool SP2 = false>
__device__ __forceinline__ void gemm_phase(PG8_LAS unsigned char* lds, const Gemm g, const Sched& S, const Epi& E) {
    const int tid = threadIdx.x, wid = __builtin_amdgcn_readfirstlane(tid >> 6), lane = tid & 63, wr = wid >> 2, wc = wid & 3, fr = lane & 15, fq = lane >> 4;
    const int K = g.K, nt = K / BK;
    unsigned voffA[2], voffB[2];
#pragma unroll
    for (int i = 0; i < 2; ++i) { int R, C; stage_rc(tid * 16 + i * 8192, R, C); const int Rb = Epi::PERM ? ((R & ~31) + perm32(R & 31)) : R;
        voffA[i] = (unsigned)(R * g.lda + C) * 2u; voffB[i] = (unsigned)(Rb * g.ldb + C) * 2u; }
    const size_t kstep = (size_t)(BK * 2);
    const size_t hstepA = (size_t)HALF * g.lda * 2, hstepB = (size_t)HALF * g.ldb * 2;
    const size_t tstepA = 2 * hstepA, tstepB = 2 * hstepB;
    const unsigned ldsw = (unsigned)wid * 1024u;
    const int aoff = lds_byte(wr * 64 + fr, fq * 8), boff = lds_byte(wc * 32 + fr, fq * 8);
#define PG8_SA(b, h) (((b) * 2 + (h)) * HTB)
#define PG8_SB(b, h) ((4 + (b) * 2 + (h)) * HTB)
#define PG8_STAGE(bufoff, gbase, voff) do { _Pragma("unroll") for (int _i = 0; _i < 2; ++_i) \
        __builtin_amdgcn_global_load_lds((const unsigned*)((const char*)(gbase) + (voff)[_i]), (PG8_LAS unsigned*)(lds + (bufoff) + ldsw + _i * 8192), 16, 0, 0); } while (0)
#define PG8_LDA(dst, b, h) do { _Pragma("unroll") for (int m = 0; m < 4; ++m) _Pragma("unroll") for (int k = 0; k < 2; ++k) dst[m][k] = *(const PG8_LAS bf16x8*)(lds + PG8_SA(b, h) + aoff + m * 2048 + k * 1024); } while (0)
#define PG8_LDB(dst, b, h) do { _Pragma("unroll") for (int n = 0; n < 2; ++n) _Pragma("unroll") for (int k = 0; k < 2; ++k) dst[n][k] = *(const PG8_LAS bf16x8*)(lds + PG8_SB(b, h) + boff + n * 2048 + k * 1024); } while (0)
#define PG8_MMA(ai, bj, At, Bt) do { __builtin_amdgcn_s_setprio(1); _Pragma("unroll") for (int m = 0; m < 4; ++m) _Pragma("unroll") for (int n = 0; n < 2; ++n) _Pragma("unroll") for (int k = 0; k < 2; ++k) \
        acc[ai][bj][m][n] = __builtin_amdgcn_mfma_f32_16x16x32_bf16(Bt[n][k], At[m][k], acc[ai][bj][m][n], 0, 0, 0); __builtin_amdgcn_s_setprio(0); } while (0)
#define PG8_WAIT_V(n) asm volatile("s_waitcnt vmcnt(" #n ")" ::: "memory")
#define PG8_WAIT_L(n) asm volatile("s_waitcnt lgkmcnt(" #n ")" ::: "memory")
#define PG8_BAR __builtin_amdgcn_s_barrier()
#define PG8_SCHED __builtin_amdgcn_sched_barrier(0)
    Unit cur, nxt; int ui = 0;
    if (!S.next(0, cur)) return;
    f32x4 acc[2][2][4][2];
#pragma unroll
    for (int a = 0; a < 2; ++a)
#pragma unroll
        for (int b = 0; b < 2; ++b)
#pragma unroll
            for (int m = 0; m < 4; ++m)
#pragma unroll
                for (int n = 0; n < 2; ++n) acc[a][b][m][n] = (f32x4){0.f, 0.f, 0.f, 0.f};
    bf16x8 At[4][2], B0[2][2], B1[2][2];
    const char* cA = (const char*)g.A + (size_t)cur.pm * tstepA; const char* cB = (const char*)g.Bt + (size_t)cur.pn * tstepB;
    S.a_ready(cur);
    if constexpr (SP2) {
        PG8_STAGE(PG8_SB(0, 0), cB, voffB); PG8_STAGE(PG8_SB(0, 1), cB + hstepB, voffB); PG8_STAGE(PG8_SA(0, 0), cA, voffA); PG8_STAGE(PG8_SA(0, 1), cA + hstepA, voffA);
        if (wr == 1) PG8_BAR;
        PG8_WAIT_V(2); PG8_BAR;
        PG8_STAGE(PG8_SB(1, 0), cB + kstep, voffB); PG8_STAGE(PG8_SA(1, 0), cA + kstep, voffA); PG8_STAGE(PG8_SB(1, 1), cB + hstepB + kstep, voffB);
        PG8_WAIT_V(6); PG8_BAR;
    } else {
        PG8_STAGE(PG8_SB(0, 0), cB, voffB); PG8_STAGE(PG8_SA(0, 0), cA, voffA); PG8_STAGE(PG8_SB(0, 1), cB + hstepB, voffB); PG8_STAGE(PG8_SA(0, 1), cA + hstepA, voffA);
        if (wr == 1) PG8_BAR;
        PG8_WAIT_V(4); PG8_BAR;
        PG8_STAGE(PG8_SB(1, 0), cB + kstep, voffB); PG8_STAGE(PG8_SA(1, 0), cA + kstep, voffA); PG8_STAGE(PG8_SB(1, 1), cB + hstepB + kstep, voffB);
        PG8_WAIT_V(6); PG8_BAR;
    }
    for (;;) {
        const bool has_next = S.next(ui + 1, nxt);
        const char* nA = has_next ? (const char*)g.A + (size_t)nxt.pm * tstepA : cA; const char* nB = has_next ? (const char*)g.Bt + (size_t)nxt.pn * tstepB : cB;
        for (int t = 0; t < nt; t += 2) {
            if constexpr (Epi::HAS_MID) { if (t == E.kmid) E.mid(acc, cur, wr, wc, fr, fq); }
            const bool last = (t == nt - 2);
            const char* a1 = cA + (size_t)(t + 1) * kstep;
            const char* a2 = last ? nA : cA + (size_t)(t + 2) * kstep; const char* b2 = last ? nB : cB + (size_t)(t + 2) * kstep;
            const char* a3 = a2 + kstep; const char* b3 = b2 + kstep;
            if (last && has_next) S.a_ready(nxt);
            if constexpr (SP2) {
            PG8_LDB(B0, 0, 0); PG8_LDB(B1, 0, 1); PG8_SCHED; PG8_LDA(At, 0, 0); PG8_STAGE(PG8_SA(1, 1), a1 + hstepA, voffA);
            PG8_WAIT_V(8); PG8_WAIT_L(0); PG8_BAR; PG8_MMA(0, 0, At, B0); PG8_MMA(0, 1, At, B1); PG8_BAR; PG8_SCHED;
            PG8_LDA(At, 0, 1); PG8_STAGE(PG8_SB(0, 0), b2, voffB); PG8_STAGE(PG8_SB(0, 1), b2 + hstepB, voffB); PG8_STAGE(PG8_SA(0, 0), a2, voffA);
            PG8_WAIT_V(8); PG8_WAIT_L(0); PG8_BAR; PG8_MMA(1, 0, At, B0); PG8_MMA(1, 1, At, B1); PG8_BAR; PG8_SCHED;
            PG8_LDB(B0, 1, 0); PG8_LDB(B1, 1, 1); PG8_SCHED; PG8_LDA(At, 1, 0); PG8_STAGE(PG8_SA(0, 1), a2 + hstepA, voffA);
            PG8_WAIT_V(8); PG8_WAIT_L(0); PG8_BAR; PG8_MMA(0, 0, At, B0); PG8_MMA(0, 1, At, B1); PG8_BAR; PG8_SCHED;
            PG8_LDA(At, 1, 1); PG8_STAGE(PG8_SB(1, 0), b3, voffB); PG8_STAGE(PG8_SB(1, 1), b3 + hstepB, voffB); PG8_STAGE(PG8_SA(1, 0), a3, voffA);
            PG8_WAIT_V(8); PG8_WAIT_L(0); PG8_BAR; PG8_MMA(1, 0, At, B0); PG8_MMA(1, 1, At, B1); PG8_BAR; PG8_SCHED;
            } else {
            PG8_LDB(B0, 0, 0); PG8_SCHED; PG8_LDA(At, 0, 0); PG8_STAGE(PG8_SA(1, 1), a1 + hstepA, voffA);
            PG8_WAIT_L(8); PG8_BAR; PG8_WAIT_L(0); PG8_MMA(0, 0, At, B0); PG8_BAR; PG8_SCHED;
            PG8_LDB(B1, 0, 1); PG8_STAGE(PG8_SB(0, 0), b2, voffB);
            PG8_BAR; PG8_WAIT_L(0); PG8_MMA(0, 1, At, B1); PG8_BAR;
            PG8_LDA(At, 0, 1); PG8_STAGE(PG8_SA(0, 0), a2, voffA);
            PG8_BAR; PG8_WAIT_L(0); PG8_MMA(1, 0, At, B0); PG8_BAR; PG8_SCHED;
            PG8_STAGE(PG8_SB(0, 1), b2 + hstepB, voffB);
            PG8_WAIT_V(6); PG8_BAR; PG8_MMA(1, 1, At, B1); PG8_BAR;
            PG8_LDB(B0, 1, 0); PG8_SCHED; PG8_LDA(At, 1, 0); PG8_STAGE(PG8_SA(0, 1), a2 + hstepA, voffA);
            PG8_WAIT_L(8); PG8_BAR; PG8_WAIT_L(0); PG8_MMA(0, 0, At, B0); PG8_BAR; PG8_SCHED;
            PG8_LDB(B1, 1, 1); PG8_STAGE(PG8_SB(1, 0), b3, voffB);
            PG8_BAR; PG8_WAIT_L(0); PG8_MMA(0, 1, At, B1); PG8_BAR;
            PG8_LDA(At, 1, 1); PG8_STAGE(PG8_SA(1, 0), a3, voffA);
            PG8_BAR; PG8_WAIT_L(0); PG8_MMA(1, 0, At, B0); PG8_BAR; PG8_SCHED;
            PG8_STAGE(PG8_SB(1, 1), b3 + hstepB, voffB);
            PG8_WAIT_V(6); PG8_BAR; PG8_MMA(1, 1, At, B1); PG8_BAR;
            }
        }
        if constexpr (ALIGN_EPI) { if (wr == 0) PG8_BAR; }
        if constexpr (!Epi::AFTER_DRAIN) { E(acc, cur, wr, wc, fr, fq); S.done(cur); }
        if (!has_next) break;
#pragma unroll
        for (int a = 0; a < 2; ++a)
#pragma unroll
            for (int b = 0; b < 2; ++b)
#pragma unroll
                for (int m = 0; m < 4; ++m)
#pragma unroll
                    for (int n = 0; n < 2; ++n) acc[a][b][m][n] = (f32x4){0.f, 0.f, 0.f, 0.f};
        cur = nxt; cA = nA; cB = nB; ++ui;
        if constexpr (ALIGN_EPI) { if (wr == 1) PG8_BAR; }
    }
    PG8_WAIT_V(0);
    if constexpr (!ALIGN_EPI) { if (wr == 0) PG8_BAR; }
    PG8_BAR;
    if constexpr (Epi::AFTER_DRAIN) { E.fused(acc, cur, wr, wc, fr, fq, lds, wid, lane); S.done(cur); }
#undef PG8_SA
#undef PG8_SB
#undef PG8_STAGE
#undef PG8_LDA
#undef PG8_LDB
#undef PG8_MMA
#undef PG8_WAIT_V
#undef PG8_WAIT_L
#undef PG8_BAR
#undef PG8_SCHED
}
}

constexpr int NTOK = 16384, DM = 1024, INW = 1280, SSMW = 512, NGRP = 32, NST = 64, SEQL = 2048, NBATCH = 8, DFF = 2816;
constexpr int TCH = 32, NCH = SEQL / TCH  , GROWS = NBATCH * NCH  , KX = 128 + TCH * 16  ;
constexpr size_t MiB = 1u << 20;
constexpr size_t WS_BAR = 0;
constexpr size_t WS_CNT = 16384;
constexpr size_t WS_XB = 65536;
constexpr size_t WS_RSQ = 896 * 1024;
constexpr size_t WS_RS0 = 1 * MiB + 65536;
constexpr size_t WS_XT = 1 * MiB + 131072;
constexpr size_t WS_RSQH = 1 * MiB;
constexpr size_t WS_WIN = 2 * MiB, WS_WGLU = 5 * MiB, WS_WOUT = 6 * MiB, WS_WGU = 8 * MiB, WS_WDN = 19 * MiB;
constexpr size_t WS_TW = 25 * MiB;
constexpr size_t WS_W1 = 45 * MiB;
constexpr size_t WS_AT = 49 * MiB;
constexpr size_t WS_XN = 50 * MiB;
constexpr size_t WS_UX = 162 * MiB;
constexpr size_t WS_Q = 182 * MiB, WS_K = 198 * MiB, WS_VT = 202 * MiB;
constexpr size_t WS_Y = 82 * MiB;
constexpr size_t WS_MG = 98 * MiB;
constexpr size_t WS_ACT = 162 * MiB;
constexpr size_t WS_HB = 130 * MiB;
constexpr size_t WS_END = 250 * MiB;
constexpr int LDS_BYTES = 147456, LDSCTL_OFF = 143360;
constexpr float NORM_EPS = 1e-6f;
constexpr float LOG2E = 1.4426950408889634f;

#define LAS __attribute__((address_space(3)))
typedef unsigned short bf16;
typedef float f32x4 __attribute__((ext_vector_type(4)));
typedef float f32x16 __attribute__((ext_vector_type(16)));
typedef unsigned u32x4 __attribute__((ext_vector_type(4)));
typedef unsigned u32x2 __attribute__((ext_vector_type(2)));
typedef float f32x2 __attribute__((ext_vector_type(2)));
typedef short bf16x8 __attribute__((ext_vector_type(8)));
using pg8::cvt_pk_bf16;

__device__ __forceinline__ float bf_lo(unsigned w) { return __uint_as_float(w << 16); }
__device__ __forceinline__ float bf_hi(unsigned w) { return __uint_as_float(w & 0xffff0000u); }
__device__ __forceinline__ float fast_sigmoid(float x) { return __builtin_amdgcn_rcpf(1.0f + __builtin_amdgcn_exp2f(-x * LOG2E)); }
__device__ __forceinline__ float gelu_tanh(float x) { const float u = 1.5957691216057308f * (x + 0.044715f * x * x * x); return x * fast_sigmoid(u); }
__device__ __forceinline__ float wave_sum(float v) {
#pragma unroll
    for (int o = 1; o < 64; o <<= 1) v += __shfl_xor(v, o);
    return v;
}
__device__ __forceinline__ int crow(int r, int hi) { return (r & 3) + 8 * (r >> 2) + 4 * hi; }

struct Params {
    const float* x; const int* pos; const float* g_pre_mix; const float* w_in; const float* lam_re; const float* lam_im; const float* log_dt;
    const float* b_re; const float* b_im; const float* c_re; const float* c_im; const float* ssm_d; const float* w_glu; const float* b_glu; const float* sinks;
    const float* g_ssm_out; const float* g_attn_out; const float* w_out; const float* g_post_mix; const float* g_pre_ffn; const float* w_gate_up; const float* w_down; const float* g_post_ffn;
    float* out; unsigned char* ws;
};

namespace pg8 {
struct EpiInProj {
    static constexpr bool PERM = true, AFTER_DRAIN = false, HAS_MID = false;
    bf16_t* UX; bf16_t* Q; bf16_t* Kb; bf16_t* VT; const int* pos; const float* rs0;
    __device__ __forceinline__ void operator()(const f32x4 (&acc_)[2][2][4][2], const Unit& u, int wr, int wc, int fr, int fq) const {
        const int row0 = u.pm * BM + wr * 64 + fr;
        f32x4 acc[2][2][4][2];
#pragma unroll
        for (int ai = 0; ai < 2; ++ai)
#pragma unroll
            for (int m = 0; m < 4; ++m) { const float r = rs0[row0 + ai * HALF + m * 16];
#pragma unroll
                for (int bj = 0; bj < 2; ++bj)
#pragma unroll
                    for (int n = 0; n < 2; ++n) acc[ai][bj][m][n] = acc_[ai][bj][m][n] * r; }
        if (u.pn < 2) {
#pragma unroll
            for (int ai = 0; ai < 2; ++ai)
#pragma unroll
                for (int m = 0; m < 4; ++m) { const int tok = row0 + ai * HALF + m * 16;
#pragma unroll
                    for (int bj = 0; bj < 2; ++bj) { const int g = u.pn * 16 + bj * 8 + wc * 2 + (fq >> 1), h0 = 8 * (fq & 1);
                        bf16_t* dst = UX + ((size_t)(g * 512 + (tok >> 5))) * 640 + 128 + (tok & 31) * 16 + h0;
                        const f32x4 v0 = acc[ai][bj][m][0], v1 = acc[ai][bj][m][1]; u32x4 w;
                        w.x = cvt_pk_bf16(v0[0], v0[1]); w.y = cvt_pk_bf16(v0[2], v0[3]); w.z = cvt_pk_bf16(v1[0], v1[1]); w.w = cvt_pk_bf16(v1[2], v1[3]);
                        *(u32x4*)dst = w; } }
        } else {
            const bool isq = u.pn < 4; const bool dorope = (wc & 1) == 0;
            const float qs = 0.125f * 1.4426950408889634f;
#pragma unroll
            for (int ai = 0; ai < 2; ++ai)
#pragma unroll
                for (int m = 0; m < 4; ++m) { const int tok = row0 + ai * HALF + m * 16;
                    float cs0[4], sn0[4], cs1[4], sn1[4];
                    if (dorope) { const float pf = (float)pos[tok];
                        constexpr float IFR[8] = {0.15915494309189535f, 0.03086376340470123f, 0.005985185712713705f, 0.001160663641240061f, 0.00022507907903927653f, 4.364795279280289e-05f, 8.464330808241401e-06f, 1.6414262627950345e-06f};
#pragma unroll
                        for (int j = 0; j < 4; ++j) { const float r0 = __builtin_amdgcn_fractf(pf * IFR[j]), r1 = __builtin_amdgcn_fractf(pf * IFR[4 + j]);
                            cs0[j] = __builtin_amdgcn_cosf(r0); sn0[j] = __builtin_amdgcn_sinf(r0); cs1[j] = __builtin_amdgcn_cosf(r1); sn1[j] = __builtin_amdgcn_sinf(r1); } }
#pragma unroll
                    for (int bj = 0; bj < 2; ++bj) {
                        f32x4 v0 = acc[ai][bj][m][0], v1 = acc[ai][bj][m][1];
                        if (isq || bj == 0) {
                            if (dorope) {
#pragma unroll
                                for (int j = 0; j < 4; ++j) {
                                    const float p0 = __shfl_xor(v0[j], 16), p1 = __shfl_xor(v1[j], 16);
                                    const float c0 = cs0[j], s0 = sn0[j], c1 = cs1[j], s1 = sn1[j];
                                    if (fq == 0) { v0[j] = v0[j] * c0 - p0 * s0; v1[j] = v1[j] * c1 - p1 * s1; }
                                    else if (fq == 1) { v0[j] = v0[j] * c0 + p0 * s0; v1[j] = v1[j] * c1 + p1 * s1; }
                                }
                            }
                            bf16_t* dst;
                            if (isq) { const int head = (u.pn - 2) * 4 + bj * 2 + (wc >> 1); v0 = v0 * qs; v1 = v1 * qs; dst = Q + (size_t)tok * 512 + head * 64 + (wc & 1) * 32 + 8 * fq; }
                            else dst = Kb + (size_t)tok * 128 + (wc >> 1) * 64 + (wc & 1) * 32 + 8 * fq;
                            u32x4 w; w.x = cvt_pk_bf16(v0[0], v0[1]); w.y = cvt_pk_bf16(v0[2], v0[3]); w.z = cvt_pk_bf16(v1[0], v1[1]); w.w = cvt_pk_bf16(v1[2], v1[3]);
                            *(u32x4*)dst = w;
                        } else {
                            const int hk = wc >> 1, d0 = (wc & 1) * 32 + 8 * fq, b = tok >> 11, l = tok & 2047;
                            bf16_t* dst = VT + ((size_t)((b * 2 + hk) * 64 + d0)) * 2048 + l;
#pragma unroll
                            for (int j = 0; j < 4; ++j) { dst[(size_t)j * 2048] = (bf16_t)(cvt_pk_bf16(v0[j], 0.f) & 0xffffu); dst[(size_t)(4 + j) * 2048] = (bf16_t)(cvt_pk_bf16(v1[j], 0.f) & 0xffffu); }
                        }
                    }
                }
        }
    }
};
struct EpiSsmC {
    static constexpr bool PERM = true, AFTER_DRAIN = false, HAS_MID = false;
    const bf16_t* UX; const float* dvec; bf16_t* Y;
    __device__ __forceinline__ void operator()(const f32x4 (&acc)[2][2][4][2], const Unit& u, int wr, int wc, int fr, int fq) const {
        const int g = u.pm >> 1, pmr = u.pm & 1, pnr = u.pn & 1, h0 = 8 * (fq & 1);
        const f32x4 d0 = *(const f32x4*)(dvec + g * 16 + h0), d1 = *(const f32x4*)(dvec + g * 16 + h0 + 4);
#pragma unroll
        for (int ai = 0; ai < 2; ++ai)
#pragma unroll
            for (int m = 0; m < 4; ++m) { const int nloc = pmr * 256 + ai * HALF + wr * 64 + m * 16 + fr;
#pragma unroll
                for (int bj = 0; bj < 2; ++bj) { const int t = pnr * 16 + bj * 8 + wc * 2 + (fq >> 1); const int tok = nloc * 32 + t;
                    const u32x4 uw = *(const u32x4*)(UX + ((size_t)(g * 512 + nloc)) * 640 + 128 + t * 16 + h0);
                    const f32x4 a0 = acc[ai][bj][m][0], a1 = acc[ai][bj][m][1];
                    float y[8];
                    y[0] = a0[0] + d0[0] * bf_lo(uw.x); y[1] = a0[1] + d0[1] * bf_hi(uw.x); y[2] = a0[2] + d0[2] * bf_lo(uw.y); y[3] = a0[3] + d0[3] * bf_hi(uw.y);
                    y[4] = a1[0] + d1[0] * bf_lo(uw.z); y[5] = a1[1] + d1[1] * bf_hi(uw.z); y[6] = a1[2] + d1[2] * bf_lo(uw.w); y[7] = a1[3] + d1[3] * bf_hi(uw.w);
#pragma unroll
                    for (int i = 0; i < 8; ++i) y[i] = gelu_tanh(y[i]);
                    u32x4 w; w.x = cvt_pk_bf16(y[0], y[1]); w.y = cvt_pk_bf16(y[2], y[3]); w.z = cvt_pk_bf16(y[4], y[5]); w.w = cvt_pk_bf16(y[6], y[7]);
                    *(u32x4*)(Y + (size_t)tok * 512 + g * 16 + h0) = w; } }
    }
};
template <int MODE  > struct EpiGated {
    static constexpr bool PERM = true, AFTER_DRAIN = false, HAS_MID = false;
    bf16_t* O; int ldc; const float* bias; float* rowsq;
    __device__ __forceinline__ void operator()(const f32x4 (&acc)[2][2][4][2], const Unit& u, int wr, int wc, int fr, int fq) const {
        const int row0 = u.pm * BM + wr * 64 + fr, col0 = u.pn * HALF + wc * 32 + 8 * fq;
        float rsc[2][4];
        if (MODE == 1) {
#pragma unroll
            for (int ai = 0; ai < 2; ++ai)
#pragma unroll
                for (int m = 0; m < 4; ++m) rsc[ai][m] = 1.0f / sqrtf(rowsq[row0 + ai * HALF + m * 16] * (1.0f / 1024.0f) + 1e-6f);
        }
        f32x4 ba[2], bg[2];
        if (MODE == 0) { ba[0] = *(const f32x4*)(bias + col0); ba[1] = *(const f32x4*)(bias + col0 + 4); bg[0] = *(const f32x4*)(bias + 512 + col0); bg[1] = *(const f32x4*)(bias + 512 + col0 + 4); }
#pragma unroll
        for (int ai = 0; ai < 2; ++ai)
#pragma unroll
            for (int m = 0; m < 4; ++m) { float o[8];
#pragma unroll
                for (int n = 0; n < 2; ++n)
#pragma unroll
                    for (int j = 0; j < 4; ++j) { const float a = (MODE == 1) ? acc[ai][0][m][n][j] * rsc[ai][m] : acc[ai][0][m][n][j], gt = (MODE == 1) ? acc[ai][1][m][n][j] * rsc[ai][m] : acc[ai][1][m][n][j];
                        o[4 * n + j] = (MODE == 0) ? (a + ba[n][j]) * fast_sigmoid(gt + bg[n][j]) : (a * fast_sigmoid(a)) * gt; }
                u32x4 w; w.x = cvt_pk_bf16(o[0], o[1]); w.y = cvt_pk_bf16(o[2], o[3]); w.z = cvt_pk_bf16(o[4], o[5]); w.w = cvt_pk_bf16(o[6], o[7]);
                *(u32x4*)(O + (size_t)(row0 + ai * HALF + m * 16) * ldc + col0) = w;
                if (MODE == 0) { float s = ((o[0] * o[0] + o[1] * o[1]) + (o[2] * o[2] + o[3] * o[3])) + ((o[4] * o[4] + o[5] * o[5]) + (o[6] * o[6] + o[7] * o[7]));
                    s += __shfl_xor(s, 16); s += __shfl_xor(s, 32); if (fq == 0) unsafeAtomicAdd(rowsq + row0 + ai * HALF + m * 16, s); } }
    }
};
struct EpiF32 {
    static constexpr bool PERM = true, AFTER_DRAIN = false, HAS_MID = false;
    float* O; int ldc;
    __device__ __forceinline__ void operator()(const f32x4 (&acc)[2][2][4][2], const Unit& u, int wr, int wc, int fr, int fq) const {
        const int row0 = u.pm * BM + wr * 64 + fr, col0 = u.pn * BM + wc * 32 + 8 * fq;
#pragma unroll
        for (int ai = 0; ai < 2; ++ai)
#pragma unroll
            for (int m = 0; m < 4; ++m) { float* rowp = O + (size_t)(row0 + ai * HALF + m * 16) * ldc + col0;
#pragma unroll
                for (int bj = 0; bj < 2; ++bj) { *(f32x4*)(rowp + bj * HALF) = acc[ai][bj][m][0]; *(f32x4*)(rowp + bj * HALF + 4) = acc[ai][bj][m][1]; } }
    }
};

struct PanelSq {
    float* xbuf;
    unsigned* cnt;
    float eps;
    __device__ __forceinline__ void run(const f32x4 (&v)[2][2][4][2], const Unit& u, int wr, int wc, int fr, int fq, PG8_LAS unsigned char* lds, int wid, int lane) const {
        PG8_LAS float* Pp = (PG8_LAS float*)lds;
        PG8_LAS float* S = (PG8_LAS float*)(lds + 4096);
#pragma unroll
        for (int ai = 0; ai < 2; ++ai)
#pragma unroll
            for (int m = 0; m < 4; ++m) { float s = 0.f;
#pragma unroll
                for (int bj = 0; bj < 2; ++bj)
#pragma unroll
                    for (int n = 0; n < 2; ++n) { const f32x4 x = v[ai][bj][m][n]; s += (x[0] * x[0] + x[1] * x[1]) + (x[2] * x[2] + x[3] * x[3]); }
                s += __shfl_xor(s, 16); s += __shfl_xor(s, 32);
                if (fq == 0) Pp[(ai * HALF + wr * 64 + m * 16 + fr) * 4 + wc] = s; }
        asm volatile("s_waitcnt lgkmcnt(0)" ::: "memory"); __builtin_amdgcn_s_barrier(); asm volatile("" ::: "memory");
        const int row = wid * 32 + (lane & 31);
        if (lane < 32) { const float t = (Pp[row * 4 + 0] + Pp[row * 4 + 1]) + (Pp[row * 4 + 2] + Pp[row * 4 + 3]);
            __hip_atomic_store(xbuf + ((size_t)(u.pm * BM + row) * 4 + u.pn), t, __ATOMIC_RELAXED, __HIP_MEMORY_SCOPE_AGENT); }
        asm volatile("s_waitcnt vmcnt(0)" ::: "memory");
        if (lane == 0) __hip_atomic_fetch_add(cnt + 64 * u.pm, 1u, __ATOMIC_RELAXED, __HIP_MEMORY_SCOPE_AGENT);
        if (wid == 0) { unsigned sp = 0;
            while ((unsigned)__builtin_amdgcn_readfirstlane(__hip_atomic_load(cnt + 64 * u.pm, __ATOMIC_RELAXED, __HIP_MEMORY_SCOPE_AGENT)) < 32u) { __builtin_amdgcn_s_sleep(2); if (++sp > (1u << 22)) break; }
            __builtin_amdgcn_fence(__ATOMIC_ACQUIRE, "agent"); }
        asm volatile("s_waitcnt vmcnt(0) lgkmcnt(0)" ::: "memory"); __builtin_amdgcn_s_barrier(); asm volatile("" ::: "memory");
        if (lane < 32) { const float* slot = xbuf + (size_t)(u.pm * BM + row) * 4; float q = 0.f;
#pragma unroll
            for (int t = 0; t < 4; ++t) q += __hip_atomic_load(slot + t, __ATOMIC_RELAXED, __HIP_MEMORY_SCOPE_AGENT);
            S[row] = 1.0f / sqrtf(q * (1.0f / 1024.0f) + eps); }
        asm volatile("s_waitcnt lgkmcnt(0)" ::: "memory"); __builtin_amdgcn_s_barrier(); asm volatile("" ::: "memory");
    }
};
struct EpiNormResNorm {
    static constexpr bool PERM = true, AFTER_DRAIN = true, HAS_MID = true;
    const bf16_t* base; bf16_t* hb; float* rsq_h; const float* g1; PanelSq st1;
    const PG8_LAS float* tab; int kmid;
    __device__ __forceinline__ void mid(f32x4 (&acc)[2][2][4][2], const Unit& u, int wr, int wc, int fr, int fq) const {
#pragma unroll
        for (int ai = 0; ai < 2; ++ai)
#pragma unroll
            for (int m = 0; m < 4; ++m) { const float f = tab[ai * HALF + wr * 64 + m * 16 + fr];
#pragma unroll
                for (int bj = 0; bj < 2; ++bj)
#pragma unroll
                    for (int n = 0; n < 2; ++n) acc[ai][bj][m][n] = acc[ai][bj][m][n] * f; }
        asm volatile("s_waitcnt lgkmcnt(0)" ::: "memory");
    }
    __device__ __forceinline__ void fused(f32x4 (&acc)[2][2][4][2], const Unit& u, int wr, int wc, int fr, int fq, PG8_LAS unsigned char* lds, int wid, int lane) const {
        const PG8_LAS float* S = (const PG8_LAS float*)(lds + 4096);
        const int col0 = u.pn * BM + wc * 32 + 8 * fq;
#pragma unroll
        for (int ai = 0; ai < 2; ++ai)
#pragma unroll
            for (int m = 0; m < 4; ++m) { const float rb = tab[256 + ai * HALF + wr * 64 + m * 16 + fr];
#pragma unroll
                for (int bj = 0; bj < 2; ++bj)
#pragma unroll
                    for (int n = 0; n < 2; ++n) acc[ai][bj][m][n] = acc[ai][bj][m][n] * rb; }
        st1.run(acc, u, wr, wc, fr, fq, lds, wid, lane);
        f32x4 gv[2][2];
#pragma unroll
        for (int bj = 0; bj < 2; ++bj)
#pragma unroll
            for (int n = 0; n < 2; ++n) gv[bj][n] = *(const f32x4*)(g1 + col0 + bj * HALF + 4 * n);
#pragma unroll
        for (int ai = 0; ai < 2; ++ai)
#pragma unroll
            for (int m = 0; m < 4; ++m) { const int r = ai * HALF + wr * 64 + m * 16 + fr; const float rs = S[r]; const size_t off = (size_t)(u.pm * BM + r) * 1024 + col0;
#pragma unroll
                for (int bj = 0; bj < 2; ++bj) { const u32x4 xw = *(const u32x4*)(base + off + bj * HALF);
                    acc[ai][bj][m][0] = (f32x4){bf_lo(xw.x), bf_hi(xw.x), bf_lo(xw.y), bf_hi(xw.y)} + acc[ai][bj][m][0] * rs * gv[bj][0];
                    acc[ai][bj][m][1] = (f32x4){bf_lo(xw.z), bf_hi(xw.z), bf_lo(xw.w), bf_hi(xw.w)} + acc[ai][bj][m][1] * rs * gv[bj][1]; }
                float s = 0.f;
#pragma unroll
                for (int bj = 0; bj < 2; ++bj) { const f32x4 h0 = acc[ai][bj][m][0], h1 = acc[ai][bj][m][1];
                    s += ((h0[0] * h0[0] + h0[1] * h0[1]) + (h0[2] * h0[2] + h0[3] * h0[3])) + ((h1[0] * h1[0] + h1[1] * h1[1]) + (h1[2] * h1[2] + h1[3] * h1[3]));
                    u32x4 hw; hw.x = cvt_pk_bf16(h0[0], h0[1]); hw.y = cvt_pk_bf16(h0[2], h0[3]); hw.z = cvt_pk_bf16(h1[0], h1[1]); hw.w = cvt_pk_bf16(h1[2], h1[3]); *(u32x4*)(hb + off + bj * HALF) = hw; }
                s += __shfl_xor(s, 16); s += __shfl_xor(s, 32);
                if (fq == 0) unsafeAtomicAdd(rsq_h + u.pm * BM + r, s);
                if (m & 1) asm volatile("" ::: "memory"); }
    }
};
struct EpiNormRes {
    static constexpr bool PERM = true, AFTER_DRAIN = true, HAS_MID = false;
    const bf16_t* base; float* out; const float* g1; PanelSq st;
    __device__ __forceinline__ void fused(f32x4 (&acc)[2][2][4][2], const Unit& u, int wr, int wc, int fr, int fq, PG8_LAS unsigned char* lds, int wid, int lane) const {
        const PG8_LAS float* S = (const PG8_LAS float*)(lds + 4096);
        const int col0 = u.pn * BM + wc * 32 + 8 * fq;
        st.run(acc, u, wr, wc, fr, fq, lds, wid, lane);
        f32x4 gv[2][2];
#pragma unroll
        for (int bj = 0; bj < 2; ++bj)
#pragma unroll
            for (int n = 0; n < 2; ++n) gv[bj][n] = *(const f32x4*)(g1 + col0 + bj * HALF + 4 * n);
#pragma unroll
        for (int ai = 0; ai < 2; ++ai)
#pragma unroll
            for (int m = 0; m < 4; ++m) { const int r = ai * HALF + wr * 64 + m * 16 + fr; const float rs = S[r]; const size_t off = (size_t)(u.pm * BM + r) * 1024 + col0;
#pragma unroll
                for (int bj = 0; bj < 2; ++bj)
                { const u32x4 hw = *(const u32x4*)(base + off + bj * HALF);
                    const f32x4 b0 = (f32x4){bf_lo(hw.x), bf_hi(hw.x), bf_lo(hw.y), bf_hi(hw.y)}, b1 = (f32x4){bf_lo(hw.z), bf_hi(hw.z), bf_lo(hw.w), bf_hi(hw.w)};
                    *(f32x4*)(out + off + bj * HALF) = b0 + acc[ai][bj][m][0] * rs * gv[bj][0]; *(f32x4*)(out + off + bj * HALF + 4) = b1 + acc[ai][bj][m][1] * rs * gv[bj][1]; }
                if (m & 1) asm volatile("" ::: "memory"); }
    }
};
struct SsmOrder {
    int c;
    __device__ bool next(int i, Unit& u) const { if (i > 0 || c >= 128) return false; const int U = (c & 7) * 16 + (c >> 3), g = U >> 2; u.pm = 2 * g + ((U >> 1) & 1); u.pn = 2 * g + (U & 1); return true; }
    __device__ __forceinline__ void a_ready(const Unit&) const {}
    __device__ __forceinline__ void done(const Unit&) const {}
};
}
__device__ __forceinline__ void transpose_item(const float* W, int K, int N, bf16* WT, int src_col0, int dst_row0, int k0, LAS float* scr, int lane, const float* ks = nullptr) {
    if (ks) {
#pragma unroll 32
        for (int i = 0; i < 32; ++i) { const int kk = 2 * i + (lane >> 5); scr[kk * 33 + (lane & 31)] = W[(size_t)(k0 + kk) * N + src_col0 + (lane & 31)] * ks[kk]; }
    } else {
#pragma unroll 32
        for (int i = 0; i < 32; ++i) { const int kk = 2 * i + (lane >> 5); scr[kk * 33 + (lane & 31)] = W[(size_t)(k0 + kk) * N + src_col0 + (lane & 31)]; }
    }
    asm volatile("s_waitcnt lgkmcnt(0)" ::: "memory");
    const int c = lane & 7;
#pragma unroll
    for (int j = 0; j < 4; ++j) { const int n = (lane >> 3) + 8 * j; const LAS float* s = scr + (8 * c) * 33 + n;
        u32x4 o; o.x = cvt_pk_bf16(s[0 * 33], s[1 * 33]); o.y = cvt_pk_bf16(s[2 * 33], s[3 * 33]); o.z = cvt_pk_bf16(s[4 * 33], s[5 * 33]); o.w = cvt_pk_bf16(s[6 * 33], s[7 * 33]);
        *(u32x4*)(WT + (size_t)(dst_row0 + n) * K + k0 + 8 * c) = o; }
    asm volatile("s_waitcnt lgkmcnt(0)" ::: "memory");
}
__device__ __forceinline__ int gated_src_col(int n0, int half_off) { const int pn = n0 >> 8, r = n0 & 255; return r < 128 ? 128 * pn + r : half_off + 128 * pn + (r - 128); }

__device__ __forceinline__ void sincos_rev(double ang, float& s, float& c) {
    const double rev = ang * 0.15915494309189533576888; const float fr = (float)(rev - floor(rev));
    s = __builtin_amdgcn_sinf(fr); c = __builtin_amdgcn_cosf(fr);
}

__device__ __forceinline__ void prologue_b(const Params& P, LAS unsigned char* lds, int tid, int lane, int wave, int blk, int G, int which, int wave0 = 0) {
    unsigned char* ws = P.ws;
    for (int item = blk; (which & 1) && item < NGRP * 8; item += G) {
        const int g = item >> 3, part = item & 7;
        LAS f32x2* APW = (LAS f32x2*)lds;
        LAS f32x2* BB = APW + 33 * 64;
        LAS f32x2* CC = BB + 64 * 16;
        LAS float* KT = (LAS float*)(CC + 16 * 64);
        const float dt = expf(P.log_dt[g]);
        for (int e = tid; e < 33 * 64; e += 512) { const int jx = e >> 6, p = e & 63;
            const float lr = fminf(P.lam_re[g * 64 + p], -1e-4f), li = P.lam_im[g * 64 + p];
            const float mag = expf((float)jx * (lr * dt)); float s, c; sincos_rev((double)jx * (double)(li * dt), s, c);
            f32x2 v; v.x = mag * c; v.y = mag * s; APW[e] = v; }
        for (int e = tid; e < 64 * 16; e += 512) { const int p = e >> 4;
            const float lr = fminf(P.lam_re[g * 64 + p], -1e-4f), li = P.lam_im[g * 64 + p];
            const float mag = expf(lr * dt); float s, c; sincos_rev((double)(li * dt), s, c); const float ar = mag * c, ai = mag * s;
            const float den = lr * lr + li * li, fr = ((ar - 1.0f) * lr + ai * li) / den, fi = (ai * lr - (ar - 1.0f) * li) / den;
            const float br = P.b_re[(size_t)g * 1024 + e], bi = P.b_im[(size_t)g * 1024 + e];
            f32x2 v; v.x = fr * br - fi * bi; v.y = fr * bi + fi * br; BB[e] = v;
            f32x2 w; w.x = P.c_re[(size_t)g * 1024 + e]; w.y = P.c_im[(size_t)g * 1024 + e]; CC[e] = w; }
        __syncthreads();
        if (part == 0 && tid < 64) ((f32x2*)(ws + WS_AT))[g * 64 + tid] = APW[32 * 64 + tid];
        {
            const int hh = tid & 255, h = hh >> 4, hp = hh & 15, jl = 2 * (tid >> 8), j0 = 4 * part + jl;
            float k0 = 0.f, k1 = 0.f;
            for (int p = 0; p < 64; ++p) {
                const f32x2 cv = CC[h * 64 + p], bv = BB[p * 16 + hp], w0 = APW[j0 * 64 + p], w1 = APW[(j0 + 1) * 64 + p];
                const float zr = cv.x * bv.x - cv.y * bv.y, zi = cv.x * bv.y + cv.y * bv.x;
                k0 += zr * w0.x - zi * w0.y; k1 += zr * w1.x - zi * w1.y;
            }
            KT[jl * 256 + hh] = k0; KT[(jl + 1) * 256 + hh] = k1;
        }
        __syncthreads();
        bf16* TWg = (bf16*)(ws + WS_TW) + (size_t)g * 512 * 640;
        for (int e = tid; e < 4096; e += 512) {
            const int jj = e >> 10, t = (e >> 5) & 31, h = (e >> 1) & 15, half = e & 1, jx = 4 * part + jj;
            if (t >= jx) { const LAS float* kp = KT + jj * 256 + h * 16 + 8 * half;
                u32x4 w; w.x = cvt_pk_bf16(kp[0], kp[1]); w.y = cvt_pk_bf16(kp[2], kp[3]); w.z = cvt_pk_bf16(kp[4], kp[5]); w.w = cvt_pk_bf16(kp[6], kp[7]);
                *(u32x4*)(TWg + (size_t)(t * 16 + h) * 640 + 128 + (t - jx) * 16 + 8 * half) = w; }
            const int lg = 4 * (7 - part) + jj, s = t + lg;
            if (lg >= 1 && s < 32) *(u32x4*)(TWg + (size_t)(t * 16 + h) * 640 + 128 + s * 16 + 8 * half) = (u32x4){0u, 0u, 0u, 0u};
        }
        for (int e = tid; e < 64 * 16; e += 512) {
            const int rl = e >> 4, c8 = (e & 15) * 8, t = 4 * part + (rl >> 4), h = rl & 15; float v[8];
#pragma unroll
            for (int i = 0; i < 8; ++i) { const int q = c8 + i, p = q & 63; const f32x2 cv = CC[h * 64 + p], wv = APW[(t + 1) * 64 + p];
                v[i] = (q < 64) ? (cv.x * wv.x - cv.y * wv.y) : -(cv.x * wv.y + cv.y * wv.x); }
            u32x4 w; w.x = cvt_pk_bf16(v[0], v[1]); w.y = cvt_pk_bf16(v[2], v[3]); w.z = cvt_pk_bf16(v[4], v[5]); w.w = cvt_pk_bf16(v[6], v[7]);
            *(u32x4*)(TWg + (size_t)(t * 16 + h) * 640 + c8) = w;
        }
        bf16* W1g = (bf16*)(ws + WS_W1) + (size_t)g * 128 * 512;
        for (int e = tid; e < 16 * 64; e += 512) {
            const int q = 16 * part + (e >> 6), c8 = (e & 63) * 8, s = c8 >> 4, hp0 = c8 & 15, p = q & 63; float v[8];
            const f32x2 wv = APW[(31 - s) * 64 + p];
#pragma unroll
            for (int i = 0; i < 8; ++i) { const f32x2 bv = BB[p * 16 + hp0 + i]; v[i] = (q < 64) ? (wv.x * bv.x - wv.y * bv.y) : (wv.x * bv.y + wv.y * bv.x); }
            u32x4 w; w.x = cvt_pk_bf16(v[0], v[1]); w.y = cvt_pk_bf16(v[2], v[3]); w.z = cvt_pk_bf16(v[4], v[5]); w.w = cvt_pk_bf16(v[6], v[7]);
            *(u32x4*)(W1g + (size_t)q * 512 + c8) = w;
        }
        __syncthreads();
    }
    {
        LAS float* scr = (LAS float*)(lds + wave * 16384);
        const int gw = blk * (8 - wave0) + (wave - wave0), NGW = G * (8 - wave0);
        constexpr int I_IN = 16 * 40, I_GLU = 8 * 32, I_OUT = 16 * 32, I_GU = 16 * 176, I_DN = 44 * 32, NIT = I_IN + I_GLU + I_OUT + I_GU + I_DN;
        const int it_lo = (which & 1) ? I_IN : I_IN + I_GLU + I_OUT, it_hi = (which & 2) ? NIT : I_IN + I_GLU + I_OUT;
        for (int it = it_lo + gw; wave >= wave0 && it < it_hi; it += NGW) {
            int r = it;
            if (r < I_IN) { const int nb = r % 40, kb = r / 40; transpose_item(P.w_in, 1024, 1280, (bf16*)(ws + WS_WIN), 32 * nb, 32 * nb, 64 * kb, scr, lane); continue; } r -= I_IN;
            if (r < I_GLU) { const int nb = r % 32, kb = r / 32; transpose_item(P.w_glu, 512, 1024, (bf16*)(ws + WS_WGLU), gated_src_col(32 * nb, 512), 32 * nb, 64 * kb, scr, lane); continue; } r -= I_GLU;
            if (r < I_OUT) { const int nb = r % 32, kb = r / 32; transpose_item(P.w_out, 1024, 1024, (bf16*)(ws + WS_WOUT), 32 * nb, 32 * nb, 64 * kb, scr, lane, kb < 8 ? P.g_ssm_out + 64 * kb : P.g_attn_out + 64 * (kb - 8)); continue; } r -= I_OUT;
            if (r < I_GU) { const int nb = r % 176, kb = r / 176; transpose_item(P.w_gate_up, 1024, 5632, (bf16*)(ws + WS_WGU), gated_src_col(32 * nb, 2816), 32 * nb, 64 * kb, scr, lane, P.g_pre_ffn + 64 * kb); continue; } r -= I_GU;
            { const int nb = r % 32, kb = r / 32; transpose_item(P.w_down, 2816, 1024, (bf16*)(ws + WS_WDN), 32 * nb, 32 * nb, 64 * kb, scr, lane); }
        }
    }
}

__device__ __forceinline__ void prologue_a(const Params& P, LAS unsigned char* lds, int tid, int lane, int wave) {
    unsigned char* ws = P.ws;
    const int G = gridDim.x, blk = blockIdx.x;
    {
        LAS float* scr = (LAS float*)(lds + wave * 16384);
        const int gw = blk * 8 + wave, NGW = G * 8;
        for (int r = gw; r < 16 * 40; r += NGW) { const int nb = r % 40, kb = r / 40; transpose_item(P.w_in, 1024, 1280, (bf16*)(ws + WS_WIN), 32 * nb, 32 * nb, 64 * kb, scr, lane, P.g_pre_mix + 64 * kb); }
        for (int m = gw; m < NTOK; m += NGW) {
            const f32x4* xr = (const f32x4*)(P.x + (size_t)m * DM) + lane; f32x4 v[4]; float s = 0.f;
#pragma unroll
            for (int j = 0; j < 4; ++j) { v[j] = xr[64 * j]; s += (v[j].x * v[j].x + v[j].y * v[j].y) + (v[j].z * v[j].z + v[j].w * v[j].w); }
            const float rstd = 1.0f / sqrtf(wave_sum(s) * (1.0f / DM) + NORM_EPS);
            if (lane == 0) ((float*)(ws + WS_RS0))[m] = rstd;
            u32x2* o8 = (u32x2*)((bf16*)(ws + WS_XN) + (size_t)m * DM) + lane;
#pragma unroll
            for (int j = 0; j < 4; ++j) { u32x2 w; w.x = cvt_pk_bf16(v[j].x, v[j].y); w.y = cvt_pk_bf16(v[j].z, v[j].w); o8[64 * j] = w; }
        }
        for (int e = blk * 512 + tid; e < NTOK; e += G * 512) { ((float*)(ws + WS_RSQ))[e] = 0.f; ((float*)(ws + WS_RSQH))[e] = 0.f; }
    }
}

__device__ __forceinline__ void ssm_pass_a(const Params& P, int lane, int wave) {
    if (wave >= 2) return;
    unsigned char* ws = P.ws;
    for (int unit = wave * 256 + blockIdx.x; unit < 512; unit += 2 * gridDim.x > 512 ? 512 : 2 * gridDim.x) {
        const int g = unit >> 4, b = (unit >> 1) & 7, hs = unit & 1;
        const int r32 = lane & 31, hi = lane >> 5;
        const int sig = 16 * ((r32 >> 2) & 1) + 4 * (r32 >> 3) + (r32 & 3);
        bf16* UXg = (bf16*)(ws + WS_UX) + ((size_t)(g * 512 + b * 64)) * 640;
        const bf16* a0p = UXg + (size_t)sig * 640 + 128 + 8 * hi;
        const bf16* a1p = a0p + (size_t)32 * 640;
        const bf16* W1g = (const bf16*)(ws + WS_W1) + (size_t)g * 128 * 512;
        const bf16* b0p = W1g + (size_t)(32 * hs + r32) * 512 + 8 * hi;
        const bf16* b1p = b0p + (size_t)64 * 512;
        f32x16 acc[2][2];
#pragma unroll
        for (int i = 0; i < 2; ++i)
#pragma unroll
            for (int j = 0; j < 2; ++j)
#pragma unroll
                for (int r = 0; r < 16; ++r) acc[i][j][r] = 0.f;
#pragma unroll 4
        for (int ks = 0; ks < 32; ++ks) {
            const bf16x8 A0 = *(const bf16x8*)(a0p + 16 * ks), A1 = *(const bf16x8*)(a1p + 16 * ks), B0 = *(const bf16x8*)(b0p + 16 * ks), B1 = *(const bf16x8*)(b1p + 16 * ks);
            acc[0][0] = __builtin_amdgcn_mfma_f32_32x32x16_bf16(A0, B0, acc[0][0], 0, 0, 0);
            acc[0][1] = __builtin_amdgcn_mfma_f32_32x32x16_bf16(A0, B1, acc[0][1], 0, 0, 0);
            acc[1][0] = __builtin_amdgcn_mfma_f32_32x32x16_bf16(A1, B0, acc[1][0], 0, 0, 0);
            acc[1][1] = __builtin_amdgcn_mfma_f32_32x32x16_bf16(A1, B1, acc[1][1], 0, 0, 0);
        }
        const int p = 32 * hs + r32;
        const float2 aT = ((const float2*)(ws + WS_AT))[g * 64 + p];
        float er[2], ei[2];
#pragma unroll
        for (int rt = 0; rt < 2; ++rt) { float lr = 0.f, li = 0.f;
#pragma unroll
            for (int r = 0; r < 16; ++r) { const float nr = aT.x * lr - aT.y * li + acc[rt][0][r], ni = aT.x * li + aT.y * lr + acc[rt][1][r]; lr = nr; li = ni; }
            er[rt] = lr; ei[rt] = li; }
        float pr = aT.x, pi = aT.y;
#pragma unroll
        for (int k = 0; k < 4; ++k) { const float nr = pr * pr - pi * pi, ni = 2.f * pr * pi; pr = nr; pi = ni; }
        const float x0r = __shfl_xor(er[0], 32), x0i = __shfl_xor(ei[0], 32);
        const float s0r = hi ? x0r : 0.f, s0i = hi ? x0i : 0.f;
        const float ebr = pr * s0r - pi * s0i + er[0], ebi = pr * s0i + pi * s0r + ei[0];
        const float y0r = __shfl_xor(ebr, 32), y0i = __shfl_xor(ebi, 32);
        const float ecr = pr * y0r - pi * y0i + er[1], eci = pr * y0i + pi * y0r + ei[1];
        const float z0r = __shfl_xor(ecr, 32), z0i = __shfl_xor(eci, 32);
        const float s1r = hi ? z0r : y0r, s1i = hi ? z0i : y0i;
#pragma unroll
        for (int rt = 0; rt < 2; ++rt) { float cr = rt ? s1r : s0r, ci = rt ? s1i : s0i;
            bf16* xo = UXg + (size_t)(32 * rt + 16 * hi) * 640 + p;
#pragma unroll
            for (int r = 0; r < 16; ++r) {
                xo[(size_t)r * 640] = (bf16)(cvt_pk_bf16(cr, 0.f) & 0xffffu); xo[(size_t)r * 640 + 64] = (bf16)(cvt_pk_bf16(ci, 0.f) & 0xffffu);
                const float nr = aT.x * cr - aT.y * ci + acc[rt][0][r], ni = aT.x * ci + aT.y * cr + acc[rt][1][r]; cr = nr; ci = ni; }
        }
    }
}

__device__ __forceinline__ void attn_phase(const Params& P, LAS unsigned char* lds, int tid, int lane, int wave, int unit0, int nunits) {
    unsigned char* ws = P.ws;
    const bf16* Q = (const bf16*)(ws + WS_Q); const bf16* Kb = (const bf16*)(ws + WS_K); const bf16* VT = (const bf16*)(ws + WS_VT); bf16* MG = (bf16*)(ws + WS_MG);
    const int r32 = lane & 31, hi = lane >> 5;
    const int h = wave, hk = h >> 2;
    const float sink2 = P.sinks[h] * LOG2E;
    constexpr int KST = 272, VST = 392, VOFF = 192 * KST;
#pragma unroll 1
    for (int unit = unit0; unit < unit0 + nunits; ++unit) {
        const int b = unit >> 5, l0 = (unit & 31) * 64, tokb = b * SEQL;
        LAS float* rsq = (LAS float*)(lds + 139264);
        if (tid < 64) rsq[tid] = 0.f;
        {
            u32x4 kv[6], vv[6];
#pragma unroll
            for (int i = 0; i < 6; ++i) { const int p = tid + 512 * i, row = p >> 4, c16 = p & 15; int t = l0 - 128 + row; t = t < 0 ? t + 128 : t;
                kv[i] = *(const u32x4*)(Kb + (size_t)(tokb + t) * 128 + c16 * 8); }
#pragma unroll
            for (int i = 0; i < 6; ++i) { const int p = tid + 512 * i, row = p / 24, c = p % 24; int k0 = l0 - 128 + 8 * c; k0 = k0 < 0 ? k0 + 128 : k0;
                vv[i] = *(const u32x4*)(VT + ((size_t)(b * 128 + row)) * SEQL + k0); }
#pragma unroll
            for (int i = 0; i < 6; ++i) { const int p = tid + 512 * i, row = p >> 4, c16 = p & 15; *(LAS u32x4*)(lds + row * KST + c16 * 16) = kv[i]; }
#pragma unroll
            for (int i = 0; i < 6; ++i) { const int p = tid + 512 * i, row = p / 24, c = p % 24; LAS u32x2* d = (LAS u32x2*)(lds + VOFF + row * VST + c * 16);
                u32x2 a, bq; a.x = vv[i].x; a.y = vv[i].y; bq.x = vv[i].z; bq.y = vv[i].w; d[0] = a; d[1] = bq; }
        }
        __syncthreads();
#pragma unroll 1
        for (int sub = 0; sub < 2; ++sub) {
            const int q0 = l0 + 32 * sub;
            bf16x8 qf[4];
#pragma unroll
            for (int ds = 0; ds < 4; ++ds) qf[ds] = *(const bf16x8*)(Q + (size_t)(tokb + q0 + r32) * 512 + h * 64 + 16 * ds + 8 * hi);
            f32x16 s[5];
#pragma unroll
            for (int kt = 0; kt < 5; ++kt) {
#pragma unroll
                for (int r = 0; r < 16; ++r) s[kt][r] = 0.f;
                const LAS unsigned char* kp = lds + (32 * (kt + sub) + r32) * KST + hk * 128 + hi * 16;
#pragma unroll
                for (int ds = 0; ds < 4; ++ds) { const bf16x8 kf = *(const LAS bf16x8*)(kp + ds * 32); s[kt] = __builtin_amdgcn_mfma_f32_32x32x16_bf16(kf, qf[ds], s[kt], 0, 0, 0); }
                if (kt < 4) { const bool dead = (q0 - 128 + 32 * kt) < 0;
#pragma unroll
                    for (int r = 0; r < 16; ++r) s[kt][r] = dead ? -1e30f : s[kt][r]; }
            }
#pragma unroll
            for (int r = 0; r < 16; ++r) { const int cr = crow(r, hi); if (cr <= r32) s[0][r] = -1e30f; if (cr > r32) s[4][r] = -1e30f; }
            float m = sink2;
#pragma unroll
            for (int kt = 0; kt < 5; ++kt)
#pragma unroll
                for (int r = 0; r < 16; ++r) m = fmaxf(m, s[kt][r]);
            m = fmaxf(m, __shfl_xor(m, 32));
            float sum = 0.f;
#pragma unroll
            for (int kt = 0; kt < 5; ++kt)
#pragma unroll
                for (int r = 0; r < 16; ++r) { const float pv = __builtin_amdgcn_exp2f(s[kt][r] - m); s[kt][r] = pv; sum += pv; }
            sum += __shfl_xor(sum, 32);
            const float inv = 1.0f / (sum + __builtin_amdgcn_exp2f(sink2 - m));
            __builtin_amdgcn_sched_barrier(0);
            f32x16 o[2];
#pragma unroll
            for (int r = 0; r < 16; ++r) { o[0][r] = 0.f; o[1][r] = 0.f; }
#pragma unroll
            for (int kt = 0; kt < 5; ++kt) {
#pragma unroll
                for (int ks = 0; ks < 2; ++ks) {
                    u32x4 pw; pw.x = cvt_pk_bf16(s[kt][8 * ks + 0], s[kt][8 * ks + 1]); pw.y = cvt_pk_bf16(s[kt][8 * ks + 2], s[kt][8 * ks + 3]);
                    pw.z = cvt_pk_bf16(s[kt][8 * ks + 4], s[kt][8 * ks + 5]); pw.w = cvt_pk_bf16(s[kt][8 * ks + 6], s[kt][8 * ks + 7]);
                    const bf16x8 pa = __builtin_bit_cast(bf16x8, pw);
#pragma unroll
                    for (int dt = 0; dt < 2; ++dt) {
                        const LAS unsigned char* vp = lds + VOFF + (hk * 64 + 32 * dt + r32) * VST + (32 * (kt + sub) + 16 * ks + 4 * hi) * 2;
                        const u32x2 lo = *(const LAS u32x2*)vp, hi2 = *(const LAS u32x2*)(vp + 16);
                        u32x4 vw; vw.x = lo.x; vw.y = lo.y; vw.z = hi2.x; vw.w = hi2.y;
                        o[dt] = __builtin_amdgcn_mfma_f32_32x32x16_bf16(pa, __builtin_bit_cast(bf16x8, vw), o[dt], 0, 0, 0);
                    }
                }
            }
            {
                LAS unsigned short* stg = (LAS unsigned short*)(lds + 102400 + wave * 4608);
#pragma unroll
                for (int r = 0; r < 16; ++r) { const int cr = crow(r, hi); const float iv = __shfl(inv, cr);
                    stg[cr * 72 + r32] = (unsigned short)(cvt_pk_bf16(o[0][r] * iv, 0.f) & 0xffffu); stg[cr * 72 + 32 + r32] = (unsigned short)(cvt_pk_bf16(o[1][r] * iv, 0.f) & 0xffffu); }
                asm volatile("s_waitcnt lgkmcnt(0)" ::: "memory");
                const int row = lane >> 1, hf = lane & 1; float sq = 0.f;
                bf16* dst = MG + (size_t)(tokb + q0 + row) * 1024 + 512 + h * 64 + hf * 32;
#pragma unroll
                for (int i = 0; i < 4; ++i) { const u32x4 w = *(const LAS u32x4*)(stg + row * 72 + hf * 32 + 8 * i);
                    const float a0 = bf_lo(w.x), a1 = bf_hi(w.x), a2 = bf_lo(w.y), a3 = bf_hi(w.y), a4 = bf_lo(w.z), a5 = bf_hi(w.z), a6 = bf_lo(w.w), a7 = bf_hi(w.w);
                    sq += ((a0 * a0 + a1 * a1) + (a2 * a2 + a3 * a3)) + ((a4 * a4 + a5 * a5) + (a6 * a6 + a7 * a7));
                    *(u32x4*)(dst + 8 * i) = w; }
                sq += __shfl_xor(sq, 1);
                if (hf == 0) __builtin_amdgcn_ds_faddf(rsq + 32 * sub + row, sq, 0, 0, false);
                asm volatile("s_waitcnt lgkmcnt(0)" ::: "memory");
            }
        }
        __syncthreads();
        if (tid < 64) ((float*)(ws + WS_RSQ))[NTOK + tokb + l0 + tid] = rsq[tid];
        __syncthreads();
    }
}

#define XB_TMO      128
#define XB_XCNT(j)  (256  + 64 * (j))
#define XB_XSUB(j)  (1280 + 64 * (j))
#define XB_XGEN(j)  (2304 + 64 * (j))
#define XB_TOP      3328
#define XB_TOPGEN   3392
#define XCD_BAR_WORDS 3456
#define XB_SPIN_CAP (1u << 18)

__device__ __forceinline__ unsigned xb_ld(unsigned* p)              { return __hip_atomic_load(p, __ATOMIC_RELAXED, __HIP_MEMORY_SCOPE_AGENT); }
__device__ __forceinline__ unsigned xb_add(unsigned* p, unsigned v) { return __hip_atomic_fetch_add(p, v, __ATOMIC_RELAXED, __HIP_MEMORY_SCOPE_AGENT); }
__device__ __forceinline__ unsigned xb_xcc_id() { return (unsigned)__builtin_amdgcn_s_getreg((3 << 11) | 20) & 0xFu; }
#define XB_SPIN(cond, bar) do { unsigned _sp = 0; while (cond) { __builtin_amdgcn_s_sleep(1); \
    if ((++_sp & 255u) == 0u) { if (xb_ld(&(bar)[XB_TMO])) break; if (_sp > XB_SPIN_CAP) { atomicAdd(&(bar)[XB_TMO], 1u); break; } } } } while (0)

struct XcdBarrier {
    unsigned* bar; unsigned x;
    volatile LAS unsigned* st;
};

__device__ __forceinline__ XcdBarrier xcd_barrier_post(unsigned* bar, volatile LAS unsigned* st) {
    XcdBarrier b; b.bar = bar; b.x = xb_xcc_id(); b.st = st;
    if (threadIdx.x == 0) (void)xb_add(&bar[XB_XCNT(b.x)], 1u);
    return b;
}
__device__ __forceinline__ void xcd_barrier_complete(unsigned* bar, unsigned x, unsigned& nloc, unsigned& nx) {
    const unsigned G = gridDim.x * gridDim.y * gridDim.z;
    unsigned sum, cnt, mine, sp = 0u;
    for (;;) {
        sum = 0u; cnt = 0u; mine = 0u;
#pragma unroll
        for (unsigned j = 0; j < 16; ++j) { const unsigned c = xb_ld(&bar[XB_XCNT(j)]); sum += c; cnt += (c > 0u) ? 1u : 0u; mine = (j == x) ? c : mine; }
        if (sum == G) break;
        __builtin_amdgcn_s_sleep(1);
        if ((++sp & 255u) == 0u) { if (xb_ld(&bar[XB_TMO])) break; if (sp > XB_SPIN_CAP) { atomicAdd(&bar[XB_TMO], 1u); break; } }
    }
    nloc = mine > 0u ? mine : 1u; nx = cnt > 0u ? cnt : 1u;
}

__device__ __forceinline__ void xcd_barrier(const XcdBarrier& b) {
    asm volatile("s_waitcnt vmcnt(0)" ::: "memory");
    __syncthreads();
    if (threadIdx.x == 0) {
        unsigned* bar = b.bar;
        __builtin_amdgcn_s_waitcnt(0);
        unsigned nloc = b.st[0], nx = b.st[1];
        if (nloc == 0u) { xcd_barrier_complete(bar, b.x, nloc, nx); b.st[0] = nloc; b.st[1] = nx; }
        const unsigned old = xb_add(&bar[XB_XSUB(b.x)], 1u);
        const unsigned gen = old / nloc;
        if (old + 1u == (gen + 1u) * nloc) {
            __builtin_amdgcn_fence(__ATOMIC_RELEASE, "agent");
            asm volatile("s_waitcnt vmcnt(0)" ::: "memory");
            const unsigned og = xb_add(&bar[XB_TOP], 1u);
            const unsigned tg = og / nx;
            if (og + 1u == (tg + 1u) * nx) xb_add(&bar[XB_TOPGEN], 1u);
            else XB_SPIN(xb_ld(&bar[XB_TOPGEN]) == tg, bar);
            __builtin_amdgcn_fence(__ATOMIC_ACQUIRE, "agent");
            xb_add(&bar[XB_XGEN(b.x)], 1u);
            asm volatile("s_waitcnt vmcnt(0)" ::: "memory");
        } else {
            XB_SPIN(xb_ld(&bar[XB_XGEN(b.x)]) == gen, bar);
            __builtin_amdgcn_fence(__ATOMIC_ACQUIRE, "agent");
            asm volatile("s_waitcnt vmcnt(0)" ::: "memory");
        }
    }
    __syncthreads();
}

__device__ __forceinline__ void quad_sync(unsigned* cnt, unsigned target, bool fast) {
    asm volatile("s_waitcnt vmcnt(0)" ::: "memory");
    __syncthreads();
    if (threadIdx.x == 0) {
        if (!fast) { __builtin_amdgcn_fence(__ATOMIC_RELEASE, "agent"); asm volatile("s_waitcnt vmcnt(0)" ::: "memory"); }
        (void)xb_add(cnt, 1u);
        unsigned sp = 0u; while (xb_ld(cnt) < target) { __builtin_amdgcn_s_sleep(1); if (++sp > (1u << 22)) break; }
        __builtin_amdgcn_fence(__ATOMIC_ACQUIRE, "agent");
        asm volatile("s_waitcnt vmcnt(0)" ::: "memory");
    }
    __syncthreads();
}

__global__ void __launch_bounds__(512, 2) fwd_megakernel(Params P) {
    extern __shared__ __attribute__((aligned(16))) unsigned char lds_raw[];
    LAS unsigned char* lds = (LAS unsigned char*)lds_raw;
    cg::grid_group grid = cg::this_grid();
    const int tid = threadIdx.x, lane = tid & 63, wave = __builtin_amdgcn_readfirstlane(tid >> 6);
    const int G = gridDim.x, blk = blockIdx.x;
    unsigned char* ws = P.ws;
    typedef pg8::bf16_t bt;

    if (tid < 4) ((LAS unsigned*)(lds + LDSCTL_OFF))[tid] = 0u;
    __syncthreads();
    const XcdBarrier bar = xcd_barrier_post((unsigned*)(ws + WS_BAR), (volatile LAS unsigned*)(lds + LDSCTL_OFF));
    if (tid == 0) ((unsigned*)(ws + WS_XT))[blk] = bar.x;
    prologue_a(P, lds, tid, lane, wave);
    if (P.ws == nullptr) grid.sync();
    xcd_barrier(bar);
    {
        pg8::Gemm g{(const bt*)(ws + WS_XN), (const bt*)(ws + WS_WIN), NTOK, INW, DM, DM, DM}; pg8::StaticOrder S; S.init(NTOK, INW, G, blk);
        pg8::EpiInProj E{(bt*)(ws + WS_UX), (bt*)(ws + WS_Q), (bt*)(ws + WS_K), (bt*)(ws + WS_VT), P.pos, (const float*)(ws + WS_RS0)};
        pg8::gemm_phase<pg8::EpiInProj, pg8::StaticOrder, true, true>(lds, g, S, E);
    }
    if (G == 256) { if (blk >= 64) prologue_b(P, lds, tid, lane, wave, blk - 64, 192, 1); } else prologue_b(P, lds, tid, lane, wave, blk, G, 3);
    xcd_barrier(bar);
    ssm_pass_a(P, lane, wave);
    prologue_b(P, lds, tid, lane, wave, blk, G, 2, 2);
    xcd_barrier(bar);
    {
        pg8::Gemm g{(const bt*)(ws + WS_UX), (const bt*)(ws + WS_TW), NGRP * GROWS, NGRP * 512, KX, KX, KX}; pg8::SsmOrder S{blk};
        pg8::EpiSsmC E{(const bt*)(ws + WS_UX), P.ssm_d, (bt*)(ws + WS_Y)};
        pg8::gemm_phase<pg8::EpiSsmC, pg8::SsmOrder, true, true>(lds, g, S, E);
        if (G == 256) { if (blk >= 128) attn_phase(P, lds, tid, lane, wave, (blk - 128) * 2, 2); }
        else for (int u = blk; u < 256; u += G) attn_phase(P, lds, tid, lane, wave, u, 1);
    }
    xcd_barrier(bar);
    const bool quads = (G == 256);
    bool qfast = false; unsigned* qcnt = (unsigned*)(ws + WS_CNT) + 4096;
    if (quads) { const int x = blk & 7, p = (blk >> 3) & 7; const unsigned* xt = (const unsigned*)(ws + WS_XT);
        const unsigned x0 = xt[x + 8 * p], x1 = xt[x + 8 * (p + 8)], x2 = xt[x + 8 * (p + 16)], x3 = xt[x + 8 * (p + 24)];
        qfast = (x0 == x1) && (x1 == x2) && (x2 == x3); qcnt += 64 * (8 * x + p); }
    {
        pg8::Gemm g{(const bt*)(ws + WS_Y), (const bt*)(ws + WS_WGLU), NTOK, 1024, 512, 512, 512}; pg8::StaticOrder S; S.init(NTOK, 1024, G, blk);
        pg8::EpiGated<0> E{(bt*)(ws + WS_MG), 1024, P.b_glu, (float*)(ws + WS_RSQ)};
        pg8::gemm_phase<pg8::EpiGated<0>, pg8::StaticOrder, true, true>(lds, g, S, E);
    }
    if (quads) quad_sync(qcnt, 4u, qfast); else xcd_barrier(bar);
    {
        pg8::Gemm g{(const bt*)(ws + WS_MG), (const bt*)(ws + WS_WOUT), NTOK, DM, DM, DM, DM}; pg8::StaticOrder S; S.init(NTOK, DM, G, blk);
        pg8::PanelSq st1{(float*)(ws + WS_XB), (unsigned*)(ws + WS_CNT), NORM_EPS};
        LAS float* tab = (LAS float*)(lds + LDSCTL_OFF + 64);
        { pg8::Unit u0; if (S.next(0, u0) && tid < 256) { const int row = u0.pm * 256 + tid; const float sa = ((const float*)(ws + WS_RSQ))[row] * (1.0f / 512.0f) + NORM_EPS, sb = ((const float*)(ws + WS_RSQ))[NTOK + row] * (1.0f / 512.0f) + NORM_EPS;
            tab[tid] = sqrtf(sb / sa); tab[256 + tid] = 1.0f / sqrtf(sb); } }
        __syncthreads();
        pg8::EpiNormResNorm E{(const bt*)(ws + WS_XN), (bt*)(ws + WS_HB), (float*)(ws + WS_RSQH), P.g_post_mix, st1, tab, 8};
        pg8::gemm_phase<pg8::EpiNormResNorm, pg8::StaticOrder, false, true>(lds, g, S, E);
    }
    if (quads) quad_sync(qcnt, 8u, qfast); else xcd_barrier(bar);
    {
        pg8::Gemm g{(const bt*)(ws + WS_HB), (const bt*)(ws + WS_WGU), NTOK, 2 * DFF, DM, DM, DM}; pg8::StaticOrder S; S.init(NTOK, 2 * DFF, G, blk);
        pg8::EpiGated<1> E{(bt*)(ws + WS_ACT), DFF, nullptr, (float*)(ws + WS_RSQH)};
        pg8::gemm_phase<pg8::EpiGated<1>, pg8::StaticOrder, true, true>(lds, g, S, E);
    }
    if (quads) quad_sync(qcnt, 12u, qfast); else xcd_barrier(bar);
    {
        pg8::Gemm g{(const bt*)(ws + WS_ACT), (const bt*)(ws + WS_WDN), NTOK, DM, DFF, DFF, DFF}; pg8::StaticOrder S; S.init(NTOK, DM, G, blk);
        pg8::PanelSq st{(float*)(ws + WS_XB) + 2 * NTOK * 4, (unsigned*)(ws + WS_CNT) + 2 * 4096, NORM_EPS};
        pg8::EpiNormRes E{(const bt*)(ws + WS_HB), P.out, P.g_post_ffn, st};
        pg8::gemm_phase<pg8::EpiNormRes, pg8::StaticOrder, false, true>(lds, g, S, E);
    }
}

extern "C" void kernel_launch(void* const* d_in, const int* in_sizes, int n_in, void* d_out, int out_size, void* d_ws, size_t ws_size, hipStream_t stream) {
    static int grid_blocks = 0;
    if (grid_blocks == 0) {
        int dev = 0, cus = 0, per_cu = 0;
        hipGetDevice(&dev);
        hipDeviceGetAttribute(&cus, hipDeviceAttributeMultiprocessorCount, dev);
        hipFuncSetAttribute((const void*)fwd_megakernel, hipFuncAttributeMaxDynamicSharedMemorySize, LDS_BYTES);
        hipOccupancyMaxActiveBlocksPerMultiprocessor(&per_cu, (const void*)fwd_megakernel, 512, LDS_BYTES);
        if (per_cu < 1) { fprintf(stderr, "kernel_launch: occupancy query reports %d blocks per CU\n", per_cu); per_cu = 1; }
        grid_blocks = cus * 1;
        (void)hipGetLastError();
    }
    Params p{};
    p.x = (const float*)d_in[0]; p.pos = (const int*)d_in[1]; p.g_pre_mix = (const float*)d_in[2]; p.w_in = (const float*)d_in[3]; p.lam_re = (const float*)d_in[4]; p.lam_im = (const float*)d_in[5];
    p.log_dt = (const float*)d_in[6]; p.b_re = (const float*)d_in[7]; p.b_im = (const float*)d_in[8]; p.c_re = (const float*)d_in[9]; p.c_im = (const float*)d_in[10]; p.ssm_d = (const float*)d_in[11];
    p.w_glu = (const float*)d_in[12]; p.b_glu = (const float*)d_in[13]; p.sinks = (const float*)d_in[14]; p.g_ssm_out = (const float*)d_in[15]; p.g_attn_out = (const float*)d_in[16]; p.w_out = (const float*)d_in[17];
    p.g_post_mix = (const float*)d_in[18]; p.g_pre_ffn = (const float*)d_in[19]; p.w_gate_up = (const float*)d_in[20]; p.w_down = (const float*)d_in[21]; p.g_post_ffn = (const float*)d_in[22];
    p.out = (float*)d_out; p.ws = (unsigned char*)d_ws;
    (void)hipMemsetAsync(d_ws, 0, 65536, stream);
    void* args[] = {&p};
    hipError_t e = hipLaunchCooperativeKernel((const void*)fwd_megakernel, dim3(grid_blocks), dim3(512), args, LDS_BYTES, stream);
    if (e != hipSuccess) fprintf(stderr, "cooperative launch failed: %s (grid %d)\n", hipGetErrorString(e), grid_blocks);
}
```

```cpp
#include <hip/hip_runtime.h>
#include <hip/hip_cooperative_groups.h>
#include <cstdio>
#include <cstdint>
namespace cg = cooperative_groups;
namespace pg8 {
#define PG8_LAS __attribute__((address_space(3)))
typedef unsigned short bf16_t;
typedef short bf16x8 __attribute__((ext_vector_type(8)));
typedef float f32x4 __attribute__((ext_vector_type(4)));
typedef unsigned u32x4 __attribute__((ext_vector_type(4)));
constexpr int BM = 256, BK = 64, HALF = 128, HTB = HALF * BK * 2  , STAGE_BYTES = 8 * HTB, NXCD = 8, WGM = 8;

__host__ __device__ __forceinline__ int lds_byte(int r, int c) { const int st = (r >> 4) * 2 + (c >> 5), rr = r & 15, cc = c & 31, ob = rr * 64 + cc * 2; return st * 1024 + (ob ^ (((ob >> 9) & 1) << 5)); }
__host__ __device__ __forceinline__ void stage_rc(int b, int& R, int& C) { const int st = b / 1024, sb = b % 1024, swz = sb ^ (((sb >> 9) & 1) << 5); R = (st >> 1) * 16 + swz / 64; C = (st & 1) * 32 + (swz % 64) / 2; }
__host__ __device__ __forceinline__ int perm32(int rho) { const int n = rho >> 4, i = rho & 15; return 8 * (i >> 2) + 4 * n + (i & 3); }

struct Unit { int pm, pn; };
struct Gemm { const bf16_t* A; const bf16_t* Bt; int M, N, K, lda, ldb; };

struct StaticOrder {
    int nM, nN, nwg, G, c;
    __host__ __device__ void init(int M, int N, int G_, int c_) { nM = M / BM; nN = N / BM; nwg = nM * nN; G = G_; c = c_; }
    __host__ __device__ bool next(int i, Unit& u) const {
        const long L = (long)i * G + c; if (L >= nwg) return false;
        int wgid = (int)L; { const int q = nwg / NXCD, r = nwg % NXCD, xcd = wgid % NXCD, off = wgid / NXCD; wgid = (xcd < r ? xcd * (q + 1) : r * (q + 1) + (xcd - r) * q) + off; }
        const int nig = WGM * nN, gid = wgid / nig, fm = gid * WGM, gsz = (nM - fm) < WGM ? (nM - fm) : WGM;
        u.pm = fm + ((wgid % nig) % gsz); u.pn = (wgid % nig) / gsz; return true;
    }
    __device__ __forceinline__ void a_ready(const Unit&) const {}
    __device__ __forceinline__ void done(const Unit&) const {}
};

__device__ __forceinline__ unsigned cvt_pk_bf16(float lo, float hi) { unsigned r; asm volatile("v_cvt_pk_bf16_f32 %0, %1, %2" : "=v"(r) : "v"(lo), "v"(hi)); return r; }
template <class Epi, class Sched, bool ALIGN_EPI = false, bool SP2 = false>
__device__ __forceinline__ void gemm_phase(PG8_LAS unsigned char* lds, const Gemm g, const Sched& S, const Epi& E) {
    const int tid = threadIdx.x, wid = __builtin_amdgcn_readfirstlane(tid >> 6), lane = tid & 63, wr = wid >> 2, wc = wid & 3, fr = lane & 15, fq = lane >> 4;
    const int K = g.K, nt = K / BK;
    unsigned voffA[2], voffB[2];
#pragma unroll
    for (int i = 0; i < 2; ++i) { int R, C; stage_rc(tid * 16 + i * 8192, R, C); const int Rb = Epi::PERM ? ((R & ~31) + perm32(R & 31)) : R;
        voffA[i] = (unsigned)(R * g.lda + C) * 2u; voffB[i] = (unsigned)(Rb * g.ldb + C) * 2u; }
    const size_t kstep = (size_t)(BK * 2);
    const size_t hstepA = (size_t)HALF * g.lda * 2, hstepB = (size_t)HALF * g.ldb * 2;
    const size_t tstepA = 2 * hstepA, tstepB = 2 * hstepB;
    const unsigned ldsw = (unsigned)wid * 1024u;
    const int aoff = lds_byte(wr * 64 + fr, fq * 8), boff = lds_byte(wc * 32 + fr, fq * 8);
#define PG8_SA(b, h) (((b) * 2 + (h)) * HTB)
#define PG8_SB(b, h) ((4 + (b) * 2 + (h)) * HTB)
#define PG8_STAGE(bufoff, gbase, voff) do { _Pragma("unroll") for (int _i = 0; _i < 2; ++_i) \
        __builtin_amdgcn_global_load_lds((const unsigned*)((const char*)(gbase) + (voff)[_i]), (PG8_LAS unsigned*)(lds + (bufoff) + ldsw + _i * 8192), 16, 0, 0); } while (0)
#define PG8_LDA(dst, b, h) do { _Pragma("unroll") for (int m = 0; m < 4; ++m) _Pragma("unroll") for (int k = 0; k < 2; ++k) dst[m][k] = *(const PG8_LAS bf16x8*)(lds + PG8_SA(b, h) + aoff + m * 2048 + k * 1024); } while (0)
#define PG8_LDB(dst, b, h) do { _Pragma("unroll") for (int n = 0; n < 2; ++n) _Pragma("unroll") for (int k = 0; k < 2; ++k) dst[n][k] = *(const PG8_LAS bf16x8*)(lds + PG8_SB(b, h) + boff + n * 2048 + k * 1024); } while (0)
#define PG8_MMA(ai, bj, At, Bt) do { __builtin_amdgcn_s_setprio(1); _Pragma("unroll") for (int m = 0; m < 4; ++m) _Pragma("unroll") for (int n = 0; n < 2; ++n) _Pragma("unroll") for (int k = 0; k < 2; ++k) \
        acc[ai][bj][m][n] = __builtin_amdgcn_mfma_f32_16x16x32_bf16(Bt[n][k], At[m][k], acc[ai][bj][m][n], 0, 0, 0); __builtin_amdgcn_s_setprio(0); } while (0)
#define PG8_WAIT_V(n) asm volatile("s_waitcnt vmcnt(" #n ")" ::: "memory")
#define PG8_WAIT_L(n) asm volatile("s_waitcnt lgkmcnt(" #n ")" ::: "memory")
#define PG8_BAR __builtin_amdgcn_s_barrier()
#define PG8_SCHED __builtin_amdgcn_sched_barrier(0)
    Unit cur, nxt; int ui = 0;
    if (!S.next(0, cur)) return;
    f32x4 acc[2][2][4][2];
#pragma unroll
    for (int a = 0; a < 2; ++a)
#pragma unroll
        for (int b = 0; b < 2; ++b)
#pragma unroll
            for (int m = 0; m < 4; ++m)
#pragma unroll
                for (int n = 0; n < 2; ++n) acc[a][b][m][n] = (f32x4){0.f, 0.f, 0.f, 0.f};
    bf16x8 At[4][2], B0[2][2], B1[2][2];
    const char* cA = (const char*)g.A + (size_t)cur.pm * tstepA; const char* cB = (const char*)g.Bt + (size_t)cur.pn * tstepB;
    S.a_ready(cur);
    if constexpr (SP2) {
        PG8_STAGE(PG8_SB(0, 0), cB, voffB); PG8_STAGE(PG8_SB(0, 1), cB + hstepB, voffB); PG8_STAGE(PG8_SA(0, 0), cA, voffA); PG8_STAGE(PG8_SA(0, 1), cA + hstepA, voffA);
        if (wr == 1) PG8_BAR;
        PG8_WAIT_V(2); PG8_BAR;
        PG8_STAGE(PG8_SB(1, 0), cB + kstep, voffB); PG8_STAGE(PG8_SA(1, 0), cA + kstep, voffA); PG8_STAGE(PG8_SB(1, 1), cB + hstepB + kstep, voffB);
        PG8_WAIT_V(6); PG8_BAR;
    } else {
        PG8_STAGE(PG8_SB(0, 0), cB, voffB); PG8_STAGE(PG8_SA(0, 0), cA, voffA); PG8_STAGE(PG8_SB(0, 1), cB + hstepB, voffB); PG8_STAGE(PG8_SA(0, 1), cA + hstepA, voffA);
        if (wr == 1) PG8_BAR;
        PG8_WAIT_V(4); PG8_BAR;
        PG8_STAGE(PG8_SB(1, 0), cB + kstep, voffB); PG8_STAGE(PG8_SA(1, 0), cA + kstep, voffA); PG8_STAGE(PG8_SB(1, 1), cB + hstepB + kstep, voffB);
        PG8_WAIT_V(6); PG8_BAR;
    }
    for (;;) {
        const bool has_next = S.next(ui + 1, nxt);
        const char* nA = has_next ? (const char*)g.A + (size_t)nxt.pm * tstepA : cA; const char* nB = has_next ? (const char*)g.Bt + (size_t)nxt.pn * tstepB : cB;
        for (int t = 0; t < nt; t += 2) {
            if constexpr (Epi::HAS_MID) { if (t == E.kmid) E.mid(acc, cur, wr, wc, fr, fq); }
            const bool last = (t == nt - 2);
            const char* a1 = cA + (size_t)(t + 1) * kstep;
            const char* a2 = last ? nA : cA + (size_t)(t + 2) * kstep; const char* b2 = last ? nB : cB + (size_t)(t + 2) * kstep;
            const char* a3 = a2 + kstep; const char* b3 = b2 + kstep;
            if (last && has_next) S.a_ready(nxt);
            if constexpr (SP2) {
            PG8_LDB(B0, 0, 0); PG8_LDB(B1, 0, 1); PG8_SCHED; PG8_LDA(At, 0, 0); PG8_STAGE(PG8_SA(1, 1), a1 + hstepA, voffA);
            PG8_WAIT_V(8); PG8_WAIT_L(0); PG8_BAR; PG8_MMA(0, 0, At, B0); PG8_MMA(0, 1, At, B1); PG8_BAR; PG8_SCHED;
            PG8_LDA(At, 0, 1); PG8_STAGE(PG8_SB(0, 0), b2, voffB); PG8_STAGE(PG8_SB(0, 1), b2 + hstepB, voffB); PG8_STAGE(PG8_SA(0, 0), a2, voffA);
            PG8_WAIT_V(8); PG8_WAIT_L(0); PG8_BAR; PG8_MMA(1, 0, At, B0); PG8_MMA(1, 1, At, B1); PG8_BAR; PG8_SCHED;
            PG8_LDB(B0, 1, 0); PG8_LDB(B1, 1, 1); PG8_SCHED; PG8_LDA(At, 1, 0); PG8_STAGE(PG8_SA(0, 1), a2 + hstepA, voffA);
            PG8_WAIT_V(8); PG8_WAIT_L(0); PG8_BAR; PG8_MMA(0, 0, At, B0); PG8_MMA(0, 1, At, B1); PG8_BAR; PG8_SCHED;
            PG8_LDA(At, 1, 1); PG8_STAGE(PG8_SB(1, 0), b3, voffB); PG8_STAGE(PG8_SB(1, 1), b3 + hstepB, voffB); PG8_STAGE(PG8_SA(1, 0), a3, voffA);
            PG8_WAIT_V(8); PG8_WAIT_L(0); PG8_BAR; PG8_MMA(1, 0, At, B0); PG8_MMA(1, 1, At, B1); PG8_BAR; PG8_SCHED;
            } else {
            PG8_LDB(B0, 0, 0); PG8_SCHED; PG8_LDA(At, 0, 0); PG8_STAGE(PG8_SA(1, 1), a1 + hstepA, voffA);
            PG8_WAIT_L(8); PG8_BAR; PG8_WAIT_L(0); PG8_MMA(0, 0, At, B0); PG8_BAR; PG8_SCHED;
            PG8_LDB(B1, 0, 1); PG8_STAGE(PG8_SB(0, 0), b2, voffB);
            PG8_BAR; PG8_WAIT_L(0); PG8_MMA(0, 1, At, B1); PG8_BAR;
            PG8_LDA(At, 0, 1); PG8_STAGE(PG8_SA(0, 0), a2, voffA);
            PG8_BAR; PG8_WAIT_L(0); PG8_MMA(1, 0, At, B0); PG8_BAR; PG8_SCHED;
            PG8_STAGE(PG8_SB(0, 1), b2 + hstepB, voffB);
            PG8_WAIT_V(6); PG8_BAR; PG8_MMA(1, 1, At, B1); PG8_BAR;
            PG8_LDB(B0, 1, 0); PG8_SCHED; PG8_LDA(At, 1, 0); PG8_STAGE(PG8_SA(0, 1), a2 + hstepA, voffA);
            PG8_WAIT_L(8); PG8_BAR; PG8_WAIT_L(0); PG8_MMA(0, 0, At, B0); PG8_BAR; PG8_SCHED;
            PG8_LDB(B1, 1, 1); PG8_STAGE(PG8_SB(1, 0), b3, voffB);
            PG8_BAR; PG8_WAIT_L(0); PG8_MMA(0, 1, At, B1); PG8_BAR;
            PG8_LDA(At, 1, 1); PG8_STAGE(PG8_SA(1, 0), a3, voffA);
            PG8_BAR; PG8_WAIT_L(0); PG8_MMA(1, 0, At, B0); PG8_BAR; PG8_SCHED;
            PG8_STAGE(PG8_SB(1, 1), b3 + hstepB, voffB);
            PG8_WAIT_V(6); PG8_BAR; PG8_MMA(1, 1, At, B1); PG8_BAR;
            }
        }
        if constexpr (ALIGN_EPI) { if (wr == 0) PG8_BAR; }
        if constexpr (!Epi::AFTER_DRAIN) { E(acc, cur, wr, wc, fr, fq); S.done(cur); }
        if (!has_next) break;
#pragma unroll
        for (int a = 0; a < 2; ++a)
#pragma unroll
            for (int b = 0; b < 2; ++b)
#pragma unroll
                for (int m = 0; m < 4; ++m)
#pragma unroll
                    for (int n = 0; n < 2; ++n) acc[a][b][m][n] = (f32x4){0.f, 0.f, 0.f, 0.f};
        cur = nxt; cA = nA; cB = nB; ++ui;
        if constexpr (ALIGN_EPI) { if (wr == 1) PG8_BAR; }
    }
    PG8_WAIT_V(0);
    if constexpr (!ALIGN_EPI) { if (wr == 0) PG8_BAR; }
    PG8_BAR;
    if constexpr (Epi::AFTER_DRAIN) { E.fused(acc, cur, wr, wc, fr, fq, lds, wid, lane); S.done(cur); }
#undef PG8_SA
#undef PG8_SB
#undef PG8_STAGE
#undef PG8_LDA
#undef PG8_LDB
#undef PG8_MMA
#undef PG8_WAIT_V
#undef PG8_WAIT_L
#undef PG8_BAR
#undef PG8_SCHED
}
}

constexpr int NTOK = 16384, DM = 1024, INW = 1280, SSMW = 512, NGRP = 32, NST = 64, SEQL = 2048, NBATCH = 8, DFF = 2816;
constexpr int TCH = 32, NCH = SEQL / TCH  , GROWS = NBATCH * NCH  , KX = 128 + TCH * 16  ;
constexpr size_t MiB = 1u << 20;
constexpr size_t WS_BAR = 0;
constexpr size_t WS_CNT = 16384;
constexpr size_t WS_XB = 65536;
constexpr size_t WS_RSQ = 896 * 1024;
constexpr size_t WS_RS0 = 1 * MiB + 65536;
constexpr size_t WS_XT = 1 * MiB + 131072;
constexpr size_t WS_RSQH = 1 * MiB;
constexpr size_t WS_WIN = 2 * MiB, WS_WGLU = 5 * MiB, WS_WOUT = 6 * MiB, WS_WGU = 8 * MiB, WS_WDN = 19 * MiB;
constexpr size_t WS_TW = 25 * MiB;
constexpr size_t WS_W1 = 45 * MiB;
constexpr size_t WS_AT = 49 * MiB;
constexpr size_t WS_XN = 50 * MiB;
constexpr size_t WS_UX = 162 * MiB;
constexpr size_t WS_Q = 182 * MiB, WS_K = 198 * MiB, WS_VT = 202 * MiB;
constexpr size_t WS_Y = 82 * MiB;
constexpr size_t WS_MG = 98 * MiB;
constexpr size_t WS_ACT = 162 * MiB;
constexpr size_t WS_HB = 130 * MiB;
constexpr size_t WS_END = 250 * MiB;
constexpr int LDS_BYTES = 147456, LDSCTL_OFF = 143360;
constexpr float NORM_EPS = 1e-6f;
constexpr float LOG2E = 1.4426950408889634f;

#define LAS __attribute__((address_space(3)))
typedef unsigned short bf16;
typedef float f32x4 __attribute__((ext_vector_type(4)));
typedef float f32x16 __attribute__((ext_vector_type(16)));
typedef unsigned u32x4 __attribute__((ext_vector_type(4)));
typedef unsigned u32x2 __attribute__((ext_vector_type(2)));
typedef float f32x2 __attribute__((ext_vector_type(2)));
typedef short bf16x8 __attribute__((ext_vector_type(8)));
using pg8::cvt_pk_bf16;

__device__ __forceinline__ float bf_lo(unsigned w) { return __uint_as_float(w << 16); }
__device__ __forceinline__ float bf_hi(unsigned w) { return __uint_as_float(w & 0xffff0000u); }
__device__ __forceinline__ float fast_sigmoid(float x) { return __builtin_amdgcn_rcpf(1.0f + __builtin_amdgcn_exp2f(-x * LOG2E)); }
__device__ __forceinline__ float gelu_tanh(float x) { const float u = 1.5957691216057308f * (x + 0.044715f * x * x * x); return x * fast_sigmoid(u); }
__device__ __forceinline__ float wave_sum(float v) {
#pragma unroll
    for (int o = 1; o < 64; o <<= 1) v += __shfl_xor(v, o);
    return v;
}
__device__ __forceinline__ int crow(int r, int hi) { return (r & 3) + 8 * (r >> 2) + 4 * hi; }

struct Params {
    const float* x; const int* pos; const float* g_pre_mix; const float* w_in; const float* lam_re; const float* lam_im; const float* log_dt;
    const float* b_re; const float* b_im; const float* c_re; const float* c_im; const float* ssm_d; const float* w_glu; const float* b_glu; const float* sinks;
    const float* g_ssm_out; const float* g_attn_out; const float* w_out; const float* g_post_mix; const float* g_pre_ffn; const float* w_gate_up; const float* w_down; const float* g_post_ffn;
    float* out; unsigned char* ws;
};

namespace pg8 {
struct EpiInProj {
    static constexpr bool PERM = true, AFTER_DRAIN = false, HAS_MID = false;
    bf16_t* UX; bf16_t* Q; bf16_t* Kb; bf16_t* VT; const int* pos; const float* rs0;
    __device__ __forceinline__ void operator()(const f32x4 (&acc_)[2][2][4][2], const Unit& u, int wr, int wc, int fr, int fq) const {
        const int row0 = u.pm * BM + wr * 64 + fr;
        f32x4 acc[2][2][4][2];
#pragma unroll
        for (int ai = 0; ai < 2; ++ai)
#pragma unroll
            for (int m = 0; m < 4; ++m) { const float r = rs0[row0 + ai * HALF + m * 16];
#pragma unroll
                for (int bj = 0; bj < 2; ++bj)
#pragma unroll
                    for (int n = 0; n < 2; ++n) acc[ai][bj][m][n] = acc_[ai][bj][m][n] * r; }
        if (u.pn < 2) {
#pragma unroll
            for (int ai = 0; ai < 2; ++ai)
#pragma unroll
                for (int m = 0; m < 4; ++m) { const int tok = row0 + ai * HALF + m * 16;
#pragma unroll
                    for (int bj = 0; bj < 2; ++bj) { const int g = u.pn * 16 + bj * 8 + wc * 2 + (fq >> 1), h0 = 8 * (fq & 1);
                        bf16_t* dst = UX + ((size_t)(g * 512 + (tok >> 5))) * 640 + 128 + (tok & 31) * 16 + h0;
                        const f32x4 v0 = acc[ai][bj][m][0], v1 = acc[ai][bj][m][1]; u32x4 w;
                        w.x = cvt_pk_bf16(v0[0], v0[1]); w.y = cvt_pk_bf16(v0[2], v0[3]); w.z = cvt_pk_bf16(v1[0], v1[1]); w.w = cvt_pk_bf16(v1[2], v1[3]);
                        *(u32x4*)dst = w; } }
        } else {
            const bool isq = u.pn < 4; const bool dorope = (wc & 1) == 0;
            const float qs = 0.125f * 1.4426950408889634f;
#pragma unroll
            for (int ai = 0; ai < 2; ++ai)
#pragma unroll
                for (int m = 0; m < 4; ++m) { const int tok = row0 + ai * HALF + m * 16;
                    float cs0[4], sn0[4], cs1[4], sn1[4];
                    if (dorope) { const float pf = (float)pos[tok];
                        constexpr float IFR[8] = {0.15915494309189535f, 0.03086376340470123f, 0.005985185712713705f, 0.001160663641240061f, 0.00022507907903927653f, 4.364795279280289e-05f, 8.464330808241401e-06f, 1.6414262627950345e-06f};
#pragma unroll
                        for (int j = 0; j < 4; ++j) { const float r0 = __builtin_amdgcn_fractf(pf * IFR[j]), r1 = __builtin_amdgcn_fractf(pf * IFR[4 + j]);
                            cs0[j] = __builtin_amdgcn_cosf(r0); sn0[j] = __builtin_amdgcn_sinf(r0); cs1[j] = __builtin_amdgcn_cosf(r1); sn1[j] = __builtin_amdgcn_sinf(r1); } }
#pragma unroll
                    for (int bj = 0; bj < 2; ++bj) {
                        f32x4 v0 = acc[ai][bj][m][0], v1 = acc[ai][bj][m][1];
                        if (isq || bj == 0) {
                            if (dorope) {
#pragma unroll
                                for (int j = 0; j < 4; ++j) {
                                    const float p0 = __shfl_xor(v0[j], 16), p1 = __shfl_xor(v1[j], 16);
                                    const float c0 = cs0[j], s0 = sn0[j], c1 = cs1[j], s1 = sn1[j];
                                    if (fq == 0) { v0[j] = v0[j] * c0 - p0 * s0; v1[j] = v1[j] * c1 - p1 * s1; }
                                    else if (fq == 1) { v0[j] = v0[j] * c0 + p0 * s0; v1[j] = v1[j] * c1 + p1 * s1; }
                                }
                            }
                            bf16_t* dst;
                            if (isq) { const int head = (u.pn - 2) * 4 + bj * 2 + (wc >> 1); v0 = v0 * qs; v1 = v1 * qs; dst = Q + (size_t)tok * 512 + head * 64 + (wc & 1) * 32 + 8 * fq; }
                            else dst = Kb + (size_t)tok * 128 + (wc >> 1) * 64 + (wc & 1) * 32 + 8 * fq;
                            u32x4 w; w.x = cvt_pk_bf16(v0[0], v0[1]); w.y = cvt_pk_bf16(v0[2], v0[3]); w.z = cvt_pk_bf16(v1[0], v1[1]); w.w = cvt_pk_bf16(v1[2], v1[3]);
                            *(u32x4*)dst = w;
                        } else {
                            const int hk = wc >> 1, d0 = (wc & 1) * 32 + 8 * fq, b = tok >> 11, l = tok & 2047;
                            bf16_t* dst = VT + ((size_t)((b * 2 + hk) * 64 + d0)) * 2048 + l;
#pragma unroll
                            for (int j = 0; j < 4; ++j) { dst[(size_t)j * 2048] = (bf16_t)(cvt_pk_bf16(v0[j], 0.f) & 0xffffu); dst[(size_t)(4 + j) * 2048] = (bf16_t)(cvt_pk_bf16(v1[j], 0.f) & 0xffffu); }
                        }
                    }
                }
        }
    }
};
struct EpiSsmC {
    static constexpr bool PERM = true, AFTER_DRAIN = false, HAS_MID = false;
    const bf16_t* UX; const float* dvec; bf16_t* Y;
    __device__ __forceinline__ void operator()(const f32x4 (&acc)[2][2][4][2], const Unit& u, int wr, int wc, int fr, int fq) const {
        const int g = u.pm >> 1, pmr = u.pm & 1, pnr = u.pn & 1, h0 = 8 * (fq & 1);
        const f32x4 d0 = *(const f32x4*)(dvec + g * 16 + h0), d1 = *(const f32x4*)(dvec + g * 16 + h0 + 4);
#pragma unroll
        for (int ai = 0; ai < 2; ++ai)
#pragma unroll
            for (int m = 0; m < 4; ++m) { const int nloc = pmr * 256 + ai * HALF + wr * 64 + m * 16 + fr;
#pragma unroll
                for (int bj = 0; bj < 2; ++bj) { const int t = pnr * 16 + bj * 8 + wc * 2 + (fq >> 1); const int tok = nloc * 32 + t;
                    const u32x4 uw = *(const u32x4*)(UX + ((size_t)(g * 512 + nloc)) * 640 + 128 + t * 16 + h0);
                    const f32x4 a0 = acc[ai][bj][m][0], a1 = acc[ai][bj][m][1];
                    float y[8];
                    y[0] = a0[0] + d0[0] * bf_lo(uw.x); y[1] = a0[1] + d0[1] * bf_hi(uw.x); y[2] = a0[2] + d0[2] * bf_lo(uw.y); y[3] = a0[3] + d0[3] * bf_hi(uw.y);
                    y[4] = a1[0] + d1[0] * bf_lo(uw.z); y[5] = a1[1] + d1[1] * bf_hi(uw.z); y[6] = a1[2] + d1[2] * bf_lo(uw.w); y[7] = a1[3] + d1[3] * bf_hi(uw.w);
#pragma unroll
                    for (int i = 0; i < 8; ++i) y[i] = gelu_tanh(y[i]);
                    u32x4 w; w.x = cvt_pk_bf16(y[0], y[1]); w.y = cvt_pk_bf16(y[2], y[3]); w.z = cvt_pk_bf16(y[4], y[5]); w.w = cvt_pk_bf16(y[6], y[7]);
                    *(u32x4*)(Y + (size_t)tok * 512 + g * 16 + h0) = w; } }
    }
};
template <int MODE  > struct EpiGated {
    static constexpr bool PERM = true, AFTER_DRAIN = false, HAS_MID = false;
    bf16_t* O; int ldc; const float* bias; float* rowsq;
    __device__ __forceinline__ void operator()(const f32x4 (&acc)[2][2][4][2], const Unit& u, int wr, int wc, int fr, int fq) const {
        const int row0 = u.pm * BM + wr * 64 + fr, col0 = u.pn * HALF + wc * 32 + 8 * fq;
        float rsc[2][4];
        if (MODE == 1) {
#pragma unroll
            for (int ai = 0; ai < 2; ++ai)
#pragma unroll
                for (int m = 0; m < 4; ++m) rsc[ai][m] = 1.0f / sqrtf(rowsq[row0 + ai * HALF + m * 16] * (1.0f / 1024.0f) + 1e-6f);
        }
        f32x4 ba[2], bg[2];
        if (MODE == 0) { ba[0] = *(const f32x4*)(bias + col0); ba[1] = *(const f32x4*)(bias + col0 + 4); bg[0] = *(const f32x4*)(bias + 512 + col0); bg[1] = *(const f32x4*)(bias + 512 + col0 + 4); }
#pragma unroll
        for (int ai = 0; ai < 2; ++ai)
#pragma unroll
            for (int m = 0; m < 4; ++m) { float o[8];
#pragma unroll
                for (int n = 0; n < 2; ++n)
#pragma unroll
                    for (int j = 0; j < 4; ++j) { const float a = (MODE == 1) ? acc[ai][0][m][n][j] * rsc[ai][m] : acc[ai][0][m][n][j], gt = (MODE == 1) ? acc[ai][1][m][n][j] * rsc[ai][m] : acc[ai][1][m][n][j];
                        o[4 * n + j] = (MODE == 0) ? (a + ba[n][j]) * fast_sigmoid(gt + bg[n][j]) : (a * fast_sigmoid(a)) * gt; }
                u32x4 w; w.x = cvt_pk_bf16(o[0], o[1]); w.y = cvt_pk_bf16(o[2], o[3]); w.z = cvt_pk_bf16(o[4], o[5]); w.w = cvt_pk_bf16(o[6], o[7]);
                *(u32x4*)(O + (size_t)(row0 + ai * HALF + m * 16) * ldc + col0) = w;
                if (MODE == 0) { float s = ((o[0] * o[0] + o[1] * o[1]) + (o[2] * o[2] + o[3] * o[3])) + ((o[4] * o[4] + o[5] * o[5]) + (o[6] * o[6] + o[7] * o[7]));
                    s += __shfl_xor(s, 16); s += __shfl_xor(s, 32); if (fq == 0) unsafeAtomicAdd(rowsq + row0 + ai * HALF + m * 16, s); } }
    }
};
struct EpiF32 {
    static constexpr bool PERM = true, AFTER_DRAIN = false, HAS_MID = false;
    float* O; int ldc;
    __device__ __forceinline__ void operator()(const f32x4 (&acc)[2][2][4][2], const Unit& u, int wr, int wc, int fr, int fq) const {
        const int row0 = u.pm * BM + wr * 64 + fr, col0 = u.pn * BM + wc * 32 + 8 * fq;
#pragma unroll
        for (int ai = 0; ai < 2; ++ai)
#pragma unroll
            for (int m = 0; m < 4; ++m) { float* rowp = O + (size_t)(row0 + ai * HALF + m * 16) * ldc + col0;
#pragma unroll
                for (int bj = 0; bj < 2; ++bj) { *(f32x4*)(rowp + bj * HALF) = acc[ai][bj][m][0]; *(f32x4*)(rowp + bj * HALF + 4) = acc[ai][bj][m][1]; } }
    }
};

struct PanelSq {
    float* xbuf;
    unsigned* cnt;
    float eps;
    __device__ __forceinline__ void run(const f32x4 (&v)[2][2][4][2], const Unit& u, int wr, int wc, int fr, int fq, PG8_LAS unsigned char* lds, int wid, int lane) const {
        PG8_LAS float* Pp = (PG8_LAS float*)lds;
        PG8_LAS float* S = (PG8_LAS float*)(lds + 4096);
#pragma unroll
        for (int ai = 0; ai < 2; ++ai)
#pragma unroll
            for (int m = 0; m < 4; ++m) { float s = 0.f;
#pragma unroll
                for (int bj = 0; bj < 2; ++bj)
#pragma unroll
                    for (int n = 0; n < 2; ++n) { const f32x4 x = v[ai][bj][m][n]; s += (x[0] * x[0] + x[1] * x[1]) + (x[2] * x[2] + x[3] * x[3]); }
                s += __shfl_xor(s, 16); s += __shfl_xor(s, 32);
                if (fq == 0) Pp[(ai * HALF + wr * 64 + m * 16 + fr) * 4 + wc] = s; }
        asm volatile("s_waitcnt lgkmcnt(0)" ::: "memory"); __builtin_amdgcn_s_barrier(); asm volatile("" ::: "memory");
        const int row = wid * 32 + (lane & 31);
        if (lane < 32) { const float t = (Pp[row * 4 + 0] + Pp[row * 4 + 1]) + (Pp[row * 4 + 2] + Pp[row * 4 + 3]);
            __hip_atomic_store(xbuf + ((size_t)(u.pm * BM + row) * 4 + u.pn), t, __ATOMIC_RELAXED, __HIP_MEMORY_SCOPE_AGENT); }
        asm volatile("s_waitcnt vmcnt(0)" ::: "memory");
        if (lane == 0) __hip_atomic_fetch_add(cnt + 64 * u.pm, 1u, __ATOMIC_RELAXED, __HIP_MEMORY_SCOPE_AGENT);
        if (wid == 0) { unsigned sp = 0;
            while ((unsigned)__builtin_amdgcn_readfirstlane(__hip_atomic_load(cnt + 64 * u.pm, __ATOMIC_RELAXED, __HIP_MEMORY_SCOPE_AGENT)) < 32u) { __builtin_amdgcn_s_sleep(2); if (++sp > (1u << 22)) break; }
            __builtin_amdgcn_fence(__ATOMIC_ACQUIRE, "agent"); }
        asm volatile("s_waitcnt vmcnt(0) lgkmcnt(0)" ::: "memory"); __builtin_amdgcn_s_barrier(); asm volatile("" ::: "memory");
        if (lane < 32) { const float* slot = xbuf + (size_t)(u.pm * BM + row) * 4; float q = 0.f;
#pragma unroll
            for (int t = 0; t < 4; ++t) q += __hip_atomic_load(slot + t, __ATOMIC_RELAXED, __HIP_MEMORY_SCOPE_AGENT);
            S[row] = 1.0f / sqrtf(q * (1.0f / 1024.0f) + eps); }
        asm volatile("s_waitcnt lgkmcnt(0)" ::: "memory"); __builtin_amdgcn_s_barrier(); asm volatile("" ::: "memory");
    }
};
struct EpiNormResNorm {
    static constexpr bool PERM = true, AFTER_DRAIN = true, HAS_MID = true;
    const bf16_t* base; bf16_t* hb; float* rsq_h; const float* g1; PanelSq st1;
    const PG8_LAS float* tab; int kmid;
    __device__ __forceinline__ void mid(f32x4 (&acc)[2][2][4][2], const Unit& u, int wr, int wc, int fr, int fq) const {
#pragma unroll
        for (int ai = 0; ai < 2; ++ai)
#pragma unroll
            for (int m = 0; m < 4; ++m) { const float f = tab[ai * HALF + wr * 64 + m * 16 + fr];
#pragma unroll
                for (int bj = 0; bj < 2; ++bj)
#pragma unroll
                    for (int n = 0; n < 2; ++n) acc[ai][bj][m][n] = acc[ai][bj][m][n] * f; }
        asm volatile("s_waitcnt lgkmcnt(0)" ::: "memory");
    }
    __device__ __forceinline__ void fused(f32x4 (&acc)[2][2][4][2], const Unit& u, int wr, int wc, int fr, int fq, PG8_LAS unsigned char* lds, int wid, int lane) const {
        const PG8_LAS float* S = (const PG8_LAS float*)(lds + 4096);
        const int col0 = u.pn * BM + wc * 32 + 8 * fq;
#pragma unroll
        for (int ai = 0; ai < 2; ++ai)
#pragma unroll
            for (int m = 0; m < 4; ++m) { const float rb = tab[256 + ai * HALF + wr * 64 + m * 16 + fr];
#pragma unroll
                for (int bj = 0; bj < 2; ++bj)
#pragma unroll
                    for (int n = 0; n < 2; ++n) acc[ai][bj][m][n] = acc[ai][bj][m][n] * rb; }
        st1.run(acc, u, wr, wc, fr, fq, lds, wid, lane);
        f32x4 gv[2][2];
#pragma unroll
        for (int bj = 0; bj < 2; ++bj)
#pragma unroll
            for (int n = 0; n < 2; ++n) gv[bj][n] = *(const f32x4*)(g1 + col0 + bj * HALF + 4 * n);
#pragma unroll
        for (int ai = 0; ai < 2; ++ai)
#pragma unroll
            for (int m = 0; m < 4; ++m) { const int r = ai * HALF + wr * 64 + m * 16 + fr; const float rs = S[r]; const size_t off = (size_t)(u.pm * BM + r) * 1024 + col0;
#pragma unroll
                for (int bj = 0; bj < 2; ++bj) { const u32x4 xw = *(const u32x4*)(base + off + bj * HALF);
                    acc[ai][bj][m][0] = (f32x4){bf_lo(xw.x), bf_hi(xw.x), bf_lo(xw.y), bf_hi(xw.y)} + acc[ai][bj][m][0] * rs * gv[bj][0];
                    acc[ai][bj][m][1] = (f32x4){bf_lo(xw.z), bf_hi(xw.z), bf_lo(xw.w), bf_hi(xw.w)} + acc[ai][bj][m][1] * rs * gv[bj][1]; }
                float s = 0.f;
#pragma unroll
                for (int bj = 0; bj < 2; ++bj) { const f32x4 h0 = acc[ai][bj][m][0], h1 = acc[ai][bj][m][1];
                    s += ((h0[0] * h0[0] + h0[1] * h0[1]) + (h0[2] * h0[2] + h0[3] * h0[3])) + ((h1[0] * h1[0] + h1[1] * h1[1]) + (h1[2] * h1[2] + h1[3] * h1[3]));
                    u32x4 hw; hw.x = cvt_pk_bf16(h0[0], h0[1]); hw.y = cvt_pk_bf16(h0[2], h0[3]); hw.z = cvt_pk_bf16(h1[0], h1[1]); hw.w = cvt_pk_bf16(h1[2], h1[3]); *(u32x4*)(hb + off + bj * HALF) = hw; }
                s += __shfl_xor(s, 16); s += __shfl_xor(s, 32);
                if (fq == 0) unsafeAtomicAdd(rsq_h + u.pm * BM + r, s);
                if (m & 1) asm volatile("" ::: "memory"); }
    }
};
struct EpiNormRes {
    static constexpr bool PERM = true, AFTER_DRAIN = true, HAS_MID = false;
    const bf16_t* base; float* out; const float* g1; PanelSq st;
    __device__ __forceinline__ void fused(f32x4 (&acc)[2][2][4][2], const Unit& u, int wr, int wc, int fr, int fq, PG8_LAS unsigned char* lds, int wid, int lane) const {
        const PG8_LAS float* S = (const PG8_LAS float*)(lds + 4096);
        const int col0 = u.pn * BM + wc * 32 + 8 * fq;
        st.run(acc, u, wr, wc, fr, fq, lds, wid, lane);
        f32x4 gv[2][2];
#pragma unroll
        for (int bj = 0; bj < 2; ++bj)
#pragma unroll
            for (int n = 0; n < 2; ++n) gv[bj][n] = *(const f32x4*)(g1 + col0 + bj * HALF + 4 * n);
#pragma unroll
        for (int ai = 0; ai < 2; ++ai)
#pragma unroll
            for (int m = 0; m < 4; ++m) { const int r = ai * HALF + wr * 64 + m * 16 + fr; const float rs = S[r]; const size_t off = (size_t)(u.pm * BM + r) * 1024 + col0;
#pragma unroll
                for (int bj = 0; bj < 2; ++bj)
                { const u32x4 hw = *(const u32x4*)(base + off + bj * HALF);
                    const f32x4 b0 = (f32x4){bf_lo(hw.x), bf_hi(hw.x), bf_lo(hw.y), bf_hi(hw.y)}, b1 = (f32x4){bf_lo(hw.z), bf_hi(hw.z), bf_lo(hw.w), bf_hi(hw.w)};
                    *(f32x4*)(out + off + bj * HALF) = b0 + acc[ai][bj][m][0] * rs * gv[bj][0]; *(f32x4*)(out + off + bj * HALF + 4) = b1 + acc[ai][bj][m][1] * rs * gv[bj][1]; }
                if (m & 1) asm volatile("" ::: "memory"); }
    }
};
struct SsmOrder {
    int c;
    __device__ bool next(int i, Unit& u) const { if (i > 0 || c >= 128) return false; const int U = (c & 7) * 16 + (c >> 3), g = U >> 2; u.pm = 2 * g + ((U >> 1) & 1); u.pn = 2 * g + (U & 1); return true; }
    __device__ __forceinline__ void a_ready(const Unit&) const {}
    __device__ __forceinline__ void done(const Unit&) const {}
};
}
__device__ __forceinline__ void transpose_item(const float* W, int K, int N, bf16* WT, int src_col0, int dst_row0, int k0, LAS float* scr, int lane, const float* ks = nullptr) {
    if (ks) {
#pragma unroll 32
        for (int i = 0; i < 32; ++i) { const int kk = 2 * i + (lane >> 5); scr[kk * 33 + (lane & 31)] = W[(size_t)(k0 + kk) * N + src_col0 + (lane & 31)] * ks[kk]; }
    } else {
#pragma unroll 32
        for (int i = 0; i < 32; ++i) { const int kk = 2 * i + (lane >> 5); scr[kk * 33 + (lane & 31)] = W[(size_t)(k0 + kk) * N + src_col0 + (lane & 31)]; }
    }
    asm volatile("s_waitcnt lgkmcnt(0)" ::: "memory");
    const int c = lane & 7;
#pragma unroll
    for (int j = 0; j < 4; ++j) { const int n = (lane >> 3) + 8 * j; const LAS float* s = scr + (8 * c) * 33 + n;
        u32x4 o; o.x = cvt_pk_bf16(s[0 * 33], s[1 * 33]); o.y = cvt_pk_bf16(s[2 * 33], s[3 * 33]); o.z = cvt_pk_bf16(s[4 * 33], s[5 * 33]); o.w = cvt_pk_bf16(s[6 * 33], s[7 * 33]);
        *(u32x4*)(WT + (size_t)(dst_row0 + n) * K + k0 + 8 * c) = o; }
    asm volatile("s_waitcnt lgkmcnt(0)" ::: "memory");
}
__device__ __forceinline__ int gated_src_col(int n0, int half_off) { const int pn = n0 >> 8, r = n0 & 255; return r < 128 ? 128 * pn + r : half_off + 128 * pn + (r - 128); }

__device__ __forceinline__ void sincos_rev(double ang, float& s, float& c) {
    const double rev = ang * 0.15915494309189533576888; const float fr = (float)(rev - floor(rev));
    s = __builtin_amdgcn_sinf(fr); c = __builtin_amdgcn_cosf(fr);
}

__device__ __forceinline__ void prologue_b(const Params& P, LAS unsigned char* lds, int tid, int lane, int wave, int blk, int G, int which, int wave0 = 0) {
    unsigned char* ws = P.ws;
    for (int item = blk; (which & 1) && item < NGRP * 8; item += G) {
        const int g = item >> 3, part = item & 7;
        LAS f32x2* APW = (LAS f32x2*)lds;
        LAS f32x2* BB = APW + 33 * 64;
        LAS f32x2* CC = BB + 64 * 16;
        LAS float* KT = (LAS float*)(CC + 16 * 64);
        const float dt = expf(P.log_dt[g]);
        for (int e = tid; e < 33 * 64; e += 512) { const int jx = e >> 6, p = e & 63;
            const float lr = fminf(P.lam_re[g * 64 + p], -1e-4f), li = P.lam_im[g * 64 + p];
            const float mag = expf((float)jx * (lr * dt)); float s, c; sincos_rev((double)jx * (double)(li * dt), s, c);
            f32x2 v; v.x = mag * c; v.y = mag * s; APW[e] = v; }
        for (int e = tid; e < 64 * 16; e += 512) { const int p = e >> 4;
            const float lr = fminf(P.lam_re[g * 64 + p], -1e-4f), li = P.lam_im[g * 64 + p];
            const float mag = expf(lr * dt); float s, c; sincos_rev((double)(li * dt), s, c); const float ar = mag * c, ai = mag * s;
            const float den = lr * lr + li * li, fr = ((ar - 1.0f) * lr + ai * li) / den, fi = (ai * lr - (ar - 1.0f) * li) / den;
            const float br = P.b_re[(size_t)g * 1024 + e], bi = P.b_im[(size_t)g * 1024 + e];
            f32x2 v; v.x = fr * br - fi * bi; v.y = fr * bi + fi * br; BB[e] = v;
            f32x2 w; w.x = P.c_re[(size_t)g * 1024 + e]; w.y = P.c_im[(size_t)g * 1024 + e]; CC[e] = w; }
        __syncthreads();
        if (part == 0 && tid < 64) ((f32x2*)(ws + WS_AT))[g * 64 + tid] = APW[32 * 64 + tid];
        {
            const int hh = tid & 255, h = hh >> 4, hp = hh & 15, jl = 2 * (tid >> 8), j0 = 4 * part + jl;
            float k0 = 0.f, k1 = 0.f;
            for (int p = 0; p < 64; ++p) {
                const f32x2 cv = CC[h * 64 + p], bv = BB[p * 16 + hp], w0 = APW[j0 * 64 + p], w1 = APW[(j0 + 1) * 64 + p];
                const float zr = cv.x * bv.x - cv.y * bv.y, zi = cv.x * bv.y + cv.y * bv.x;
                k0 += zr * w0.x - zi * w0.y; k1 += zr * w1.x - zi * w1.y;
            }
            KT[jl * 256 + hh] = k0; KT[(jl + 1) * 256 + hh] = k1;
        }
        __syncthreads();
        bf16* TWg = (bf16*)(ws + WS_TW) + (size_t)g * 512 * 640;
        for (int e = tid; e < 4096; e += 512) {
            const int jj = e >> 10, t = (e >> 5) & 31, h = (e >> 1) & 15, half = e & 1, jx = 4 * part + jj;
            if (t >= jx) { const LAS float* kp = KT + jj * 256 + h * 16 + 8 * half;
                u32x4 w; w.x = cvt_pk_bf16(kp[0], kp[1]); w.y = cvt_pk_bf16(kp[2], kp[3]); w.z = cvt_pk_bf16(kp[4], kp[5]); w.w = cvt_pk_bf16(kp[6], kp[7]);
                *(u32x4*)(TWg + (size_t)(t * 16 + h) * 640 + 128 + (t - jx) * 16 + 8 * half) = w; }
            const int lg = 4 * (7 - part) + jj, s = t + lg;
            if (lg >= 1 && s < 32) *(u32x4*)(TWg + (size_t)(t * 16 + h) * 640 + 128 + s * 16 + 8 * half) = (u32x4){0u, 0u, 0u, 0u};
        }
        for (int e = tid; e < 64 * 16; e += 512) {
            const int rl = e >> 4, c8 = (e & 15) * 8, t = 4 * part + (rl >> 4), h = rl & 15; float v[8];
#pragma unroll
            for (int i = 0; i < 8; ++i) { const int q = c8 + i, p = q & 63; const f32x2 cv = CC[h * 64 + p], wv = APW[(t + 1) * 64 + p];
                v[i] = (q < 64) ? (cv.x * wv.x - cv.y * wv.y) : -(cv.x * wv.y + cv.y * wv.x); }
            u32x4 w; w.x = cvt_pk_bf16(v[0], v[1]); w.y = cvt_pk_bf16(v[2], v[3]); w.z = cvt_pk_bf16(v[4], v[5]); w.w = cvt_pk_bf16(v[6], v[7]);
            *(u32x4*)(TWg + (size_t)(t * 16 + h) * 640 + c8) = w;
        }
        bf16* W1g = (bf16*)(ws + WS_W1) + (size_t)g * 128 * 512;
        for (int e = tid; e < 16 * 64; e += 512) {
            const int q = 16 * part + (e >> 6), c8 = (e & 63) * 8, s = c8 >> 4, hp0 = c8 & 15, p = q & 63; float v[8];
            const f32x2 wv = APW[(31 - s) * 64 + p];
#pragma unroll
            for (int i = 0; i < 8; ++i) { const f32x2 bv = BB[p * 16 + hp0 + i]; v[i] = (q < 64) ? (wv.x * bv.x - wv.y * bv.y) : (wv.x * bv.y + wv.y * bv.x); }
            u32x4 w; w.x = cvt_pk_bf16(v[0], v[1]); w.y = cvt_pk_bf16(v[2], v[3]); w.z = cvt_pk_bf16(v[4], v[5]); w.w = cvt_pk_bf16(v[6], v[7]);
            *(u32x4*)(W1g + (size_t)q * 512 + c8) = w;
        }
        __syncthreads();
    }
    {
        LAS float* scr = (LAS float*)(lds + wave * 16384);
        const int gw = blk * (8 - wave0) + (wave - wave0), NGW = G * (8 - wave0);
        constexpr int I_IN = 16 * 40, I_GLU = 8 * 32, I_OUT = 16 * 32, I_GU = 16 * 176, I_DN = 44 * 32, NIT = I_IN + I_GLU + I_OUT + I_GU + I_DN;
        const int it_lo = (which & 1) ? I_IN : I_IN + I_GLU + I_OUT, it_hi = (which & 2) ? NIT : I_IN + I_GLU + I_OUT;
        for (int it = it_lo + gw; wave >= wave0 && it < it_hi; it += NGW) {
            int r = it;
            if (r < I_IN) { const int nb = r % 40, kb = r / 40; transpose_item(P.w_in, 1024, 1280, (bf16*)(ws + WS_WIN), 32 * nb, 32 * nb, 64 * kb, scr, lane); continue; } r -= I_IN;
            if (r < I_GLU) { const int nb = r % 32, kb = r / 32; transpose_item(P.w_glu, 512, 1024, (bf16*)(ws + WS_WGLU), gated_src_col(32 * nb, 512), 32 * nb, 64 * kb, scr, lane); continue; } r -= I_GLU;
            if (r < I_OUT) { const int nb = r % 32, kb = r / 32; transpose_item(P.w_out, 1024, 1024, (bf16*)(ws + WS_WOUT), 32 * nb, 32 * nb, 64 * kb, scr, lane, kb < 8 ? P.g_ssm_out + 64 * kb : P.g_attn_out + 64 * (kb - 8)); continue; } r -= I_OUT;
            if (r < I_GU) { const int nb = r % 176, kb = r / 176; transpose_item(P.w_gate_up, 1024, 5632, (bf16*)(ws + WS_WGU), gated_src_col(32 * nb, 2816), 32 * nb, 64 * kb, scr, lane, P.g_pre_ffn + 64 * kb); continue; } r -= I_GU;
            { const int nb = r % 32, kb = r / 32; transpose_item(P.w_down, 2816, 1024, (bf16*)(ws + WS_WDN), 32 * nb, 32 * nb, 64 * kb, scr, lane); }
        }
    }
}

__device__ __forceinline__ void prologue_a(const Params& P, LAS unsigned char* lds, int tid, int lane, int wave) {
    unsigned char* ws = P.ws;
    const int G = gridDim.x, blk = blockIdx.x;
    {
        LAS float* scr = (LAS float*)(lds + wave * 16384);
        const int gw = blk * 8 + wave, NGW = G * 8;
        for (int r = gw; r < 16 * 40; r += NGW) { const int nb = r % 40, kb = r / 40; transpose_item(P.w_in, 1024, 1280, (bf16*)(ws + WS_WIN), 32 * nb, 32 * nb, 64 * kb, scr, lane, P.g_pre_mix + 64 * kb); }
        for (int m = gw; m < NTOK; m += NGW) {
            const f32x4* xr = (const f32x4*)(P.x + (size_t)m * DM) + lane; f32x4 v[4]; float s = 0.f;
#pragma unroll
            for (int j = 0; j < 4; ++j) { v[j] = xr[64 * j]; s += (v[j].x * v[j].x + v[j].y * v[j].y) + (v[j].z * v[j].z + v[j].w * v[j].w); }
            const float rstd = 1.0f / sqrtf(wave_sum(s) * (1.0f / DM) + NORM_EPS);
            if (lane == 0) ((float*)(ws + WS_RS0))[m] = rstd;
            u32x2* o8 = (u32x2*)((bf16*)(ws + WS_XN) + (size_t)m * DM) + lane;
#pragma unroll
            for (int j = 0; j < 4; ++j) { u32x2 w; w.x = cvt_pk_bf16(v[j].x, v[j].y); w.y = cvt_pk_bf16(v[j].z, v[j].w); o8[64 * j] = w; }
        }
        for (int e = blk * 512 + tid; e < NTOK; e += G * 512) { ((float*)(ws + WS_RSQ))[e] = 0.f; ((float*)(ws + WS_RSQH))[e] = 0.f; }
    }
}

__device__ __forceinline__ void ssm_pass_a(const Params& P, int lane, int wave) {
    if (wave >= 2) return;
    unsigned char* ws = P.ws;
    for (int unit = wave * 256 + blockIdx.x; unit < 512; unit += 2 * gridDim.x > 512 ? 512 : 2 * gridDim.x) {
        const int g = unit >> 4, b = (unit >> 1) & 7, hs = unit & 1;
        const int r32 = lane & 31, hi = lane >> 5;
        const int sig = 16 * ((r32 >> 2) & 1) + 4 * (r32 >> 3) + (r32 & 3);
        bf16* UXg = (bf16*)(ws + WS_UX) + ((size_t)(g * 512 + b * 64)) * 640;
        const bf16* a0p = UXg + (size_t)sig * 640 + 128 + 8 * hi;
        const bf16* a1p = a0p + (size_t)32 * 640;
        const bf16* W1g = (const bf16*)(ws + WS_W1) + (size_t)g * 128 * 512;
        const bf16* b0p = W1g + (size_t)(32 * hs + r32) * 512 + 8 * hi;
        const bf16* b1p = b0p + (size_t)64 * 512;
        f32x16 acc[2][2];
#pragma unroll
        for (int i = 0; i < 2; ++i)
#pragma unroll
            for (int j = 0; j < 2; ++j)
#pragma unroll
                for (int r = 0; r < 16; ++r) acc[i][j][r] = 0.f;
#pragma unroll 4
        for (int ks = 0; ks < 32; ++ks) {
            const bf16x8 A0 = *(const bf16x8*)(a0p + 16 * ks), A1 = *(const bf16x8*)(a1p + 16 * ks), B0 = *(const bf16x8*)(b0p + 16 * ks), B1 = *(const bf16x8*)(b1p + 16 * ks);
            acc[0][0] = __builtin_amdgcn_mfma_f32_32x32x16_bf16(A0, B0, acc[0][0], 0, 0, 0);
            acc[0][1] = __builtin_amdgcn_mfma_f32_32x32x16_bf16(A0, B1, acc[0][1], 0, 0, 0);
            acc[1][0] = __builtin_amdgcn_mfma_f32_32x32x16_bf16(A1, B0, acc[1][0], 0, 0, 0);
            acc[1][1] = __builtin_amdgcn_mfma_f32_32x32x16_bf16(A1, B1, acc[1][1], 0, 0, 0);
        }
        const int p = 32 * hs + r32;
        const float2 aT = ((const float2*)(ws + WS_AT))[g * 64 + p];
        float er[2], ei[2];
#pragma unroll
        for (int rt = 0; rt < 2; ++rt) { float lr = 0.f, li = 0.f;
#pragma unroll
            for (int r = 0; r < 16; ++r) { const float nr = aT.x * lr - aT.y * li + acc[rt][0][r], ni = aT.x * li + aT.y * lr + acc[rt][1][r]; lr = nr; li = ni; }
            er[rt] = lr; ei[rt] = li; }
        float pr = aT.x, pi = aT.y;
#pragma unroll
        for (int k = 0; k < 4; ++k) { const float nr = pr * pr - pi * pi, ni = 2.f * pr * pi; pr = nr; pi = ni; }
        const float x0r = __shfl_xor(er[0], 32), x0i = __shfl_xor(ei[0], 32);
        const float s0r = hi ? x0r : 0.f, s0i = hi ? x0i : 0.f;
        const float ebr = pr * s0r - pi * s0i + er[0], ebi = pr * s0i + pi * s0r + ei[0];
        const float y0r = __shfl_xor(ebr, 32), y0i = __shfl_xor(ebi, 32);
        const float ecr = pr * y0r - pi * y0i + er[1], eci = pr * y0i + pi * y0r + ei[1];
        const float z0r = __shfl_xor(ecr, 32), z0i = __shfl_xor(eci, 32);
        const float s1r = hi ? z0r : y0r, s1i = hi ? z0i : y0i;
#pragma unroll
        for (int rt = 0; rt < 2; ++rt) { float cr = rt ? s1r : s0r, ci = rt ? s1i : s0i;
            bf16* xo = UXg + (size_t)(32 * rt + 16 * hi) * 640 + p;
#pragma unroll
            for (int r = 0; r < 16; ++r) {
                xo[(size_t)r * 640] = (bf16)(cvt_pk_bf16(cr, 0.f) & 0xffffu); xo[(size_t)r * 640 + 64] = (bf16)(cvt_pk_bf16(ci, 0.f) & 0xffffu);
                const float nr = aT.x * cr - aT.y * ci + acc[rt][0][r], ni = aT.x * ci + aT.y * cr + acc[rt][1][r]; cr = nr; ci = ni; }
        }
    }
}

__device__ __forceinline__ void attn_phase(const Params& P, LAS unsigned char* lds, int tid, int lane, int wave, int unit0, int nunits) {
    unsigned char* ws = P.ws;
    const bf16* Q = (const bf16*)(ws + WS_Q); const bf16* Kb = (const bf16*)(ws + WS_K); const bf16* VT = (const bf16*)(ws + WS_VT); bf16* MG = (bf16*)(ws + WS_MG);
    const int r32 = lane & 31, hi = lane >> 5;
    const int h = wave, hk = h >> 2;
    const float sink2 = P.sinks[h] * LOG2E;
    constexpr int KST = 272, VST = 392, VOFF = 192 * KST;
#pragma unroll 1
    for (int unit = unit0; unit < unit0 + nunits; ++unit) {
        const int b = unit >> 5, l0 = (unit & 31) * 64, tokb = b * SEQL;
        LAS float* rsq = (LAS float*)(lds + 139264);
        if (tid < 64) rsq[tid] = 0.f;
        {
            u32x4 kv[6], vv[6];
#pragma unroll
            for (int i = 0; i < 6; ++i) { const int p = tid + 512 * i, row = p >> 4, c16 = p & 15; int t = l0 - 128 + row; t = t < 0 ? t + 128 : t;
                kv[i] = *(const u32x4*)(Kb + (size_t)(tokb + t) * 128 + c16 * 8); }
#pragma unroll
            for (int i = 0; i < 6; ++i) { const int p = tid + 512 * i, row = p / 24, c = p % 24; int k0 = l0 - 128 + 8 * c; k0 = k0 < 0 ? k0 + 128 : k0;
                vv[i] = *(const u32x4*)(VT + ((size_t)(b * 128 + row)) * SEQL + k0); }
#pragma unroll
            for (int i = 0; i < 6; ++i) { const int p = tid + 512 * i, row = p >> 4, c16 = p & 15; *(LAS u32x4*)(lds + row * KST + c16 * 16) = kv[i]; }
#pragma unroll
            for (int i = 0; i < 6; ++i) { const int p = tid + 512 * i, row = p / 24, c = p % 24; LAS u32x2* d = (LAS u32x2*)(lds + VOFF + row * VST + c * 16);
                u32x2 a, bq; a.x = vv[i].x; a.y = vv[i].y; bq.x = vv[i].z; bq.y = vv[i].w; d[0] = a; d[1] = bq; }
        }
        __syncthreads();
#pragma unroll 1
        for (int sub = 0; sub < 2; ++sub) {
            const int q0 = l0 + 32 * sub;
            bf16x8 qf[4];
#pragma unroll
            for (int ds = 0; ds < 4; ++ds) qf[ds] = *(const bf16x8*)(Q + (size_t)(tokb + q0 + r32) * 512 + h * 64 + 16 * ds + 8 * hi);
            f32x16 s[5];
#pragma unroll
            for (int kt = 0; kt < 5; ++kt) {
#pragma unroll
                for (int r = 0; r < 16; ++r) s[kt][r] = 0.f;
                const LAS unsigned char* kp = lds + (32 * (kt + sub) + r32) * KST + hk * 128 + hi * 16;
#pragma unroll
                for (int ds = 0; ds < 4; ++ds) { const bf16x8 kf = *(const LAS bf16x8*)(kp + ds * 32); s[kt] = __builtin_amdgcn_mfma_f32_32x32x16_bf16(kf, qf[ds], s[kt], 0, 0, 0); }
                if (kt < 4) { const bool dead = (q0 - 128 + 32 * kt) < 0;
#pragma unroll
                    for (int r = 0; r < 16; ++r) s[kt][r] = dead ? -1e30f : s[kt][r]; }
            }
#pragma unroll
            for (int r = 0; r < 16; ++r) { const int cr = crow(r, hi); if (cr <= r32) s[0][r] = -1e30f; if (cr > r32) s[4][r] = -1e30f; }
            float m = sink2;
#pragma unroll
            for (int kt = 0; kt < 5; ++kt)
#pragma unroll
                for (int r = 0; r < 16; ++r) m = fmaxf(m, s[kt][r]);
            m = fmaxf(m, __shfl_xor(m, 32));
            float sum = 0.f;
#pragma unroll
            for (int kt = 0; kt < 5; ++kt)
#pragma unroll
                for (int r = 0; r < 16; ++r) { const float pv = __builtin_amdgcn_exp2f(s[kt][r] - m); s[kt][r] = pv; sum += pv; }
            sum += __shfl_xor(sum, 32);
            const float inv = 1.0f / (sum + __builtin_amdgcn_exp2f(sink2 - m));
            __builtin_amdgcn_sched_barrier(0);
            f32x16 o[2];
#pragma unroll
            for (int r = 0; r < 16; ++r) { o[0][r] = 0.f; o[1][r] = 0.f; }
#pragma unroll
            for (int kt = 0; kt < 5; ++kt) {
#pragma unroll
                for (int ks = 0; ks < 2; ++ks) {
                    u32x4 pw; pw.x = cvt_pk_bf16(s[kt][8 * ks + 0], s[kt][8 * ks + 1]); pw.y = cvt_pk_bf16(s[kt][8 * ks + 2], s[kt][8 * ks + 3]);
                    pw.z = cvt_pk_bf16(s[kt][8 * ks + 4], s[kt][8 * ks + 5]); pw.w = cvt_pk_bf16(s[kt][8 * ks + 6], s[kt][8 * ks + 7]);
                    const bf16x8 pa = __builtin_bit_cast(bf16x8, pw);
#pragma unroll
                    for (int dt = 0; dt < 2; ++dt) {
                        const LAS unsigned char* vp = lds + VOFF + (hk * 64 + 32 * dt + r32) * VST + (32 * (kt + sub) + 16 * ks + 4 * hi) * 2;
                        const u32x2 lo = *(const LAS u32x2*)vp, hi2 = *(const LAS u32x2*)(vp + 16);
                        u32x4 vw; vw.x = lo.x; vw.y = lo.y; vw.z = hi2.x; vw.w = hi2.y;
                        o[dt] = __builtin_amdgcn_mfma_f32_32x32x16_bf16(pa, __builtin_bit_cast(bf16x8, vw), o[dt], 0, 0, 0);
                    }
                }
            }
            {
                LAS unsigned short* stg = (LAS unsigned short*)(lds + 102400 + wave * 4608);
#pragma unroll
                for (int r = 0; r < 16; ++r) { const int cr = crow(r, hi); const float iv = __shfl(inv, cr);
                    stg[cr * 72 + r32] = (unsigned short)(cvt_pk_bf16(o[0][r] * iv, 0.f) & 0xffffu); stg[cr * 72 + 32 + r32] = (unsigned short)(cvt_pk_bf16(o[1][r] * iv, 0.f) & 0xffffu); }
                asm volatile("s_waitcnt lgkmcnt(0)" ::: "memory");
                const int row = lane >> 1, hf = lane & 1; float sq = 0.f;
                bf16* dst = MG + (size_t)(tokb + q0 + row) * 1024 + 512 + h * 64 + hf * 32;
#pragma unroll
                for (int i = 0; i < 4; ++i) { const u32x4 w = *(const LAS u32x4*)(stg + row * 72 + hf * 32 + 8 * i);
                    const float a0 = bf_lo(w.x), a1 = bf_hi(w.x), a2 = bf_lo(w.y), a3 = bf_hi(w.y), a4 = bf_lo(w.z), a5 = bf_hi(w.z), a6 = bf_lo(w.w), a7 = bf_hi(w.w);
                    sq += ((a0 * a0 + a1 * a1) + (a2 * a2 + a3 * a3)) + ((a4 * a4 + a5 * a5) + (a6 * a6 + a7 * a7));
                    *(u32x4*)(dst + 8 * i) = w; }
                sq += __shfl_xor(sq, 1);
                if (hf == 0) __builtin_amdgcn_ds_faddf(rsq + 32 * sub + row, sq, 0, 0, false);
                asm volatile("s_waitcnt lgkmcnt(0)" ::: "memory");
            }
        }
        __syncthreads();
        if (tid < 64) ((float*)(ws + WS_RSQ))[NTOK + tokb + l0 + tid] = rsq[tid];
        __syncthreads();
    }
}

#define XB_TMO      128
#define XB_XCNT(j)  (256  + 64 * (j))
#define XB_XSUB(j)  (1280 + 64 * (j))
#define XB_XGEN(j)  (2304 + 64 * (j))
#define XB_TOP      3328
#define XB_TOPGEN   3392
#define XCD_BAR_WORDS 3456
#define XB_SPIN_CAP (1u << 18)

__device__ __forceinline__ unsigned xb_ld(unsigned* p)              { return __hip_atomic_load(p, __ATOMIC_RELAXED, __HIP_MEMORY_SCOPE_AGENT); }
__device__ __forceinline__ unsigned xb_add(unsigned* p, unsigned v) { return __hip_atomic_fetch_add(p, v, __ATOMIC_RELAXED, __HIP_MEMORY_SCOPE_AGENT); }
__device__ __forceinline__ unsigned xb_xcc_id() { return (unsigned)__builtin_amdgcn_s_getreg((3 << 11) | 20) & 0xFu; }
#define XB_SPIN(cond, bar) do { unsigned _sp = 0; while (cond) { __builtin_amdgcn_s_sleep(1); \
    if ((++_sp & 255u) == 0u) { if (xb_ld(&(bar)[XB_TMO])) break; if (_sp > XB_SPIN_CAP) { atomicAdd(&(bar)[XB_TMO], 1u); break; } } } } while (0)

struct XcdBarrier {
    unsigned* bar; unsigned x;
    volatile LAS unsigned* st;
};

__device__ __forceinline__ XcdBarrier xcd_barrier_post(unsigned* bar, volatile LAS unsigned* st) {
    XcdBarrier b; b.bar = bar; b.x = xb_xcc_id(); b.st = st;
    if (threadIdx.x == 0) (void)xb_add(&bar[XB_XCNT(b.x)], 1u);
    return b;
}
__device__ __forceinline__ void xcd_barrier_complete(unsigned* bar, unsigned x, unsigned& nloc, unsigned& nx) {
    const unsigned G = gridDim.x * gridDim.y * gridDim.z;
    unsigned sum, cnt, mine, sp = 0u;
    for (;;) {
        sum = 0u; cnt = 0u; mine = 0u;
#pragma unroll
        for (unsigned j = 0; j < 16; ++j) { const unsigned c = xb_ld(&bar[XB_XCNT(j)]); sum += c; cnt += (c > 0u) ? 1u : 0u; mine = (j == x) ? c : mine; }
        if (sum == G) break;
        __builtin_amdgcn_s_sleep(1);
        if ((++sp & 255u) == 0u) { if (xb_ld(&bar[XB_TMO])) break; if (sp > XB_SPIN_CAP) { atomicAdd(&bar[XB_TMO], 1u); break; } }
    }
    nloc = mine > 0u ? mine : 1u; nx = cnt > 0u ? cnt : 1u;
}

__device__ __forceinline__ void xcd_barrier(const XcdBarrier& b) {
    asm volatile("s_waitcnt vmcnt(0)" ::: "memory");
    __syncthreads();
    if (threadIdx.x == 0) {
        unsigned* bar = b.bar;
        __builtin_amdgcn_s_waitcnt(0);
        unsigned nloc = b.st[0], nx = b.st[1];
        if (nloc == 0u) { xcd_barrier_complete(bar, b.x, nloc, nx); b.st[0] = nloc; b.st[1] = nx; }
        const unsigned old = xb_add(&bar[XB_XSUB(b.x)], 1u);
        const unsigned gen = old / nloc;
        if (old + 1u == (gen + 1u) * nloc) {
            __builtin_amdgcn_fence(__ATOMIC_RELEASE, "agent");
            asm volatile("s_waitcnt vmcnt(0)" ::: "memory");
            const unsigned og = xb_add(&bar[XB_TOP], 1u);
            const unsigned tg = og / nx;
            if (og + 1u == (tg + 1u) * nx) xb_add(&bar[XB_TOPGEN], 1u);
            else XB_SPIN(xb_ld(&bar[XB_TOPGEN]) == tg, bar);
            __builtin_amdgcn_fence(__ATOMIC_ACQUIRE, "agent");
            xb_add(&bar[XB_XGEN(b.x)], 1u);
            asm volatile("s_waitcnt vmcnt(0)" ::: "memory");
        } else {
            XB_SPIN(xb_ld(&bar[XB_XGEN(b.x)]) == gen, bar);
            __builtin_amdgcn_fence(__ATOMIC_ACQUIRE, "agent");
            asm volatile("s_waitcnt vmcnt(0)" ::: "memory");
        }
    }
    __syncthreads();
}

__device__ __forceinline__ void quad_sync(unsigned* cnt, unsigned target, bool fast) {
    asm volatile("s_waitcnt vmcnt(0)" ::: "memory");
    __syncthreads();
    if (threadIdx.x == 0) {
        if (!fast) { __builtin_amdgcn_fence(__ATOMIC_RELEASE, "agent"); asm volatile("s_waitcnt vmcnt(0)" ::: "memory"); }
        (void)xb_add(cnt, 1u);
        unsigned sp = 0u; while (xb_ld(cnt) < target) { __builtin_amdgcn_s_sleep(1); if (++sp > (1u << 22)) break; }
        __builtin_amdgcn_fence(__ATOMIC_ACQUIRE, "agent");
        asm volatile("s_waitcnt vmcnt(0)" ::: "memory");
    }
    __syncthreads();
}

__global__ void __launch_bounds__(512, 2) fwd_megakernel(Params P) {
    extern __shared__ __attribute__((aligned(16))) unsigned char lds_raw[];
    LAS unsigned char* lds = (LAS unsigned char*)lds_raw;
    cg::grid_group grid = cg::this_grid();
    const int tid = threadIdx.x, lane = tid & 63, wave = __builtin_amdgcn_readfirstlane(tid >> 6);
    const int G = gridDim.x, blk = blockIdx.x;
    unsigned char* ws = P.ws;
    typedef pg8::bf16_t bt;

    if (tid < 4) ((LAS unsigned*)(lds + LDSCTL_OFF))[tid] = 0u;
    __syncthreads();
    const XcdBarrier bar = xcd_barrier_post((unsigned*)(ws + WS_BAR), (volatile LAS unsigned*)(lds + LDSCTL_OFF));
    if (tid == 0) __hip_atomic_store((unsigned*)(ws + WS_XT) + blk, bar.x, __ATOMIC_RELAXED, __HIP_MEMORY_SCOPE_AGENT);
    prologue_a(P, lds, tid, lane, wave);
    if (P.ws == nullptr) grid.sync();
    xcd_barrier(bar);
    {
        pg8::Gemm g{(const bt*)(ws + WS_XN), (const bt*)(ws + WS_WIN), NTOK, INW, DM, DM, DM}; pg8::StaticOrder S; S.init(NTOK, INW, G, blk);
        pg8::EpiInProj E{(bt*)(ws + WS_UX), (bt*)(ws + WS_Q), (bt*)(ws + WS_K), (bt*)(ws + WS_VT), P.pos, (const float*)(ws + WS_RS0)};
        pg8::gemm_phase<pg8::EpiInProj, pg8::StaticOrder, true, true>(lds, g, S, E);
    }
    if (G == 256) { if (blk >= 64) prologue_b(P, lds, tid, lane, wave, blk - 64, 192, 1); } else prologue_b(P, lds, tid, lane, wave, blk, G, 3);
    xcd_barrier(bar);
    ssm_pass_a(P, lane, wave);
    prologue_b(P, lds, tid, lane, wave, blk, G, 2, 2);
    xcd_barrier(bar);
    {
        pg8::Gemm g{(const bt*)(ws + WS_UX), (const bt*)(ws + WS_TW), NGRP * GROWS, NGRP * 512, KX, KX, KX}; pg8::SsmOrder S{blk};
        pg8::EpiSsmC E{(const bt*)(ws + WS_UX), P.ssm_d, (bt*)(ws + WS_Y)};
        pg8::gemm_phase<pg8::EpiSsmC, pg8::SsmOrder, true, true>(lds, g, S, E);
        if (G == 256) { if (blk >= 128) attn_phase(P, lds, tid, lane, wave, (blk - 128) * 2, 2); }
        else for (int u = blk; u < 256; u += G) attn_phase(P, lds, tid, lane, wave, u, 1);
    }
    xcd_barrier(bar);
    const bool quads = (G == 256);
    bool qfast = false; unsigned* qcnt = (unsigned*)(ws + WS_CNT) + 4096;
    if (quads) { const int x = blk & 7, p = (blk >> 3) & 7; unsigned* xt = (unsigned*)(ws + WS_XT);
        const unsigned x0 = xb_ld(xt + x + 8 * p), x1 = xb_ld(xt + x + 8 * (p + 8)), x2 = xb_ld(xt + x + 8 * (p + 16)), x3 = xb_ld(xt + x + 8 * (p + 24));
        qfast = (x0 == x1) && (x1 == x2) && (x2 == x3); qcnt += 64 * (8 * x + p); }
    {
        pg8::Gemm g{(const bt*)(ws + WS_Y), (const bt*)(ws + WS_WGLU), NTOK, 1024, 512, 512, 512}; pg8::StaticOrder S; S.init(NTOK, 1024, G, blk);
        pg8::EpiGated<0> E{(bt*)(ws + WS_MG), 1024, P.b_glu, (float*)(ws + WS_RSQ)};
        pg8::gemm_phase<pg8::EpiGated<0>, pg8::StaticOrder, true, true>(lds, g, S, E);
    }
    if (quads) quad_sync(qcnt, 4u, qfast); else xcd_barrier(bar);
    {
        pg8::Gemm g{(const bt*)(ws + WS_MG), (const bt*)(ws + WS_WOUT), NTOK, DM, DM, DM, DM}; pg8::StaticOrder S; S.init(NTOK, DM, G, blk);
        pg8::PanelSq st1{(float*)(ws + WS_XB), (unsigned*)(ws + WS_CNT), NORM_EPS};
        LAS float* tab = (LAS float*)(lds + LDSCTL_OFF + 64);
        { pg8::Unit u0; if (S.next(0, u0) && tid < 256) { const int row = u0.pm * 256 + tid; const float sa = ((const float*)(ws + WS_RSQ))[row] * (1.0f / 512.0f) + NORM_EPS, sb = ((const float*)(ws + WS_RSQ))[NTOK + row] * (1.0f / 512.0f) + NORM_EPS;
            tab[tid] = sqrtf(sb / sa); tab[256 + tid] = 1.0f / sqrtf(sb); } }
        __syncthreads();
        pg8::EpiNormResNorm E{(const bt*)(ws + WS_XN), (bt*)(ws + WS_HB), (float*)(ws + WS_RSQH), P.g_post_mix, st1, tab, 8};
        pg8::gemm_phase<pg8::EpiNormResNorm, pg8::StaticOrder, false, true>(lds, g, S, E);
    }
    if (quads) quad_sync(qcnt, 8u, qfast); else xcd_barrier(bar);
    {
        pg8::Gemm g{(const bt*)(ws + WS_HB), (const bt*)(ws + WS_WGU), NTOK, 2 * DFF, DM, DM, DM}; pg8::StaticOrder S; S.init(NTOK, 2 * DFF, G, blk);
        pg8::EpiGated<1> E{(bt*)(ws + WS_ACT), DFF, nullptr, (float*)(ws + WS_RSQH)};
        pg8::gemm_phase<pg8::EpiGated<1>, pg8::StaticOrder, true, true>(lds, g, S, E);
    }
    if (quads) quad_sync(qcnt, 12u, qfast); else xcd_barrier(bar);
    {
        pg8::Gemm g{(const bt*)(ws + WS_ACT), (const bt*)(ws + WS_WDN), NTOK, DM, DFF, DFF, DFF}; pg8::StaticOrder S; S.init(NTOK, DM, G, blk);
        pg8::PanelSq st{(float*)(ws + WS_XB) + 2 * NTOK * 4, (unsigned*)(ws + WS_CNT) + 2 * 4096, NORM_EPS};
        pg8::EpiNormRes E{(const bt*)(ws + WS_HB), P.out, P.g_post_ffn, st};
        pg8::gemm_phase<pg8::EpiNormRes, pg8::StaticOrder, false, true>(lds, g, S, E);
    }
}

extern "C" void kernel_launch(void* const* d_in, const int* in_sizes, int n_in, void* d_out, int out_size, void* d_ws, size_t ws_size, hipStream_t stream) {
    static int grid_blocks = 0;
    if (grid_blocks == 0) {
        int dev = 0, cus = 0, per_cu = 0;
        hipGetDevice(&dev);
        hipDeviceGetAttribute(&cus, hipDeviceAttributeMultiprocessorCount, dev);
        hipFuncSetAttribute((const void*)fwd_megakernel, hipFuncAttributeMaxDynamicSharedMemorySize, LDS_BYTES);
        hipOccupancyMaxActiveBlocksPerMultiprocessor(&per_cu, (const void*)fwd_megakernel, 512, LDS_BYTES);
        if (per_cu < 1) { fprintf(stderr, "kernel_launch: occupancy query reports %d blocks per CU\n", per_cu); per_cu = 1; }
        grid_blocks = cus * 1;
        (void)hipGetLastError();
    }
    Params p{};
    p.x = (const float*)d_in[0]; p.pos = (const int*)d_in[1]; p.g_pre_mix = (const float*)d_in[2]; p.w_in = (const float*)d_in[3]; p.lam_re = (const float*)d_in[4]; p.lam_im = (const float*)d_in[5];
    p.log_dt = (const float*)d_in[6]; p.b_re = (const float*)d_in[7]; p.b_im = (const float*)d_in[8]; p.c_re = (const float*)d_in[9]; p.c_im = (const float*)d_in[10]; p.ssm_d = (const float*)d_in[11];
    p.w_glu = (const float*)d_in[12]; p.b_glu = (const float*)d_in[13]; p.sinks = (const float*)d_in[14]; p.g_ssm_out = (const float*)d_in[15]; p.g_attn_out = (const float*)d_in[16]; p.w_out = (const float*)d_in[17];
    p.g_post_mix = (const float*)d_in[18]; p.g_pre_ffn = (const float*)d_in[19]; p.w_gate_up = (const float*)d_in[20]; p.w_down = (const float*)d_in[21]; p.g_post_ffn = (const float*)d_in[22];
    p.out = (float*)d_out; p.ws = (unsigned char*)d_ws;
    (void)hipMemsetAsync(d_ws, 0, 65536, stream);
    void* args[] = {&p};
    hipError_t e = hipLaunchCooperativeKernel((const void*)fwd_megakernel, dim3(grid_blocks), dim3(512), args, LDS_BYTES, stream);
    if (e != hipSuccess) fprintf(stderr, "cooperative launch failed: %s (grid %d)\n", hipGetErrorString(e), grid_blocks);
}
```

```cpp
#include <hip/hip_runtime.h>
#include <hip/hip_cooperative_groups.h>
#include <cstdio>
#include <cstdint>
namespace cg = cooperative_groups;
namespace pg8 {
#define PG8_LAS __attribute__((address_space(3)))
typedef unsigned short bf16_t;
typedef short bf16x8 __attribute__((ext_vector_type(8)));
typedef float f32x4 __attribute__((ext_vector_type(4)));
typedef unsigned u32x4 __attribute__((ext_vector_type(4)));
constexpr int BM = 256, BK = 64, HALF = 128, HTB = HALF * BK * 2  , STAGE_BYTES = 8 * HTB, NXCD = 8, WGM = 8;

__host__ __device__ __forceinline__ int lds_byte(int r, int c) { const int st = (r >> 4) * 2 + (c >> 5), rr = r & 15, cc = c & 31, ob = rr * 64 + cc * 2; return st * 1024 + (ob ^ (((ob >> 9) & 1) << 5)); }
__host__ __device__ __forceinline__ void stage_rc(int b, int& R, int& C) { const int st = b / 1024, sb = b % 1024, swz = sb ^ (((sb >> 9) & 1) << 5); R = (st >> 1) * 16 + swz / 64; C = (st & 1) * 32 + (swz % 64) / 2; }
__host__ __device__ __forceinline__ int perm32(int rho) { const int n = rho >> 4, i = rho & 15; return 8 * (i >> 2) + 4 * n + (i & 3); }

struct Unit { int pm, pn; };
struct Gemm { const bf16_t* A; const bf16_t* Bt; int M, N, K, lda, ldb; };

struct StaticOrder {
    int nM, nN, nwg, G, c;
    __host__ __device__ void init(int M, int N, int G_, int c_) { nM = M / BM; nN = N / BM; nwg = nM * nN; G = G_; c = c_; }
    __host__ __device__ bool next(int i, Unit& u) const {
        const long L = (long)i * G + c; if (L >= nwg) return false;
        int wgid = (int)L; { const int q = nwg / NXCD, r = nwg % NXCD, xcd = wgid % NXCD, off = wgid / NXCD; wgid = (xcd < r ? xcd * (q + 1) : r * (q + 1) + (xcd - r) * q) + off; }
        const int nig = WGM * nN, gid = wgid / nig, fm = gid * WGM, gsz = (nM - fm) < WGM ? (nM - fm) : WGM;
        u.pm = fm + ((wgid % nig) % gsz); u.pn = (wgid % nig) / gsz; return true;
    }
    __device__ __forceinline__ void a_ready(const Unit&) const {}
    __device__ __forceinline__ void done(const Unit&) const {}
};

__device__ __forceinline__ unsigned cvt_pk_bf16(float lo, float hi) { unsigned r; asm volatile("v_cvt_pk_bf16_f32 %0, %1, %2" : "=v"(r) : "v"(lo), "v"(hi)); return r; }
template <class Epi, class Sched, bool ALIGN_EPI = false, bool SP2 = false>
__device__ __forceinline__ void gemm_phase(PG8_LAS unsigned char* lds, const Gemm g, const Sched& S, const Epi& E) {
    const int tid = threadIdx.x, wid = __builtin_amdgcn_readfirstlane(tid >> 6), lane = tid & 63, wr = wid >> 2, wc = wid & 3, fr = lane & 15, fq = lane >> 4;
    const int K = g.K, nt = K / BK;
    unsigned voffA[2], voffB[2];
#pragma unroll
    for (int i = 0; i < 2; ++i) { int R, C; stage_rc(tid * 16 + i * 8192, R, C); const int Rb = Epi::PERM ? ((R & ~31) + perm32(R & 31)) : R;
        voffA[i] = (unsigned)(R * g.lda + C) * 2u; voffB[i] = (unsigned)(Rb * g.ldb + C) * 2u; }
    const size_t kstep = (size_t)(BK * 2);
    const size_t hstepA = (size_t)HALF * g.lda * 2, hstepB = (size_t)HALF * g.ldb * 2;
    const size_t tstepA = 2 * hstepA, tstepB = 2 * hstepB;
    const unsigned ldsw = (unsigned)wid * 1024u;
    const int aoff = lds_byte(wr * 64 + fr, fq * 8), boff = lds_byte(wc * 32 + fr, fq * 8);
#define PG8_SA(b, h) (((b) * 2 + (h)) * HTB)
#define PG8_SB(b, h) ((4 + (b) * 2 + (h)) * HTB)
#define PG8_STAGE(bufoff, gbase, voff) do { _Pragma("unroll") for (int _i = 0; _i < 2; ++_i) \
        __builtin_amdgcn_global_load_lds((const unsigned*)((const char*)(gbase) + (voff)[_i]), (PG8_LAS unsigned*)(lds + (bufoff) + ldsw + _i * 8192), 16, 0, 0); } while (0)
#define PG8_LDA(dst, b, h) do { _Pragma("unroll") for (int m = 0; m < 4; ++m) _Pragma("unroll") for (int k = 0; k < 2; ++k) dst[m][k] = *(const PG8_LAS bf16x8*)(lds + PG8_SA(b, h) + aoff + m * 2048 + k * 1024); } while (0)
#define PG8_LDB(dst, b, h) do { _Pragma("unroll") for (int n = 0; n < 2; ++n) _Pragma("unroll") for (int k = 0; k < 2; ++k) dst[n][k] = *(const PG8_LAS bf16x8*)(lds + PG8_SB(b, h) + boff + n * 2048 + k * 1024); } while (0)
#define PG8_MMA(ai, bj, At, Bt) do { __builtin_amdgcn_s_setprio(1); _Pragma("unroll") for (int m = 0; m < 4; ++m) _Pragma("unroll") for (int n = 0; n < 2; ++n) _Pragma("unroll") for (int k = 0; k < 2; ++k) \
        acc[ai][bj][m][n] = __builtin_amdgcn_mfma_f32_16x16x32_bf16(Bt[n][k], At[m][k], acc[ai][bj][m][n], 0, 0, 0); __builtin_amdgcn_s_setprio(0); } while (0)
#define PG8_WAIT_V(n) asm volatile("s_waitcnt vmcnt(" #n ")" ::: "memory")
#define PG8_WAIT_L(n) asm volatile("s_waitcnt lgkmcnt(" #n ")" ::: "memory")
#define PG8_BAR __builtin_amdgcn_s_barrier()
#define PG8_SCHED __builtin_amdgcn_sched_barrier(0)
    Unit cur, nxt; int ui = 0;
    if (!S.next(0, cur)) return;
    f32x4 acc[2][2][4][2];
#pragma unroll
    for (int a = 0; a < 2; ++a)
#pragma unroll
        for (int b = 0; b < 2; ++b)
#pragma unroll
            for (int m = 0; m < 4; ++m)
#pragma unroll
                for (int n = 0; n < 2; ++n) acc[a][b][m][n] = (f32x4){0.f, 0.f, 0.f, 0.f};
    bf16x8 At[4][2], B0[2][2], B1[2][2];
    const char* cA = (const char*)g.A + (size_t)cur.pm * tstepA; const char* cB = (const char*)g.Bt + (size_t)cur.pn * tstepB;
    S.a_ready(cur);
    if constexpr (SP2) {
        PG8_STAGE(PG8_SB(0, 0), cB, voffB); PG8_STAGE(PG8_SB(0, 1), cB + hstepB, voffB); PG8_STAGE(PG8_SA(0, 0), cA, voffA); PG8_STAGE(PG8_SA(0, 1), cA + hstepA, voffA);
        if (wr == 1) PG8_BAR;
        PG8_WAIT_V(2); PG8_BAR;
        PG8_STAGE(PG8_SB(1, 0), cB + kstep, voffB); PG8_STAGE(PG8_SA(1, 0), cA + kstep, voffA); PG8_STAGE(PG8_SB(1, 1), cB + hstepB + kstep, voffB);
        PG8_WAIT_V(6); PG8_BAR;
    } else {
        PG8_STAGE(PG8_SB(0, 0), cB, voffB); PG8_STAGE(PG8_SA(0, 0), cA, voffA); PG8_STAGE(PG8_SB(0, 1), cB + hstepB, voffB); PG8_STAGE(PG8_SA(0, 1), cA + hstepA, voffA);
        if (wr == 1) PG8_BAR;
        PG8_WAIT_V(4); PG8_BAR;
        PG8_STAGE(PG8_SB(1, 0), cB + kstep, voffB); PG8_STAGE(PG8_SA(1, 0), cA + kstep, voffA); PG8_STAGE(PG8_SB(1, 1), cB + hstepB + kstep, voffB);
        PG8_WAIT_V(6); PG8_BAR;
    }
    for (;;) {
        const bool has_next = S.next(ui + 1, nxt);
        const char* nA = has_next ? (const char*)g.A + (size_t)nxt.pm * tstepA : cA; const char* nB = has_next ? (const char*)g.Bt + (size_t)nxt.pn * tstepB : cB;
        for (int t = 0; t < nt; t += 2) {
            if constexpr (Epi::HAS_MID) { if (t == E.kmid) E.mid(acc, cur, wr, wc, fr, fq); }
            const bool last = (t == nt - 2);
            const char* a1 = cA + (size_t)(t + 1) * kstep;
            const char* a2 = last ? nA : cA + (size_t)(t + 2) * kstep; const char* b2 = last ? nB : cB + (size_t)(t + 2) * kstep;
            const char* a3 = a2 + kstep; const char* b3 = b2 + kstep;
            if (last && has_next) S.a_ready(nxt);
            if constexpr (SP2) {
            PG8_LDB(B0, 0, 0); PG8_LDB(B1, 0, 1); PG8_SCHED; PG8_LDA(At, 0, 0); PG8_STAGE(PG8_SA(1, 1), a1 + hstepA, voffA);
            PG8_WAIT_V(8); PG8_WAIT_L(0); PG8_BAR; PG8_MMA(0, 0, At, B0); PG8_MMA(0, 1, At, B1); PG8_BAR; PG8_SCHED;
            PG8_LDA(At, 0, 1); PG8_STAGE(PG8_SB(0, 0), b2, voffB); PG8_STAGE(PG8_SB(0, 1), b2 + hstepB, voffB); PG8_STAGE(PG8_SA(0, 0), a2, voffA);
            PG8_WAIT_V(8); PG8_WAIT_L(0); PG8_BAR; PG8_MMA(1, 0, At, B0); PG8_MMA(1, 1, At, B1); PG8_BAR; PG8_SCHED;
            PG8_LDB(B0, 1, 0); PG8_LDB(B1, 1, 1); PG8_SCHED; PG8_LDA(At, 1, 0); PG8_STAGE(PG8_SA(0, 1), a2 + hstepA, voffA);
            PG8_WAIT_V(8); PG8_WAIT_L(0); PG8_BAR; PG8_MMA(0, 0, At, B0); PG8_MMA(0, 1, At, B1); PG8_BAR; PG8_SCHED;
            PG8_LDA(At, 1, 1); PG8_STAGE(PG8_SB(1, 0), b3, voffB); PG8_STAGE(PG8_SB(1, 1), b3 + hstepB, voffB); PG8_STAGE(PG8_SA(1, 0), a3, voffA);
            PG8_WAIT_V(8); PG8_WAIT_L(0); PG8_BAR; PG8_MMA(1, 0, At, B0); PG8_MMA(1, 1, At, B1); PG8_BAR; PG8_SCHED;
            } else {
            PG8_LDB(B0, 0, 0); PG8_SCHED; PG8_LDA(At, 0, 0); PG8_STAGE(PG8_SA(1, 1), a1 + hstepA, voffA);
            PG8_WAIT_L(8); PG8_BAR; PG8_WAIT_L(0); PG8_MMA(0, 0, At, B0); PG8_BAR; PG8_SCHED;
            PG8_LDB(B1, 0, 1); PG8_STAGE(PG8_SB(0, 0), b2, voffB);
            PG8_BAR; PG8_WAIT_L(0); PG8_MMA(0, 1, At, B1); PG8_BAR;
            PG8_LDA(At, 0, 1); PG8_STAGE(PG8_SA(0, 0), a2, voffA);
            PG8_BAR; PG8_WAIT_L(0); PG8_MMA(1, 0, At, B0); PG8_BAR; PG8_SCHED;
            PG8_STAGE(PG8_SB(0, 1), b2 + hstepB, voffB);
            PG8_WAIT_V(6); PG8_BAR; PG8_MMA(1, 1, At, B1); PG8_BAR;
            PG8_LDB(B0, 1, 0); PG8_SCHED; PG8_LDA(At, 1, 0); PG8_STAGE(PG8_SA(0, 1), a2 + hstepA, voffA);
            PG8_WAIT_L(8); PG8_BAR; PG8_WAIT_L(0); PG8_MMA(0, 0, At, B0); PG8_BAR; PG8_SCHED;
            PG8_LDB(B1, 1, 1); PG8_STAGE(PG8_SB(1, 0), b3, voffB);
            PG8_BAR; PG8_WAIT_L(0); PG8_MMA(0, 1, At, B1); PG8_BAR;
            PG8_LDA(At, 1, 1); PG8_STAGE(PG8_SA(1, 0), a3, voffA);
            PG8_BAR; PG8_WAIT_L(0); PG8_MMA(1, 0, At, B0); PG8_BAR; PG8_SCHED;
            PG8_STAGE(PG8_SB(1, 1), b3 + hstepB, voffB);
            PG8_WAIT_V(6); PG8_BAR; PG8_MMA(1, 1, At, B1); PG8_BAR;
            }
        }
        if constexpr (ALIGN_EPI) { if (wr == 0) PG8_BAR; }
        if constexpr (!Epi::AFTER_DRAIN) { E(acc, cur, wr, wc, fr, fq); S.done(cur); }
        if (!has_next) break;
#pragma unroll
        for (int a = 0; a < 2; ++a)
#pragma unroll
            for (int b = 0; b < 2; ++b)
#pragma unroll
                for (int m = 0; m < 4; ++m)
#pragma unroll
                    for (int n = 0; n < 2; ++n) acc[a][b][m][n] = (f32x4){0.f, 0.f, 0.f, 0.f};
        cur = nxt; cA = nA; cB = nB; ++ui;
        if constexpr (ALIGN_EPI) { if (wr == 1) PG8_BAR; }
    }
    PG8_WAIT_V(0);
    if constexpr (!ALIGN_EPI) { if (wr == 0) PG8_BAR; }
    PG8_BAR;
    if constexpr (Epi::AFTER_DRAIN) { E.fused(acc, cur, wr, wc, fr, fq, lds, wid, lane); S.done(cur); }
#undef PG8_SA
#undef PG8_SB
#undef PG8_STAGE
#undef PG8_LDA
#undef PG8_LDB
#undef PG8_MMA
#undef PG8_WAIT_V
#undef PG8_WAIT_L
#undef PG8_BAR
#undef PG8_SCHED
}
}

constexpr int NTOK = 16384, DM = 1024, INW = 1280, SSMW = 512, NGRP = 32, NST = 64, SEQL = 2048, NBATCH = 8, DFF = 2816;
constexpr int TCH = 32, NCH = SEQL / TCH  , GROWS = NBATCH * NCH  , KX = 128 + TCH * 16  ;
constexpr size_t MiB = 1u << 20;
constexpr size_t WS_BAR = 0;
constexpr size_t WS_CNT = 16384;
constexpr size_t WS_XB = 65536;
constexpr size_t WS_RSQ = 896 * 1024;
constexpr size_t WS_RS0 = 1 * MiB + 65536;
constexpr size_t WS_XT = 1 * MiB + 131072;
constexpr size_t WS_RSQH = 1 * MiB;
constexpr size_t WS_WIN = 2 * MiB, WS_WGLU = 5 * MiB, WS_WOUT = 6 * MiB, WS_WGU = 8 * MiB, WS_WDN = 19 * MiB;
constexpr size_t WS_TW = 25 * MiB;
constexpr size_t WS_W1 = 45 * MiB;
constexpr size_t WS_AT = 49 * MiB;
constexpr size_t WS_XN = 50 * MiB;
constexpr size_t WS_UX = 162 * MiB;
constexpr size_t WS_Q = 182 * MiB, WS_K = 198 * MiB, WS_VT = 202 * MiB;
constexpr size_t WS_Y = 82 * MiB;
constexpr size_t WS_MG = 98 * MiB;
constexpr size_t WS_ACT = 162 * MiB;
constexpr size_t WS_HB = 130 * MiB;
constexpr size_t WS_END = 250 * MiB;
constexpr int LDS_BYTES = 147456, LDSCTL_OFF = 143360;
constexpr float NORM_EPS = 1e-6f;
constexpr float LOG2E = 1.4426950408889634f;

#define LAS __attribute__((address_space(3)))
typedef unsigned short bf16;
typedef float f32x4 __attribute__((ext_vector_type(4)));
typedef float f32x16 __attribute__((ext_vector_type(16)));
typedef unsigned u32x4 __attribute__((ext_vector_type(4)));
typedef unsigned u32x2 __attribute__((ext_vector_type(2)));
typedef float f32x2 __attribute__((ext_vector_type(2)));
typedef short bf16x8 __attribute__((ext_vector_type(8)));
using pg8::cvt_pk_bf16;

__device__ __forceinline__ float bf_lo(unsigned w) { return __uint_as_float(w << 16); }
__device__ __forceinline__ float bf_hi(unsigned w) { return __uint_as_float(w & 0xffff0000u); }
__device__ __forceinline__ float fast_sigmoid(float x) { return __builtin_amdgcn_rcpf(1.0f + __builtin_amdgcn_exp2f(-x * LOG2E)); }
__device__ __forceinline__ float gelu_tanh(float x) { const float u = 1.5957691216057308f * (x + 0.044715f * x * x * x); return x * fast_sigmoid(u); }
__device__ __forceinline__ float wave_sum(float v) {
#pragma unroll
    for (int o = 1; o < 64; o <<= 1) v += __shfl_xor(v, o);
    return v;
}
__device__ __forceinline__ int crow(int r, int hi) { return (r & 3) + 8 * (r >> 2) + 4 * hi; }

struct Params {
    const float* x; const int* pos; const float* g_pre_mix; const float* w_in; const float* lam_re; const float* lam_im; const float* log_dt;
    const float* b_re; const float* b_im; const float* c_re; const float* c_im; const float* ssm_d; const float* w_glu; const float* b_glu; const float* sinks;
    const float* g_ssm_out; const float* g_attn_out; const float* w_out; const float* g_post_mix; const float* g_pre_ffn; const float* w_gate_up; const float* w_down; const float* g_post_ffn;
    float* out; unsigned char* ws;
};

namespace pg8 {
struct EpiInProj {
    static constexpr bool PERM = true, AFTER_DRAIN = false, HAS_MID = false;
    bf16_t* UX; bf16_t* Q; bf16_t* Kb; bf16_t* VT; const int* pos; const float* rs0;
    __device__ __forceinline__ void operator()(const f32x4 (&acc_)[2][2][4][2], const Unit& u, int wr, int wc, int fr, int fq) const {
        const int row0 = u.pm * BM + wr * 64 + fr;
        f32x4 acc[2][2][4][2];
#pragma unroll
        for (int ai = 0; ai < 2; ++ai)
#pragma unroll
            for (int m = 0; m < 4; ++m) { const float r = rs0[row0 + ai * HALF + m * 16];
#pragma unroll
                for (int bj = 0; bj < 2; ++bj)
#pragma unroll
                    for (int n = 0; n < 2; ++n) acc[ai][bj][m][n] = acc_[ai][bj][m][n] * r; }
        if (u.pn < 2) {
#pragma unroll
            for (int ai = 0; ai < 2; ++ai)
#pragma unroll
                for (int m = 0; m < 4; ++m) { const int tok = row0 + ai * HALF + m * 16;
#pragma unroll
                    for (int bj = 0; bj < 2; ++bj) { const int g = u.pn * 16 + bj * 8 + wc * 2 + (fq >> 1), h0 = 8 * (fq & 1);
                        bf16_t* dst = UX + ((size_t)(g * 512 + (tok >> 5))) * 640 + 128 + (tok & 31) * 16 + h0;
                        const f32x4 v0 = acc[ai][bj][m][0], v1 = acc[ai][bj][m][1]; u32x4 w;
                        w.x = cvt_pk_bf16(v0[0], v0[1]); w.y = cvt_pk_bf16(v0[2], v0[3]); w.z = cvt_pk_bf16(v1[0], v1[1]); w.w = cvt_pk_bf16(v1[2], v1[3]);
                        *(u32x4*)dst = w; } }
        } else {
            const bool isq = u.pn < 4; const bool dorope = (wc & 1) == 0;
            const float qs = 0.125f * 1.4426950408889634f;
#pragma unroll
            for (int ai = 0; ai < 2; ++ai)
#pragma unroll
                for (int m = 0; m < 4; ++m) { const int tok = row0 + ai * HALF + m * 16;
                    float cs0[4], sn0[4], cs1[4], sn1[4];
                    if (dorope) { const float pf = (float)pos[tok];
                        constexpr float IFR[8] = {0.15915494309189535f, 0.03086376340470123f, 0.005985185712713705f, 0.001160663641240061f, 0.00022507907903927653f, 4.364795279280289e-05f, 8.464330808241401e-06f, 1.6414262627950345e-06f};
#pragma unroll
                        for (int j = 0; j < 4; ++j) { const float r0 = __builtin_amdgcn_fractf(pf * IFR[j]), r1 = __builtin_amdgcn_fractf(pf * IFR[4 + j]);
                            cs0[j] = __builtin_amdgcn_cosf(r0); sn0[j] = __builtin_amdgcn_sinf(r0); cs1[j] = __builtin_amdgcn_cosf(r1); sn1[j] = __builtin_amdgcn_sinf(r1); } }
#pragma unroll
                    for (int bj = 0; bj < 2; ++bj) {
                        f32x4 v0 = acc[ai][bj][m][0], v1 = acc[ai][bj][m][1];
                        if (isq || bj == 0) {
                            if (dorope) {
#pragma unroll
                                for (int j = 0; j < 4; ++j) {
                                    const float p0 = __shfl_xor(v0[j], 16), p1 = __shfl_xor(v1[j], 16);
                                    const float c0 = cs0[j], s0 = sn0[j], c1 = cs1[j], s1 = sn1[j];
                                    if (fq == 0) { v0[j] = v0[j] * c0 - p0 * s0; v1[j] = v1[j] * c1 - p1 * s1; }
                                    else if (fq == 1) { v0[j] = v0[j] * c0 + p0 * s0; v1[j] = v1[j] * c1 + p1 * s1; }
                                }
                            }
                            bf16_t* dst;
                            if (isq) { const int head = (u.pn - 2) * 4 + bj * 2 + (wc >> 1); v0 = v0 * qs; v1 = v1 * qs; dst = Q + (size_t)tok * 512 + head * 64 + (wc & 1) * 32 + 8 * fq; }
                            else dst = Kb + (size_t)tok * 128 + (wc >> 1) * 64 + (wc & 1) * 32 + 8 * fq;
                            u32x4 w; w.x = cvt_pk_bf16(v0[0], v0[1]); w.y = cvt_pk_bf16(v0[2], v0[3]); w.z = cvt_pk_bf16(v1[0], v1[1]); w.w = cvt_pk_bf16(v1[2], v1[3]);
                            *(u32x4*)dst = w;
                        } else {
                            const int hk = wc >> 1, d0 = (wc & 1) * 32 + 8 * fq, b = tok >> 11, l = tok & 2047;
                            bf16_t* dst = VT + ((size_t)((b * 2 + hk) * 64 + d0)) * 2048 + l;
#pragma unroll
                            for (int j = 0; j < 4; ++j) { dst[(size_t)j * 2048] = (bf16_t)(cvt_pk_bf16(v0[j], 0.f) & 0xffffu); dst[(size_t)(4 + j) * 2048] = (bf16_t)(cvt_pk_bf16(v1[j], 0.f) & 0xffffu); }
                        }
                    }
                }
        }
    }
};
struct EpiSsmC {
    static constexpr bool PERM = true, AFTER_DRAIN = false, HAS_MID = false;
    const bf16_t* UX; const float* dvec; bf16_t* Y;
    __device__ __forceinline__ void operator()(const f32x4 (&acc)[2][2][4][2], const Unit& u, int wr, int wc, int fr, int fq) const {
        const int g = u.pm >> 1, pmr = u.pm & 1, pnr = u.pn & 1, h0 = 8 * (fq & 1);
        const f32x4 d0 = *(const f32x4*)(dvec + g * 16 + h0), d1 = *(const f32x4*)(dvec + g * 16 + h0 + 4);
#pragma unroll
        for (int ai = 0; ai < 2; ++ai)
#pragma unroll
            for (int m = 0; m < 4; ++m) { const int nloc = pmr * 256 + ai * HALF + wr * 64 + m * 16 + fr;
#pragma unroll
                for (int bj = 0; bj < 2; ++bj) { const int t = pnr * 16 + bj * 8 + wc * 2 + (fq >> 1); const int tok = nloc * 32 + t;
                    const u32x4 uw = *(const u32x4*)(UX + ((size_t)(g * 512 + nloc)) * 640 + 128 + t * 16 + h0);
                    const f32x4 a0 = acc[ai][bj][m][0], a1 = acc[ai][bj][m][1];
                    float y[8];
                    y[0] = a0[0] + d0[0] * bf_lo(uw.x); y[1] = a0[1] + d0[1] * bf_hi(uw.x); y[2] = a0[2] + d0[2] * bf_lo(uw.y); y[3] = a0[3] + d0[3] * bf_hi(uw.y);
                    y[4] = a1[0] + d1[0] * bf_lo(uw.z); y[5] = a1[1] + d1[1] * bf_hi(uw.z); y[6] = a1[2] + d1[2] * bf_lo(uw.w); y[7] = a1[3] + d1[3] * bf_hi(uw.w);
#pragma unroll
                    for (int i = 0; i < 8; ++i) y[i] = gelu_tanh(y[i]);
                    u32x4 w; w.x = cvt_pk_bf16(y[0], y[1]); w.y = cvt_pk_bf16(y[2], y[3]); w.z = cvt_pk_bf16(y[4], y[5]); w.w = cvt_pk_bf16(y[6], y[7]);
                    *(u32x4*)(Y + (size_t)tok * 512 + g * 16 + h0) = w; } }
    }
};
template <int MODE  > struct EpiGated {
    static constexpr bool PERM = true, AFTER_DRAIN = false, HAS_MID = false;
    bf16_t* O; int ldc; const float* bias; float* rowsq;
    __device__ __forceinline__ void operator()(const f32x4 (&acc)[2][2][4][2], const Unit& u, int wr, int wc, int fr, int fq) const {
        const int row0 = u.pm * BM + wr * 64 + fr, col0 = u.pn * HALF + wc * 32 + 8 * fq;
        float rsc[2][4];
        if (MODE == 1) {
#pragma unroll
            for (int ai = 0; ai < 2; ++ai)
#pragma unroll
                for (int m = 0; m < 4; ++m) rsc[ai][m] = 1.0f / sqrtf(rowsq[row0 + ai * HALF + m * 16] * (1.0f / 1024.0f) + 1e-6f);
        }
        f32x4 ba[2], bg[2];
        if (MODE == 0) { ba[0] = *(const f32x4*)(bias + col0); ba[1] = *(const f32x4*)(bias + col0 + 4); bg[0] = *(const f32x4*)(bias + 512 + col0); bg[1] = *(const f32x4*)(bias + 512 + col0 + 4); }
#pragma unroll
        for (int ai = 0; ai < 2; ++ai)
#pragma unroll
            for (int m = 0; m < 4; ++m) { float o[8];
#pragma unroll
                for (int n = 0; n < 2; ++n)
#pragma unroll
                    for (int j = 0; j < 4; ++j) { const float a = (MODE == 1) ? acc[ai][0][m][n][j] * rsc[ai][m] : acc[ai][0][m][n][j], gt = (MODE == 1) ? acc[ai][1][m][n][j] * rsc[ai][m] : acc[ai][1][m][n][j];
                        o[4 * n + j] = (MODE == 0) ? (a + ba[n][j]) * fast_sigmoid(gt + bg[n][j]) : (a * fast_sigmoid(a)) * gt; }
                u32x4 w; w.x = cvt_pk_bf16(o[0], o[1]); w.y = cvt_pk_bf16(o[2], o[3]); w.z = cvt_pk_bf16(o[4], o[5]); w.w = cvt_pk_bf16(o[6], o[7]);
                *(u32x4*)(O + (size_t)(row0 + ai * HALF + m * 16) * ldc + col0) = w;
                if (MODE == 0) { float s = ((o[0] * o[0] + o[1] * o[1]) + (o[2] * o[2] + o[3] * o[3])) + ((o[4] * o[4] + o[5] * o[5]) + (o[6] * o[6] + o[7] * o[7]));
                    s += __shfl_xor(s, 16); s += __shfl_xor(s, 32); if (fq == 0) unsafeAtomicAdd(rowsq + row0 + ai * HALF + m * 16, s); } }
    }
};
struct EpiF32 {
    static constexpr bool PERM = true, AFTER_DRAIN = false, HAS_MID = false;
    float* O; int ldc;
    __device__ __forceinline__ void operator()(const f32x4 (&acc)[2][2][4][2], const Unit& u, int wr, int wc, int fr, int fq) const {
        const int row0 = u.pm * BM + wr * 64 + fr, col0 = u.pn * BM + wc * 32 + 8 * fq;
#pragma unroll
        for (int ai = 0; ai < 2; ++ai)
#pragma unroll
            for (int m = 0; m < 4; ++m) { float* rowp = O + (size_t)(row0 + ai * HALF + m * 16) * ldc + col0;
#pragma unroll
                for (int bj = 0; bj < 2; ++bj) { *(f32x4*)(rowp + bj * HALF) = acc[ai][bj][m][0]; *(f32x4*)(rowp + bj * HALF + 4) = acc[ai][bj][m][1]; } }
    }
};

struct PanelSq {
    float* xbuf;
    unsigned* cnt;
    float eps;
    __device__ __forceinline__ void run(const f32x4 (&v)[2][2][4][2], const Unit& u, int wr, int wc, int fr, int fq, PG8_LAS unsigned char* lds, int wid, int lane) const {
        PG8_LAS float* Pp = (PG8_LAS float*)lds;
        PG8_LAS float* S = (PG8_LAS float*)(lds + 4096);
#pragma unroll
        for (int ai = 0; ai < 2; ++ai)
#pragma unroll
            for (int m = 0; m < 4; ++m) { float s = 0.f;
#pragma unroll
                for (int bj = 0; bj < 2; ++bj)
#pragma unroll
                    for (int n = 0; n < 2; ++n) { const f32x4 x = v[ai][bj][m][n]; s += (x[0] * x[0] + x[1] * x[1]) + (x[2] * x[2] + x[3] * x[3]); }
                s += __shfl_xor(s, 16); s += __shfl_xor(s, 32);
                if (fq == 0) Pp[(ai * HALF + wr * 64 + m * 16 + fr) * 4 + wc] = s; }
        asm volatile("s_waitcnt lgkmcnt(0)" ::: "memory"); __builtin_amdgcn_s_barrier(); asm volatile("" ::: "memory");
        const int row = wid * 32 + (lane & 31);
        if (lane < 32) { const float t = (Pp[row * 4 + 0] + Pp[row * 4 + 1]) + (Pp[row * 4 + 2] + Pp[row * 4 + 3]);
            __hip_atomic_store(xbuf + ((size_t)(u.pm * BM + row) * 4 + u.pn), t, __ATOMIC_RELAXED, __HIP_MEMORY_SCOPE_AGENT); }
        asm volatile("s_waitcnt vmcnt(0)" ::: "memory");
        if (lane == 0) __hip_atomic_fetch_add(cnt + 64 * u.pm, 1u, __ATOMIC_RELAXED, __HIP_MEMORY_SCOPE_AGENT);
        if (wid == 0) { unsigned sp = 0;
            while ((unsigned)__builtin_amdgcn_readfirstlane(__hip_atomic_load(cnt + 64 * u.pm, __ATOMIC_RELAXED, __HIP_MEMORY_SCOPE_AGENT)) < 32u) { __builtin_amdgcn_s_sleep(2); if (++sp > (1u << 22)) break; }
            __builtin_amdgcn_fence(__ATOMIC_ACQUIRE, "agent"); }
        asm volatile("s_waitcnt vmcnt(0) lgkmcnt(0)" ::: "memory"); __builtin_amdgcn_s_barrier(); asm volatile("" ::: "memory");
        if (lane < 32) { const float* slot = xbuf + (size_t)(u.pm * BM + row) * 4; float q = 0.f;
#pragma unroll
            for (int t = 0; t < 4; ++t) q += __hip_atomic_load(slot + t, __ATOMIC_RELAXED, __HIP_MEMORY_SCOPE_AGENT);
            S[row] = 1.0f / sqrtf(q * (1.0f / 1024.0f) + eps); }
        asm volatile("s_waitcnt lgkmcnt(0)" ::: "memory"); __builtin_amdgcn_s_barrier(); asm volatile("" ::: "memory");
    }
};
struct EpiNormResNorm {
    static constexpr bool PERM = true, AFTER_DRAIN = true, HAS_MID = true;
    const bf16_t* base; bf16_t* hb; float* rsq_h; const float* g1; PanelSq st1;
    const PG8_LAS float* tab; int kmid;
    __device__ __forceinline__ void mid(f32x4 (&acc)[2][2][4][2], const Unit& u, int wr, int wc, int fr, int fq) const {
#pragma unroll
        for (int ai = 0; ai < 2; ++ai)
#pragma unroll
            for (int m = 0; m < 4; ++m) { const float f = tab[ai * HALF + wr * 64 + m * 16 + fr];
#pragma unroll
                for (int bj = 0; bj < 2; ++bj)
#pragma unroll
                    for (int n = 0; n < 2; ++n) acc[ai][bj][m][n] = acc[ai][bj][m][n] * f; }
        asm volatile("s_waitcnt lgkmcnt(0)" ::: "memory");
    }
    __device__ __forceinline__ void fused(f32x4 (&acc)[2][2][4][2], const Unit& u, int wr, int wc, int fr, int fq, PG8_LAS unsigned char* lds, int wid, int lane) const {
        const PG8_LAS float* S = (const PG8_LAS float*)(lds + 4096);
        const int col0 = u.pn * BM + wc * 32 + 8 * fq;
#pragma unroll
        for (int ai = 0; ai < 2; ++ai)
#pragma unroll
            for (int m = 0; m < 4; ++m) { const float rb = tab[256 + ai * HALF + wr * 64 + m * 16 + fr];
#pragma unroll
                for (int bj = 0; bj < 2; ++bj)
#pragma unroll
                    for (int n = 0; n < 2; ++n) acc[ai][bj][m][n] = acc[ai][bj][m][n] * rb; }
        st1.run(acc, u, wr, wc, fr, fq, lds, wid, lane);
        f32x4 gv[2][2];
#pragma unroll
        for (int bj = 0; bj < 2; ++bj)
#pragma unroll
            for (int n = 0; n < 2; ++n) gv[bj][n] = *(const f32x4*)(g1 + col0 + bj * HALF + 4 * n);
#pragma unroll
        for (int ai = 0; ai < 2; ++ai)
#pragma unroll
            for (int m = 0; m < 4; ++m) { const int r = ai * HALF + wr * 64 + m * 16 + fr; const float rs = S[r]; const size_t off = (size_t)(u.pm * BM + r) * 1024 + col0;
#pragma unroll
                for (int bj = 0; bj < 2; ++bj) { const u32x4 xw = *(const u32x4*)(base + off + bj * HALF);
                    acc[ai][bj][m][0] = (f32x4){bf_lo(xw.x), bf_hi(xw.x), bf_lo(xw.y), bf_hi(xw.y)} + acc[ai][bj][m][0] * rs * gv[bj][0];
                    acc[ai][bj][m][1] = (f32x4){bf_lo(xw.z), bf_hi(xw.z), bf_lo(xw.w), bf_hi(xw.w)} + acc[ai][bj][m][1] * rs * gv[bj][1]; }
                float s = 0.f;
#pragma unroll
                for (int bj = 0; bj < 2; ++bj) { const f32x4 h0 = acc[ai][bj][m][0], h1 = acc[ai][bj][m][1];
                    s += ((h0[0] * h0[0] + h0[1] * h0[1]) + (h0[2] * h0[2] + h0[3] * h0[3])) + ((h1[0] * h1[0] + h1[1] * h1[1]) + (h1[2] * h1[2] + h1[3] * h1[3]));
                    u32x4 hw; hw.x = cvt_pk_bf16(h0[0], h0[1]); hw.y = cvt_pk_bf16(h0[2], h0[3]); hw.z = cvt_pk_bf16(h1[0], h1[1]); hw.w = cvt_pk_bf16(h1[2], h1[3]); *(u32x4*)(hb + off + bj * HALF) = hw; }
                s += __shfl_xor(s, 16); s += __shfl_xor(s, 32);
                if (fq == 0) unsafeAtomicAdd(rsq_h + u.pm * BM + r, s);
                if (m & 1) asm volatile("" ::: "memory"); }
    }
};
struct EpiNormRes {
    static constexpr bool PERM = true, AFTER_DRAIN = true, HAS_MID = false;
    const bf16_t* base; float* out; const float* g1; PanelSq st;
    __device__ __forceinline__ void fused(f32x4 (&acc)[2][2][4][2], const Unit& u, int wr, int wc, int fr, int fq, PG8_LAS unsigned char* lds, int wid, int lane) const {
        const PG8_LAS float* S = (const PG8_LAS float*)(lds + 4096);
        const int col0 = u.pn * BM + wc * 32 + 8 * fq;
        st.run(acc, u, wr, wc, fr, fq, lds, wid, lane);
        f32x4 gv[2][2];
#pragma unroll
        for (int bj = 0; bj < 2; ++bj)
#pragma unroll
            for (int n = 0; n < 2; ++n) gv[bj][n] = *(const f32x4*)(g1 + col0 + bj * HALF + 4 * n);
#pragma unroll
        for (int ai = 0; ai < 2; ++ai)
#pragma unroll
            for (int m = 0; m < 4; ++m) { const int r = ai * HALF + wr * 64 + m * 16 + fr; const float rs = S[r]; const size_t off = (size_t)(u.pm * BM + r) * 1024 + col0;
#pragma unroll
                for (int bj = 0; bj < 2; ++bj)
                { const u32x4 hw = *(const u32x4*)(base + off + bj * HALF);
                    const f32x4 b0 = (f32x4){bf_lo(hw.x), bf_hi(hw.x), bf_lo(hw.y), bf_hi(hw.y)}, b1 = (f32x4){bf_lo(hw.z), bf_hi(hw.z), bf_lo(hw.w), bf_hi(hw.w)};
                    *(f32x4*)(out + off + bj * HALF) = b0 + acc[ai][bj][m][0] * rs * gv[bj][0]; *(f32x4*)(out + off + bj * HALF + 4) = b1 + acc[ai][bj][m][1] * rs * gv[bj][1]; }
                if (m & 1) asm volatile("" ::: "memory"); }
    }
};
struct SsmOrder {
    int c;
    __device__ bool next(int i, Unit& u) const { if (i > 0 || c >= 128) return false; const int U = (c & 7) * 16 + (c >> 3), g = U >> 2; u.pm = 2 * g + ((U >> 1) & 1); u.pn = 2 * g + (U & 1); return true; }
    __device__ __forceinline__ void a_ready(const Unit&) const {}
    __device__ __forceinline__ void done(const Unit&) const {}
};
}
__device__ __forceinline__ void transpose_item(const float* W, int K, int N, bf16* WT, int src_col0, int dst_row0, int k0, LAS float* scr, int lane, const float* ks = nullptr) {
    if (ks) {
#pragma unroll 32
        for (int i = 0; i < 32; ++i) { const int kk = 2 * i + (lane >> 5); scr[kk * 33 + (lane & 31)] = W[(size_t)(k0 + kk) * N + src_col0 + (lane & 31)] * ks[kk]; }
    } else {
#pragma unroll 32
        for (int i = 0; i < 32; ++i) { const int kk = 2 * i + (lane >> 5); scr[kk * 33 + (lane & 31)] = W[(size_t)(k0 + kk) * N + src_col0 + (lane & 31)]; }
    }
    asm volatile("s_waitcnt lgkmcnt(0)" ::: "memory");
    const int c = lane & 7;
#pragma unroll
    for (int j = 0; j < 4; ++j) { const int n = (lane >> 3) + 8 * j; const LAS float* s = scr + (8 * c) * 33 + n;
        u32x4 o; o.x = cvt_pk_bf16(s[0 * 33], s[1 * 33]); o.y = cvt_pk_bf16(s[2 * 33], s[3 * 33]); o.z = cvt_pk_bf16(s[4 * 33], s[5 * 33]); o.w = cvt_pk_bf16(s[6 * 33], s[7 * 33]);
        *(u32x4*)(WT + (size_t)(dst_row0 + n) * K + k0 + 8 * c) = o; }
    asm volatile("s_waitcnt lgkmcnt(0)" ::: "memory");
}
__device__ __forceinline__ int gated_src_col(int n0, int half_off) { const int pn = n0 >> 8, r = n0 & 255; return r < 128 ? 128 * pn + r : half_off + 128 * pn + (r - 128); }

__device__ __forceinline__ void sincos_rev(double ang, float& s, float& c) {
    const double rev = ang * 0.15915494309189533576888; const float fr = (float)(rev - floor(rev));
    s = __builtin_amdgcn_sinf(fr); c = __builtin_amdgcn_cosf(fr);
}

__device__ __forceinline__ void prologue_b(const Params& P, LAS unsigned char* lds, int tid, int lane, int wave, int blk, int G, int which, int wave0 = 0) {
    unsigned char* ws = P.ws;
    for (int item = blk; (which & 1) && item < NGRP * 8; item += G) {
        const int g = item >> 3, part = item & 7;
        LAS f32x2* APW = (LAS f32x2*)lds;
        LAS f32x2* BB = APW + 33 * 64;
        LAS f32x2* CC = BB + 64 * 16;
        LAS float* KT = (LAS float*)(CC + 16 * 64);
        const float dt = expf(P.log_dt[g]);
        for (int e = tid; e < 33 * 64; e += 512) { const int jx = e >> 6, p = e & 63;
            const float lr = fminf(P.lam_re[g * 64 + p], -1e-4f), li = P.lam_im[g * 64 + p];
            const float mag = expf((float)jx * (lr * dt)); float s, c; sincos_rev((double)jx * (double)(li * dt), s, c);
            f32x2 v; v.x = mag * c; v.y = mag * s; APW[e] = v; }
        for (int e = tid; e < 64 * 16; e += 512) { const int p = e >> 4;
            const float lr = fminf(P.lam_re[g * 64 + p], -1e-4f), li = P.lam_im[g * 64 + p];
            const float mag = expf(lr * dt); float s, c; sincos_rev((double)(li * dt), s, c); const float ar = mag * c, ai = mag * s;
            const float den = lr * lr + li * li, fr = ((ar - 1.0f) * lr + ai * li) / den, fi = (ai * lr - (ar - 1.0f) * li) / den;
            const float br = P.b_re[(size_t)g * 1024 + e], bi = P.b_im[(size_t)g * 1024 + e];
            f32x2 v; v.x = fr * br - fi * bi; v.y = fr * bi + fi * br; BB[e] = v;
            f32x2 w; w.x = P.c_re[(size_t)g * 1024 + e]; w.y = P.c_im[(size_t)g * 1024 + e]; CC[e] = w; }
        __syncthreads();
        if (part == 0 && tid < 64) ((f32x2*)(ws + WS_AT))[g * 64 + tid] = APW[32 * 64 + tid];
        {
            const int hh = tid & 255, h = hh >> 4, hp = hh & 15, jl = 2 * (tid >> 8), j0 = 4 * part + jl;
            float k0 = 0.f, k1 = 0.f;
            for (int p = 0; p < 64; ++p) {
                const f32x2 cv = CC[h * 64 + p], bv = BB[p * 16 + hp], w0 = APW[j0 * 64 + p], w1 = APW[(j0 + 1) * 64 + p];
                const float zr = cv.x * bv.x - cv.y * bv.y, zi = cv.x * bv.y + cv.y * bv.x;
                k0 += zr * w0.x - zi * w0.y; k1 += zr * w1.x - zi * w1.y;
            }
            KT[jl * 256 + hh] = k0; KT[(jl + 1) * 256 + hh] = k1;
        }
        __syncthreads();
        bf16* TWg = (bf16*)(ws + WS_TW) + (size_t)g * 512 * 640;
        for (int e = tid; e < 4096; e += 512) {
            const int jj = e >> 10, t = (e >> 5) & 31, h = (e >> 1) & 15, half = e & 1, jx = 4 * part + jj;
            if (t >= jx) { const LAS float* kp = KT + jj * 256 + h * 16 + 8 * half;
                u32x4 w; w.x = cvt_pk_bf16(kp[0], kp[1]); w.y = cvt_pk_bf16(kp[2], kp[3]); w.z = cvt_pk_bf16(kp[4], kp[5]); w.w = cvt_pk_bf16(kp[6], kp[7]);
                *(u32x4*)(TWg + (size_t)(t * 16 + h) * 640 + 128 + (t - jx) * 16 + 8 * half) = w; }
            const int lg = 4 * (7 - part) + jj, s = t + lg;
            if (lg >= 1 && s < 32) *(u32x4*)(TWg + (size_t)(t * 16 + h) * 640 + 128 + s * 16 + 8 * half) = (u32x4){0u, 0u, 0u, 0u};
        }
        for (int e = tid; e < 64 * 16; e += 512) {
            const int rl = e >> 4, c8 = (e & 15) * 8, t = 4 * part + (rl >> 4), h = rl & 15; float v[8];
#pragma unroll
            for (int i = 0; i < 8; ++i) { const int q = c8 + i, p = q & 63; const f32x2 cv = CC[h * 64 + p], wv = APW[(t + 1) * 64 + p];
                v[i] = (q < 64) ? (cv.x * wv.x - cv.y * wv.y) : -(cv.x * wv.y + cv.y * wv.x); }
            u32x4 w; w.x = cvt_pk_bf16(v[0], v[1]); w.y = cvt_pk_bf16(v[2], v[3]); w.z = cvt_pk_bf16(v[4], v[5]); w.w = cvt_pk_bf16(v[6], v[7]);
            *(u32x4*)(TWg + (size_t)(t * 16 + h) * 640 + c8) = w;
        }
        bf16* W1g = (bf16*)(ws + WS_W1) + (size_t)g * 128 * 512;
        for (int e = tid; e < 16 * 64; e += 512) {
            const int q = 16 * part + (e >> 6), c8 = (e & 63) * 8, s = c8 >> 4, hp0 = c8 & 15, p = q & 63; float v[8];
            const f32x2 wv = APW[(31 - s) * 64 + p];
#pragma unroll
            for (int i = 0; i < 8; ++i) { const f32x2 bv = BB[p * 16 + hp0 + i]; v[i] = (q < 64) ? (wv.x * bv.x - wv.y * bv.y) : (wv.x * bv.y + wv.y * bv.x); }
            u32x4 w; w.x = cvt_pk_bf16(v[0], v[1]); w.y = cvt_pk_bf16(v[2], v[3]); w.z = cvt_pk_bf16(v[4], v[5]); w.w = cvt_pk_bf16(v[6], v[7]);
            *(u32x4*)(W1g + (size_t)q * 512 + c8) = w;
        }
        __syncthreads();
    }
    {
        LAS float* scr = (LAS float*)(lds + wave * 16384);
        const int gw = blk * (8 - wave0) + (wave - wave0), NGW = G * (8 - wave0);
        constexpr int I_IN = 16 * 40, I_GLU = 8 * 32, I_OUT = 16 * 32, I_GU = 16 * 176, I_DN = 44 * 32, NIT = I_IN + I_GLU + I_OUT + I_GU + I_DN;
        const int it_lo = (which & 1) ? I_IN : I_IN + I_GLU + I_OUT, it_hi = (which & 2) ? NIT : I_IN + I_GLU + I_OUT;
        for (int it = it_lo + gw; wave >= wave0 && it < it_hi; it += NGW) {
            int r = it;
            if (r < I_IN) { const int nb = r % 40, kb = r / 40; transpose_item(P.w_in, 1024, 1280, (bf16*)(ws + WS_WIN), 32 * nb, 32 * nb, 64 * kb, scr, lane); continue; } r -= I_IN;
            if (r < I_GLU) { const int nb = r % 32, kb = r / 32; transpose_item(P.w_glu, 512, 1024, (bf16*)(ws + WS_WGLU), gated_src_col(32 * nb, 512), 32 * nb, 64 * kb, scr, lane); continue; } r -= I_GLU;
            if (r < I_OUT) { const int nb = r % 32, kb = r / 32; transpose_item(P.w_out, 1024, 1024, (bf16*)(ws + WS_WOUT), 32 * nb, 32 * nb, 64 * kb, scr, lane, kb < 8 ? P.g_ssm_out + 64 * kb : P.g_attn_out + 64 * (kb - 8)); continue; } r -= I_OUT;
            if (r < I_GU) { const int nb = r % 176, kb = r / 176; transpose_item(P.w_gate_up, 1024, 5632, (bf16*)(ws + WS_WGU), gated_src_col(32 * nb, 2816), 32 * nb, 64 * kb, scr, lane, P.g_pre_ffn + 64 * kb); continue; } r -= I_GU;
            { const int nb = r % 32, kb = r / 32; transpose_item(P.w_down, 2816, 1024, (bf16*)(ws + WS_WDN), 32 * nb, 32 * nb, 64 * kb, scr, lane); }
        }
    }
}

__device__ __forceinline__ void prologue_a(const Params& P, LAS unsigned char* lds, int tid, int lane, int wave) {
    unsigned char* ws = P.ws;
    const int G = gridDim.x, blk = blockIdx.x;
    {
        LAS float* scr = (LAS float*)(lds + wave * 16384);
        const int gw = blk * 8 + wave, NGW = G * 8;
        for (int r = gw; r < 16 * 40; r += NGW) { const int nb = r % 40, kb = r / 40; transpose_item(P.w_in, 1024, 1280, (bf16*)(ws + WS_WIN), 32 * nb, 32 * nb, 64 * kb, scr, lane, P.g_pre_mix + 64 * kb); }
        for (int m = gw; m < NTOK; m += NGW) {
            const f32x4* xr = (const f32x4*)(P.x + (size_t)m * DM) + lane; f32x4 v[4]; float s = 0.f;
#pragma unroll
            for (int j = 0; j < 4; ++j) { v[j] = xr[64 * j]; s += (v[j].x * v[j].x + v[j].y * v[j].y) + (v[j].z * v[j].z + v[j].w * v[j].w); }
            const float rstd = 1.0f / sqrtf(wave_sum(s) * (1.0f / DM) + NORM_EPS);
            if (lane == 0) ((float*)(ws + WS_RS0))[m] = rstd;
            u32x2* o8 = (u32x2*)((bf16*)(ws + WS_XN) + (size_t)m * DM) + lane;
#pragma unroll
            for (int j = 0; j < 4; ++j) { u32x2 w; w.x = cvt_pk_bf16(v[j].x, v[j].y); w.y = cvt_pk_bf16(v[j].z, v[j].w); o8[64 * j] = w; }
        }
        for (int e = blk * 512 + tid; e < NTOK; e += G * 512) { ((float*)(ws + WS_RSQ))[e] = 0.f; ((float*)(ws + WS_RSQH))[e] = 0.f; }
    }
}

__device__ __forceinline__ void ssm_pass_a(const Params& P, int lane, int wave) {
    if (wave >= 2) return;
    unsigned char* ws = P.ws;
    for (int unit = wave * 256 + blockIdx.x; unit < 512; unit += 2 * gridDim.x > 512 ? 512 : 2 * gridDim.x) {
        const int g = unit >> 4, b = (unit >> 1) & 7, hs = unit & 1;
        const int r32 = lane & 31, hi = lane >> 5;
        const int sig = 16 * ((r32 >> 2) & 1) + 4 * (r32 >> 3) + (r32 & 3);
        bf16* UXg = (bf16*)(ws + WS_UX) + ((size_t)(g * 512 + b * 64)) * 640;
        const bf16* a0p = UXg + (size_t)sig * 640 + 128 + 8 * hi;
        const bf16* a1p = a0p + (size_t)32 * 640;
        const bf16* W1g = (const bf16*)(ws + WS_W1) + (size_t)g * 128 * 512;
        const bf16* b0p = W1g + (size_t)(32 * hs + r32) * 512 + 8 * hi;
        const bf16* b1p = b0p + (size_t)64 * 512;
        f32x16 acc[2][2];
#pragma unroll
        for (int i = 0; i < 2; ++i)
#pragma unroll
            for (int j = 0; j < 2; ++j)
#pragma unroll
                for (int r = 0; r < 16; ++r) acc[i][j][r] = 0.f;
#pragma unroll 4
        for (int ks = 0; ks < 32; ++ks) {
            const bf16x8 A0 = *(const bf16x8*)(a0p + 16 * ks), A1 = *(const bf16x8*)(a1p + 16 * ks), B0 = *(const bf16x8*)(b0p + 16 * ks), B1 = *(const bf16x8*)(b1p + 16 * ks);
            acc[0][0] = __builtin_amdgcn_mfma_f32_32x32x16_bf16(A0, B0, acc[0][0], 0, 0, 0);
            acc[0][1] = __builtin_amdgcn_mfma_f32_32x32x16_bf16(A0, B1, acc[0][1], 0, 0, 0);
            acc[1][0] = __builtin_amdgcn_mfma_f32_32x32x16_bf16(A1, B0, acc[1][0], 0, 0, 0);
            acc[1][1] = __builtin_amdgcn_mfma_f32_32x32x16_bf16(A1, B1, acc[1][1], 0, 0, 0);
        }
        const int p = 32 * hs + r32;
        const float2 aT = ((const float2*)(ws + WS_AT))[g * 64 + p];
        float er[2], ei[2];
#pragma unroll
        for (int rt = 0; rt < 2; ++rt) { float lr = 0.f, li = 0.f;
#pragma unroll
            for (int r = 0; r < 16; ++r) { const float nr = aT.x * lr - aT.y * li + acc[rt][0][r], ni = aT.x * li + aT.y * lr + acc[rt][1][r]; lr = nr; li = ni; }
            er[rt] = lr; ei[rt] = li; }
        float pr = aT.x, pi = aT.y;
#pragma unroll
        for (int k = 0; k < 4; ++k) { const float nr = pr * pr - pi * pi, ni = 2.f * pr * pi; pr = nr; pi = ni; }
        const float x0r = __shfl_xor(er[0], 32), x0i = __shfl_xor(ei[0], 32);
        const float s0r = hi ? x0r : 0.f, s0i = hi ? x0i : 0.f;
        const float ebr = pr * s0r - pi * s0i + er[0], ebi = pr * s0i + pi * s0r + ei[0];
        const float y0r = __shfl_xor(ebr, 32), y0i = __shfl_xor(ebi, 32);
        const float ecr = pr * y0r - pi * y0i + er[1], eci = pr * y0i + pi * y0r + ei[1];
        const float z0r = __shfl_xor(ecr, 32), z0i = __shfl_xor(eci, 32);
        const float s1r = hi ? z0r : y0r, s1i = hi ? z0i : y0i;
#pragma unroll
        for (int rt = 0; rt < 2; ++rt) { float cr = rt ? s1r : s0r, ci = rt ? s1i : s0i;
            bf16* xo = UXg + (size_t)(32 * rt + 16 * hi) * 640 + p;
#pragma unroll
            for (int r = 0; r < 16; ++r) {
                xo[(size_t)r * 640] = (bf16)(cvt_pk_bf16(cr, 0.f) & 0xffffu); xo[(size_t)r * 640 + 64] = (bf16)(cvt_pk_bf16(ci, 0.f) & 0xffffu);
                const float nr = aT.x * cr - aT.y * ci + acc[rt][0][r], ni = aT.x * ci + aT.y * cr + acc[rt][1][r]; cr = nr; ci = ni; }
        }
    }
}

__device__ __forceinline__ void attn_phase(const Params& P, LAS unsigned char* lds, int tid, int lane, int wave, int unit0, int nunits) {
    unsigned char* ws = P.ws;
    const bf16* Q = (const bf16*)(ws + WS_Q); const bf16* Kb = (const bf16*)(ws + WS_K); const bf16* VT = (const bf16*)(ws + WS_VT); bf16* MG = (bf16*)(ws + WS_MG);
    const int r32 = lane & 31, hi = lane >> 5;
    const int h = wave, hk = h >> 2;
    const float sink2 = P.sinks[h] * LOG2E;
    constexpr int KST = 272, VST = 392, VOFF = 192 * KST;
#pragma unroll 1
    for (int unit = unit0; unit < unit0 + nunits; ++unit) {
        const int b = unit >> 5, l0 = (unit & 31) * 64, tokb = b * SEQL;
        LAS float* rsq = (LAS float*)(lds + 139264);
        if (tid < 64) rsq[tid] = 0.f;
        {
            u32x4 kv[6], vv[6];
#pragma unroll
            for (int i = 0; i < 6; ++i) { const int p = tid + 512 * i, row = p >> 4, c16 = p & 15; int t = l0 - 128 + row; t = t < 0 ? t + 128 : t;
                kv[i] = *(const u32x4*)(Kb + (size_t)(tokb + t) * 128 + c16 * 8); }
#pragma unroll
            for (int i = 0; i < 6; ++i) { const int p = tid + 512 * i, row = p / 24, c = p % 24; int k0 = l0 - 128 + 8 * c; k0 = k0 < 0 ? k0 + 128 : k0;
                vv[i] = *(const u32x4*)(VT + ((size_t)(b * 128 + row)) * SEQL + k0); }
#pragma unroll
            for (int i = 0; i < 6; ++i) { const int p = tid + 512 * i, row = p >> 4, c16 = p & 15; *(LAS u32x4*)(lds + row * KST + c16 * 16) = kv[i]; }
#pragma unroll
            for (int i = 0; i < 6; ++i) { const int p = tid + 512 * i, row = p / 24, c = p % 24; LAS u32x2* d = (LAS u32x2*)(lds + VOFF + row * VST + c * 16);
                u32x2 a, bq; a.x = vv[i].x; a.y = vv[i].y; bq.x = vv[i].z; bq.y = vv[i].w; d[0] = a; d[1] = bq; }
        }
        __syncthreads();
#pragma unroll 1
        for (int sub = 0; sub < 2; ++sub) {
            const int q0 = l0 + 32 * sub;
            bf16x8 qf[4];
#pragma unroll
            for (int ds = 0; ds < 4; ++ds) qf[ds] = *(const bf16x8*)(Q + (size_t)(tokb + q0 + r32) * 512 + h * 64 + 16 * ds + 8 * hi);
            f32x16 s[5];
#pragma unroll
            for (int kt = 0; kt < 5; ++kt) {
#pragma unroll
                for (int r = 0; r < 16; ++r) s[kt][r] = 0.f;
                const LAS unsigned char* kp = lds + (32 * (kt + sub) + r32) * KST + hk * 128 + hi * 16;
#pragma unroll
                for (int ds = 0; ds < 4; ++ds) { const bf16x8 kf = *(const LAS bf16x8*)(kp + ds * 32); s[kt] = __builtin_amdgcn_mfma_f32_32x32x16_bf16(kf, qf[ds], s[kt], 0, 0, 0); }
                if (kt < 4) { const bool dead = (q0 - 128 + 32 * kt) < 0;
#pragma unroll
                    for (int r = 0; r < 16; ++r) s[kt][r] = dead ? -1e30f : s[kt][r]; }
            }
#pragma unroll
            for (int r = 0; r < 16; ++r) { const int cr = crow(r, hi); if (cr <= r32) s[0][r] = -1e30f; if (cr > r32) s[4][r] = -1e30f; }
            float m = sink2;
#pragma unroll
            for (int kt = 0; kt < 5; ++kt)
#pragma unroll
                for (int r = 0; r < 16; ++r) m = fmaxf(m, s[kt][r]);
            m = fmaxf(m, __shfl_xor(m, 32));
            float sum = 0.f;
#pragma unroll
            for (int kt = 0; kt < 5; ++kt)
#pragma unroll
                for (int r = 0; r < 16; ++r) { const float pv = __builtin_amdgcn_exp2f(s[kt][r] - m); s[kt][r] = pv; sum += pv; }
            sum += __shfl_xor(sum, 32);
            const float inv = 1.0f / (sum + __builtin_amdgcn_exp2f(sink2 - m));
            __builtin_amdgcn_sched_barrier(0);
            f32x16 o[2];
#pragma unroll
            for (int r = 0; r < 16; ++r) { o[0][r] = 0.f; o[1][r] = 0.f; }
#pragma unroll
            for (int kt = 0; kt < 5; ++kt) {
#pragma unroll
                for (int ks = 0; ks < 2; ++ks) {
                    u32x4 pw; pw.x = cvt_pk_bf16(s[kt][8 * ks + 0], s[kt][8 * ks + 1]); pw.y = cvt_pk_bf16(s[kt][8 * ks + 2], s[kt][8 * ks + 3]);
                    pw.z = cvt_pk_bf16(s[kt][8 * ks + 4], s[kt][8 * ks + 5]); pw.w = cvt_pk_bf16(s[kt][8 * ks + 6], s[kt][8 * ks + 7]);
                    const bf16x8 pa = __builtin_bit_cast(bf16x8, pw);
#pragma unroll
                    for (int dt = 0; dt < 2; ++dt) {
                        const LAS unsigned char* vp = lds + VOFF + (hk * 64 + 32 * dt + r32) * VST + (32 * (kt + sub) + 16 * ks + 4 * hi) * 2;
                        const u32x2 lo = *(const LAS u32x2*)vp, hi2 = *(const LAS u32x2*)(vp + 16);
                        u32x4 vw; vw.x = lo.x; vw.y = lo.y; vw.z = hi2.x; vw.w = hi2.y;
                        o[dt] = __builtin_amdgcn_mfma_f32_32x32x16_bf16(pa, __builtin_bit_cast(bf16x8, vw), o[dt], 0, 0, 0);
                    }
                }
            }
            {
                LAS unsigned short* stg = (LAS unsigned short*)(lds + 102400 + wave * 4608);
#pragma unroll
                for (int r = 0; r < 16; ++r) { const int cr = crow(r, hi); const float iv = __shfl(inv, cr);
                    stg[cr * 72 + r32] = (unsigned short)(cvt_pk_bf16(o[0][r] * iv, 0.f) & 0xffffu); stg[cr * 72 + 32 + r32] = (unsigned short)(cvt_pk_bf16(o[1][r] * iv, 0.f) & 0xffffu); }
                asm volatile("s_waitcnt lgkmcnt(0)" ::: "memory");
                const int row = lane >> 1, hf = lane & 1; float sq = 0.f;
                bf16* dst = MG + (size_t)(tokb + q0 + row) * 1024 + 512 + h * 64 + hf * 32;
#pragma unroll
                for (int i = 0; i < 4; ++i) { const u32x4 w = *(const LAS u32x4*)(stg + row * 72 + hf * 32 + 8 * i);
                    const float a0 = bf_lo(w.x), a1 = bf_hi(w.x), a2 = bf_lo(w.y), a3 = bf_hi(w.y), a4 = bf_lo(w.z), a5 = bf_hi(w.z), a6 = bf_lo(w.w), a7 = bf_hi(w.w);
                    sq += ((a0 * a0 + a1 * a1) + (a2 * a2 + a3 * a3)) + ((a4 * a4 + a5 * a5) + (a6 * a6 + a7 * a7));
                    *(u32x4*)(dst + 8 * i) = w; }
                sq += __shfl_xor(sq, 1);
                if (hf == 0) __builtin_amdgcn_ds_faddf(rsq + 32 * sub + row, sq, 0, 0, false);
                asm volatile("s_waitcnt lgkmcnt(0)" ::: "memory");
            }
        }
        __syncthreads();
        if (tid < 64) ((float*)(ws + WS_RSQ))[NTOK + tokb + l0 + tid] = rsq[tid];
        __syncthreads();
    }
}

#define XB_TMO      128
#define XB_XCNT(j)  (256  + 64 * (j))
#define XB_XSUB(j)  (1280 + 64 * (j))
#define XB_XGEN(j)  (2304 + 64 * (j))
#define XB_TOP      3328
#define XB_TOPGEN   3392
#define XCD_BAR_WORDS 3456
#define XB_SPIN_CAP (1u << 18)

__device__ __forceinline__ unsigned xb_ld(unsigned* p)              { return __hip_atomic_load(p, __ATOMIC_RELAXED, __HIP_MEMORY_SCOPE_AGENT); }
__device__ __forceinline__ unsigned xb_add(unsigned* p, unsigned v) { return __hip_atomic_fetch_add(p, v, __ATOMIC_RELAXED, __HIP_MEMORY_SCOPE_AGENT); }
__device__ __forceinline__ unsigned xb_xcc_id() { return (unsigned)__builtin_amdgcn_s_getreg((3 << 11) | 20) & 0xFu; }
#define XB_SPIN(cond, bar) do { unsigned _sp = 0; while (cond) { __builtin_amdgcn_s_sleep(1); \
    if ((++_sp & 255u) == 0u) { if (xb_ld(&(bar)[XB_TMO])) break; if (_sp > XB_SPIN_CAP) { atomicAdd(&(bar)[XB_TMO], 1u); break; } } } } while (0)

struct XcdBarrier {
    unsigned* bar; unsigned x;
    volatile LAS unsigned* st;
};

__device__ __forceinline__ XcdBarrier xcd_barrier_post(unsigned* bar, volatile LAS unsigned* st) {
    XcdBarrier b; b.bar = bar; b.x = xb_xcc_id(); b.st = st;
    if (threadIdx.x == 0) (void)xb_add(&bar[XB_XCNT(b.x)], 1u);
    return b;
}
__device__ __forceinline__ void xcd_barrier_complete(unsigned* bar, unsigned x, unsigned& nloc, unsigned& nx) {
    const unsigned G = gridDim.x * gridDim.y * gridDim.z;
    unsigned sum, cnt, mine, sp = 0u;
    for (;;) {
        sum = 0u; cnt = 0u; mine = 0u;
#pragma unroll
        for (unsigned j = 0; j < 16; ++j) { const unsigned c = xb_ld(&bar[XB_XCNT(j)]); sum += c; cnt += (c > 0u) ? 1u : 0u; mine = (j == x) ? c : mine; }
        if (sum == G) break;
        __builtin_amdgcn_s_sleep(1);
        if ((++sp & 255u) == 0u) { if (xb_ld(&bar[XB_TMO])) break; if (sp > XB_SPIN_CAP) { atomicAdd(&bar[XB_TMO], 1u); break; } }
    }
    nloc = mine > 0u ? mine : 1u; nx = cnt > 0u ? cnt : 1u;
}

__device__ __forceinline__ void xcd_barrier(const XcdBarrier& b) {
    asm volatile("s_waitcnt vmcnt(0)" ::: "memory");
    __syncthreads();
    if (threadIdx.x == 0) {
        unsigned* bar = b.bar;
        __builtin_amdgcn_s_waitcnt(0);
        unsigned nloc = b.st[0], nx = b.st[1];
        if (nloc == 0u) { xcd_barrier_complete(bar, b.x, nloc, nx); b.st[0] = nloc; b.st[1] = nx; }
        const unsigned old = xb_add(&bar[XB_XSUB(b.x)], 1u);
        const unsigned gen = old / nloc;
        if (old + 1u == (gen + 1u) * nloc) {
            __builtin_amdgcn_fence(__ATOMIC_RELEASE, "agent");
            asm volatile("s_waitcnt vmcnt(0)" ::: "memory");
            const unsigned og = xb_add(&bar[XB_TOP], 1u);
            const unsigned tg = og / nx;
            if (og + 1u == (tg + 1u) * nx) xb_add(&bar[XB_TOPGEN], 1u);
            else XB_SPIN(xb_ld(&bar[XB_TOPGEN]) == tg, bar);
            __builtin_amdgcn_fence(__ATOMIC_ACQUIRE, "agent");
            xb_add(&bar[XB_XGEN(b.x)], 1u);
            asm volatile("s_waitcnt vmcnt(0)" ::: "memory");
        } else {
            XB_SPIN(xb_ld(&bar[XB_XGEN(b.x)]) == gen, bar);
            __builtin_amdgcn_fence(__ATOMIC_ACQUIRE, "agent");
            asm volatile("s_waitcnt vmcnt(0)" ::: "memory");
        }
    }
    __syncthreads();
}

__device__ __forceinline__ void quad_sync(unsigned* cnt, unsigned target, bool fast) {
    asm volatile("s_waitcnt vmcnt(0)" ::: "memory");
    __syncthreads();
    if (threadIdx.x == 0) {
        if (!fast) { __builtin_amdgcn_fence(__ATOMIC_RELEASE, "agent"); asm volatile("s_waitcnt vmcnt(0)" ::: "memory"); }
        (void)xb_add(cnt, 1u);
        unsigned sp = 0u; while (xb_ld(cnt) < target) { __builtin_amdgcn_s_sleep(1); if (++sp > (1u << 22)) break; }
        __builtin_amdgcn_fence(__ATOMIC_ACQUIRE, "agent");
        asm volatile("s_waitcnt vmcnt(0)" ::: "memory");
    }
    __syncthreads();
}

__global__ void __launch_bounds__(512, 2) fwd_megakernel(Params P) {
    extern __shared__ __attribute__((aligned(16))) unsigned char lds_raw[];
    LAS unsigned char* lds = (LAS unsigned char*)lds_raw;
    const int tid = threadIdx.x, lane = tid & 63, wave = __builtin_amdgcn_readfirstlane(tid >> 6);
    const int G = gridDim.x, blk = blockIdx.x;
    unsigned char* ws = P.ws;
    typedef pg8::bf16_t bt;

    if (tid < 4) ((LAS unsigned*)(lds + LDSCTL_OFF))[tid] = 0u;
    __syncthreads();
    const XcdBarrier bar = xcd_barrier_post((unsigned*)(ws + WS_BAR), (volatile LAS unsigned*)(lds + LDSCTL_OFF));
    if (tid == 0) __hip_atomic_store((unsigned*)(ws + WS_XT) + blk, bar.x, __ATOMIC_RELAXED, __HIP_MEMORY_SCOPE_AGENT);
    prologue_a(P, lds, tid, lane, wave);
    xcd_barrier(bar);
    {
        pg8::Gemm g{(const bt*)(ws + WS_XN), (const bt*)(ws + WS_WIN), NTOK, INW, DM, DM, DM}; pg8::StaticOrder S; S.init(NTOK, INW, G, blk);
        pg8::EpiInProj E{(bt*)(ws + WS_UX), (bt*)(ws + WS_Q), (bt*)(ws + WS_K), (bt*)(ws + WS_VT), P.pos, (const float*)(ws + WS_RS0)};
        pg8::gemm_phase<pg8::EpiInProj, pg8::StaticOrder, true, true>(lds, g, S, E);
    }
    if (G == 256) { if (blk >= 64) prologue_b(P, lds, tid, lane, wave, blk - 64, 192, 1); } else prologue_b(P, lds, tid, lane, wave, blk, G, 3);
    xcd_barrier(bar);
    ssm_pass_a(P, lane, wave);
    prologue_b(P, lds, tid, lane, wave, blk, G, 2, 2);
    xcd_barrier(bar);
    {
        pg8::Gemm g{(const bt*)(ws + WS_UX), (const bt*)(ws + WS_TW), NGRP * GROWS, NGRP * 512, KX, KX, KX}; pg8::SsmOrder S{blk};
        pg8::EpiSsmC E{(const bt*)(ws + WS_UX), P.ssm_d, (bt*)(ws + WS_Y)};
        pg8::gemm_phase<pg8::EpiSsmC, pg8::SsmOrder, true, true>(lds, g, S, E);
        if (G == 256) { if (blk >= 128) attn_phase(P, lds, tid, lane, wave, (blk - 128) * 2, 2); }
        else for (int u = blk; u < 256; u += G) attn_phase(P, lds, tid, lane, wave, u, 1);
    }
    xcd_barrier(bar);
    const bool quads = (G == 256);
    bool qfast = false; unsigned* qcnt = (unsigned*)(ws + WS_CNT) + 4096;
    if (quads) { const int x = blk & 7, p = (blk >> 3) & 7; unsigned* xt = (unsigned*)(ws + WS_XT);
        const unsigned x0 = xb_ld(xt + x + 8 * p), x1 = xb_ld(xt + x + 8 * (p + 8)), x2 = xb_ld(xt + x + 8 * (p + 16)), x3 = xb_ld(xt + x + 8 * (p + 24));
        qfast = (x0 == x1) && (x1 == x2) && (x2 == x3); qcnt += 64 * (8 * x + p); }
    {
        pg8::Gemm g{(const bt*)(ws + WS_Y), (const bt*)(ws + WS_WGLU), NTOK, 1024, 512, 512, 512}; pg8::StaticOrder S; S.init(NTOK, 1024, G, blk);
        pg8::EpiGated<0> E{(bt*)(ws + WS_MG), 1024, P.b_glu, (float*)(ws + WS_RSQ)};
        pg8::gemm_phase<pg8::EpiGated<0>, pg8::StaticOrder, true, true>(lds, g, S, E);
    }
    if (quads) quad_sync(qcnt, 4u, qfast); else xcd_barrier(bar);
    {
        pg8::Gemm g{(const bt*)(ws + WS_MG), (const bt*)(ws + WS_WOUT), NTOK, DM, DM, DM, DM}; pg8::StaticOrder S; S.init(NTOK, DM, G, blk);
        pg8::PanelSq st1{(float*)(ws + WS_XB), (unsigned*)(ws + WS_CNT), NORM_EPS};
        LAS float* tab = (LAS float*)(lds + LDSCTL_OFF + 64);
        { pg8::Unit u0; if (S.next(0, u0) && tid < 256) { const int row = u0.pm * 256 + tid; const float sa = ((const float*)(ws + WS_RSQ))[row] * (1.0f / 512.0f) + NORM_EPS, sb = ((const float*)(ws + WS_RSQ))[NTOK + row] * (1.0f / 512.0f) + NORM_EPS;
            tab[tid] = sqrtf(sb / sa); tab[256 + tid] = 1.0f / sqrtf(sb); } }
        __syncthreads();
        pg8::EpiNormResNorm E{(const bt*)(ws + WS_XN), (bt*)(ws + WS_HB), (float*)(ws + WS_RSQH), P.g_post_mix, st1, tab, 8};
        pg8::gemm_phase<pg8::EpiNormResNorm, pg8::StaticOrder, false, true>(lds, g, S, E);
    }
    if (quads) quad_sync(qcnt, 8u, qfast); else xcd_barrier(bar);
    {
        pg8::Gemm g{(const bt*)(ws + WS_HB), (const bt*)(ws + WS_WGU), NTOK, 2 * DFF, DM, DM, DM}; pg8::StaticOrder S; S.init(NTOK, 2 * DFF, G, blk);
        pg8::EpiGated<1> E{(bt*)(ws + WS_ACT), DFF, nullptr, (float*)(ws + WS_RSQH)};
        pg8::gemm_phase<pg8::EpiGated<1>, pg8::StaticOrder, true, true>(lds, g, S, E);
    }
    if (quads) quad_sync(qcnt, 12u, qfast); else xcd_barrier(bar);
    {
        pg8::Gemm g{(const bt*)(ws + WS_ACT), (const bt*)(ws + WS_WDN), NTOK, DM, DFF, DFF, DFF}; pg8::StaticOrder S; S.init(NTOK, DM, G, blk);
        pg8::PanelSq st{(float*)(ws + WS_XB) + 2 * NTOK * 4, (unsigned*)(ws + WS_CNT) + 2 * 4096, NORM_EPS};
        pg8::EpiNormRes E{(const bt*)(ws + WS_HB), P.out, P.g_post_ffn, st};
        pg8::gemm_phase<pg8::EpiNormRes, pg8::StaticOrder, false, true>(lds, g, S, E);
    }
}

extern "C" void kernel_launch(void* const* d_in, const int* in_sizes, int n_in, void* d_out, int out_size, void* d_ws, size_t ws_size, hipStream_t stream) {
    static int grid_blocks = 0;
    if (grid_blocks == 0) {
        int dev = 0, cus = 0, per_cu = 0;
        hipGetDevice(&dev);
        hipDeviceGetAttribute(&cus, hipDeviceAttributeMultiprocessorCount, dev);
        hipFuncSetAttribute((const void*)fwd_megakernel, hipFuncAttributeMaxDynamicSharedMemorySize, LDS_BYTES);
        hipOccupancyMaxActiveBlocksPerMultiprocessor(&per_cu, (const void*)fwd_megakernel, 512, LDS_BYTES);
        if (per_cu < 1) { fprintf(stderr, "kernel_launch: occupancy query reports %d blocks per CU\n", per_cu); per_cu = 1; }
        grid_blocks = cus * 1;
        (void)hipGetLastError();
    }
    Params p{};
    p.x = (const float*)d_in[0]; p.pos = (const int*)d_in[1]; p.g_pre_mix = (const float*)d_in[2]; p.w_in = (const float*)d_in[3]; p.lam_re = (const float*)d_in[4]; p.lam_im = (const float*)d_in[5];
    p.log_dt = (const float*)d_in[6]; p.b_re = (const float*)d_in[7]; p.b_im = (const float*)d_in[8]; p.c_re = (const float*)d_in[9]; p.c_im = (const float*)d_in[10]; p.ssm_d = (const float*)d_in[11];
    p.w_glu = (const float*)d_in[12]; p.b_glu = (const float*)d_in[13]; p.sinks = (const float*)d_in[14]; p.g_ssm_out = (const float*)d_in[15]; p.g_attn_out = (const float*)d_in[16]; p.w_out = (const float*)d_in[17];
    p.g_post_mix = (const float*)d_in[18]; p.g_pre_ffn = (const float*)d_in[19]; p.w_gate_up = (const float*)d_in[20]; p.w_down = (const float*)d_in[21]; p.g_post_ffn = (const float*)d_in[22];
    p.out = (float*)d_out; p.ws = (unsigned char*)d_ws;
    (void)hipMemsetAsync(d_ws, 0, 65536, stream);
    void* args[] = {&p};
    hipError_t e = hipLaunchCooperativeKernel((const void*)fwd_megakernel, dim3(grid_blocks), dim3(512), args, LDS_BYTES, stream);
    if (e != hipSuccess) fprintf(stderr, "cooperative launch failed: %s (grid %d)\n", hipGetErrorString(e), grid_blocks);
}
```

```cpp
#include <hip/hip_runtime.h>
#include <hip/hip_cooperative_groups.h>
#include <cstdio>
#include <cstdint>
namespace cg = cooperative_groups;
namespace pg8 {
#define PG8_LAS __attribute__((address_space(3)))
typedef unsigned short bf16_t;
typedef short bf16x8 __attribute__((ext_vector_type(8)));
typedef float f32x4 __attribute__((ext_vector_type(4)));
typedef unsigned u32x4 __attribute__((ext_vector_type(4)));
constexpr int BM = 256, BK = 64, HALF = 128, HTB = HALF * BK * 2  , STAGE_BYTES = 8 * HTB, NXCD = 8, WGM = 8;

__host__ __device__ __forceinline__ int lds_byte(int r, int c) { const int st = (r >> 4) * 2 + (c >> 5), rr = r & 15, cc = c & 31, ob = rr * 64 + cc * 2; return st * 1024 + (ob ^ (((ob >> 9) & 1) << 5)); }
__host__ __device__ __forceinline__ void stage_rc(int b, int& R, int& C) { const int st = b / 1024, sb = b % 1024, swz = sb ^ (((sb >> 9) & 1) << 5); R = (st >> 1) * 16 + swz / 64; C = (st & 1) * 32 + (swz % 64) / 2; }
__host__ __device__ __forceinline__ int perm32(int rho) { const int n = rho >> 4, i = rho & 15; return 8 * (i >> 2) + 4 * n + (i & 3); }

struct Unit { int pm, pn; };
struct Gemm { const bf16_t* A; const bf16_t* Bt; int M, N, K, lda, ldb; };

struct StaticOrder {
    int nM, nN, nwg, G, c;
    __host__ __device__ void init(int M, int N, int G_, int c_) { nM = M / BM; nN = N / BM; nwg = nM * nN; G = G_; c = c_; }
    __host__ __device__ bool next(int i, Unit& u) const {
        const long L = (long)i * G + c; if (L >= nwg) return false;
        int wgid = (int)L; { const int q = nwg / NXCD, r = nwg % NXCD, xcd = wgid % NXCD, off = wgid / NXCD; wgid = (xcd < r ? xcd * (q + 1) : r * (q + 1) + (xcd - r) * q) + off; }
        const int nig = WGM * nN, gid = wgid / nig, fm = gid * WGM, gsz = (nM - fm) < WGM ? (nM - fm) : WGM;
        u.pm = fm + ((wgid % nig) % gsz); u.pn = (wgid % nig) / gsz; return true;
    }
    __device__ __forceinline__ void a_ready(const Unit&) const {}
    __device__ __forceinline__ void done(const Unit&) const {}
};

__device__ __forceinline__ unsigned cvt_pk_bf16(float lo, float hi) { unsigned r; asm volatile("v_cvt_pk_bf16_f32 %0, %1, %2" : "=v"(r) : "v"(lo), "v"(hi)); return r; }
template <class Epi, class Sched, bool ALIGN_EPI = false, bool SP2 = false>
__device__ __forceinline__ void gemm_phase(PG8_LAS unsigned char* lds, const Gemm g, const Sched& S, const Epi& E) {
    const int tid = threadIdx.x, wid = __builtin_amdgcn_readfirstlane(tid >> 6), lane = tid & 63, wr = wid >> 2, wc = wid & 3, fr = lane & 15, fq = lane >> 4;
    const int K = g.K, nt = K / BK;
    unsigned voffA[2], voffB[2];
#pragma unroll
    for (int i = 0; i < 2; ++i) { int R, C; stage_rc(tid * 16 + i * 8192, R, C); const int Rb = Epi::PERM ? ((R & ~31) + perm32(R & 31)) : R;
        voffA[i] = (unsigned)(R * g.lda + C) * 2u; voffB[i] = (unsigned)(Rb * g.ldb + C) * 2u; }
    const size_t kstep = (size_t)(BK * 2);
    const size_t hstepA = (size_t)HALF * g.lda * 2, hstepB = (size_t)HALF * g.ldb * 2;
    const size_t tstepA = 2 * hstepA, tstepB = 2 * hstepB;
    const unsigned ldsw = (unsigned)wid * 1024u;
    const int aoff = lds_byte(wr * 64 + fr, fq * 8), boff = lds_byte(wc * 32 + fr, fq * 8);
#define PG8_SA(b, h) (((b) * 2 + (h)) * HTB)
#define PG8_SB(b, h) ((4 + (b) * 2 + (h)) * HTB)
#define PG8_STAGE(bufoff, gbase, voff) do { _Pragma("unroll") for (int _i = 0; _i < 2; ++_i) \
        __builtin_amdgcn_global_load_lds((const unsigned*)((const char*)(gbase) + (voff)[_i]), (PG8_LAS unsigned*)(lds + (bufoff) + ldsw + _i * 8192), 16, 0, 0); } while (0)
#define PG8_LDA(dst, b, h) do { _Pragma("unroll") for (int m = 0; m < 4; ++m) _Pragma("unroll") for (int k = 0; k < 2; ++k) dst[m][k] = *(const PG8_LAS bf16x8*)(lds + PG8_SA(b, h) + aoff + m * 2048 + k * 1024); } while (0)
#define PG8_LDB(dst, b, h) do { _Pragma("unroll") for (int n = 0; n < 2; ++n) _Pragma("unroll") for (int k = 0; k < 2; ++k) dst[n][k] = *(const PG8_LAS bf16x8*)(lds + PG8_SB(b, h) + boff + n * 2048 + k * 1024); } while (0)
#define PG8_MMA(ai, bj, At, Bt) do { __builtin_amdgcn_s_setprio(1); _Pragma("unroll") for (int m = 0; m < 4; ++m) _Pragma("unroll") for (int n = 0; n < 2; ++n) _Pragma("unroll") for (int k = 0; k < 2; ++k) \
        acc[ai][bj][m][n] = __builtin_amdgcn_mfma_f32_16x16x32_bf16(Bt[n][k], At[m][k], acc[ai][bj][m][n], 0, 0, 0); __builtin_amdgcn_s_setprio(0); } while (0)
#define PG8_WAIT_V(n) asm volatile("s_waitcnt vmcnt(" #n ")" ::: "memory")
#define PG8_WAIT_L(n) asm volatile("s_waitcnt lgkmcnt(" #n ")" ::: "memory")
#define PG8_BAR __builtin_amdgcn_s_barrier()
#define PG8_SCHED __builtin_amdgcn_sched_barrier(0)
    Unit cur, nxt; int ui = 0;
    if (!S.next(0, cur)) return;
    f32x4 acc[2][2][4][2];
#pragma unroll
    for (int a = 0; a < 2; ++a)
#pragma unroll
        for (int b = 0; b < 2; ++b)
#pragma unroll
            for (int m = 0; m < 4; ++m)
#pragma unroll
                for (int n = 0; n < 2; ++n) acc[a][b][m][n] = (f32x4){0.f, 0.f, 0.f, 0.f};
    bf16x8 At[4][2], B0[2][2], B1[2][2];
    const char* cA = (const char*)g.A + (size_t)cur.pm * tstepA; const char* cB = (const char*)g.Bt + (size_t)cur.pn * tstepB;
    S.a_ready(cur);
    if constexpr (SP2) {
        PG8_STAGE(PG8_SB(0, 0), cB, voffB); PG8_STAGE(PG8_SB(0, 1), cB + hstepB, voffB); PG8_STAGE(PG8_SA(0, 0), cA, voffA); PG8_STAGE(PG8_SA(0, 1), cA + hstepA, voffA);
        if (wr == 1) PG8_BAR;
        PG8_WAIT_V(2); PG8_BAR;
        PG8_STAGE(PG8_SB(1, 0), cB + kstep, voffB); PG8_STAGE(PG8_SA(1, 0), cA + kstep, voffA); PG8_STAGE(PG8_SB(1, 1), cB + hstepB + kstep, voffB);
        PG8_WAIT_V(6); PG8_BAR;
    } else {
        PG8_STAGE(PG8_SB(0, 0), cB, voffB); PG8_STAGE(PG8_SA(0, 0), cA, voffA); PG8_STAGE(PG8_SB(0, 1), cB + hstepB, voffB); PG8_STAGE(PG8_SA(0, 1), cA + hstepA, voffA);
        if (wr == 1) PG8_BAR;
        PG8_WAIT_V(4); PG8_BAR;
        PG8_STAGE(PG8_SB(1, 0), cB + kstep, voffB); PG8_STAGE(PG8_SA(1, 0), cA + kstep, voffA); PG8_STAGE(PG8_SB(1, 1), cB + hstepB + kstep, voffB);
        PG8_WAIT_V(6); PG8_BAR;
    }
    for (;;) {
        const bool has_next = S.next(ui + 1, nxt);
        const char* nA = has_next ? (const char*)g.A + (size_t)nxt.pm * tstepA : cA; const char* nB = has_next ? (const char*)g.Bt + (size_t)nxt.pn * tstepB : cB;
        for (int t = 0; t < nt; t += 2) {
            if constexpr (Epi::HAS_MID) { if (t == E.kmid) E.mid(acc, cur, wr, wc, fr, fq); }
            const bool last = (t == nt - 2);
            const char* a1 = cA + (size_t)(t + 1) * kstep;
            const char* a2 = last ? nA : cA + (size_t)(t + 2) * kstep; const char* b2 = last ? nB : cB + (size_t)(t + 2) * kstep;
            const char* a3 = a2 + kstep; const char* b3 = b2 + kstep;
            if (last && has_next) S.a_ready(nxt);
            if constexpr (SP2) {
            PG8_LDB(B0, 0, 0); PG8_LDB(B1, 0, 1); PG8_SCHED; PG8_LDA(At, 0, 0); PG8_STAGE(PG8_SA(1, 1), a1 + hstepA, voffA);
            PG8_WAIT_V(8); PG8_WAIT_L(0); PG8_BAR; PG8_MMA(0, 0, At, B0); PG8_MMA(0, 1, At, B1); PG8_BAR; PG8_SCHED;
            PG8_LDA(At, 0, 1); PG8_STAGE(PG8_SB(0, 0), b2, voffB); PG8_STAGE(PG8_SB(0, 1), b2 + hstepB, voffB); PG8_STAGE(PG8_SA(0, 0), a2, voffA);
            PG8_WAIT_V(8); PG8_WAIT_L(0); PG8_BAR; PG8_MMA(1, 0, At, B0); PG8_MMA(1, 1, At, B1); PG8_BAR; PG8_SCHED;
            PG8_LDB(B0, 1, 0); PG8_LDB(B1, 1, 1); PG8_SCHED; PG8_LDA(At, 1, 0); PG8_STAGE(PG8_SA(0, 1), a2 + hstepA, voffA);
            PG8_WAIT_V(8); PG8_WAIT_L(0); PG8_BAR; PG8_MMA(0, 0, At, B0); PG8_MMA(0, 1, At, B1); PG8_BAR; PG8_SCHED;
            PG8_LDA(At, 1, 1); PG8_STAGE(PG8_SB(1, 0), b3, voffB); PG8_STAGE(PG8_SB(1, 1), b3 + hstepB, voffB); PG8_STAGE(PG8_SA(1, 0), a3, voffA);
            PG8_WAIT_V(8); PG8_WAIT_L(0); PG8_BAR; PG8_MMA(1, 0, At, B0); PG8_MMA(1, 1, At, B1); PG8_BAR; PG8_SCHED;
            } else {
            PG8_LDB(B0, 0, 0); PG8_SCHED; PG8_LDA(At, 0, 0); PG8_STAGE(PG8_SA(1, 1), a1 + hstepA, voffA);
            PG8_WAIT_L(8); PG8_BAR; PG8_WAIT_L(0); PG8_MMA(0, 0, At, B0); PG8_BAR; PG8_SCHED;
            PG8_LDB(B1, 0, 1); PG8_STAGE(PG8_SB(0, 0), b2, voffB);
            PG8_BAR; PG8_WAIT_L(0); PG8_MMA(0, 1, At, B1); PG8_BAR;
            PG8_LDA(At, 0, 1); PG8_STAGE(PG8_SA(0, 0), a2, voffA);
            PG8_BAR; PG8_WAIT_L(0); PG8_MMA(1, 0, At, B0); PG8_BAR; PG8_SCHED;
            PG8_STAGE(PG8_SB(0, 1), b2 + hstepB, voffB);
            PG8_WAIT_V(6); PG8_BAR; PG8_MMA(1, 1, At, B1); PG8_BAR;
            PG8_LDB(B0, 1, 0); PG8_SCHED; PG8_LDA(At, 1, 0); PG8_STAGE(PG8_SA(0, 1), a2 + hstepA, voffA);
            PG8_WAIT_L(8); PG8_BAR; PG8_WAIT_L(0); PG8_MMA(0, 0, At, B0); PG8_BAR; PG8_SCHED;
            PG8_LDB(B1, 1, 1); PG8_STAGE(PG8_SB(1, 0), b3, voffB);
            PG8_BAR; PG8_WAIT_L(0); PG8_MMA(0, 1, At, B1); PG8_BAR;
            PG8_LDA(At, 1, 1); PG8_STAGE(PG8_SA(1, 0), a3, voffA);
            PG8_BAR; PG8_WAIT_L(0); PG8_MMA(1, 0, At, B0); PG8_BAR; PG8_SCHED;
            PG8_STAGE(PG8_SB(1, 1), b3 + hstepB, voffB);
            PG8_WAIT_V(6); PG8_BAR; PG8_MMA(1, 1, At, B1); PG8_BAR;
            }
        }
        if constexpr (ALIGN_EPI) { if (wr == 0) PG8_BAR; }
        if constexpr (!Epi::AFTER_DRAIN) { E(acc, cur, wr, wc, fr, fq); S.done(cur); }
        if (!has_next) break;
#pragma unroll
        for (int a = 0; a < 2; ++a)
#pragma unroll
            for (int b = 0; b < 2; ++b)
#pragma unroll
                for (int m = 0; m < 4; ++m)
#pragma unroll
                    for (int n = 0; n < 2; ++n) acc[a][b][m][n] = (f32x4){0.f, 0.f, 0.f, 0.f};
        cur = nxt; cA = nA; cB = nB; ++ui;
        if constexpr (ALIGN_EPI) { if (wr == 1) PG8_BAR; }
    }
    PG8_WAIT_V(0);
    if constexpr (!ALIGN_EPI) { if (wr == 0) PG8_BAR; }
    PG8_BAR;
    if constexpr (Epi::AFTER_DRAIN) { E.fused(acc, cur, wr, wc, fr, fq, lds, wid, lane); S.done(cur); }
#undef PG8_SA
#undef PG8_SB
#undef PG8_STAGE
#undef PG8_LDA
#undef PG8_LDB
#undef PG8_MMA
#undef PG8_WAIT_V
#undef PG8_WAIT_L
#undef PG8_BAR
#undef PG8_SCHED
}
}

constexpr int NTOK = 16384, DM = 1024, INW = 1280, SSMW = 512, NGRP = 32, NST = 64, SEQL = 2048, NBATCH = 8, DFF = 2816;
constexpr int TCH = 32, NCH = SEQL / TCH  , GROWS = NBATCH * NCH  , KX = 128 + TCH * 16  ;
constexpr size_t MiB = 1u << 20;
constexpr size_t WS_BAR = 0;
constexpr size_t WS_CNT = 16384;
constexpr size_t WS_XB = 65536;
constexpr size_t WS_RSQ = 896 * 1024;
constexpr size_t WS_RS0 = 1 * MiB + 65536;
constexpr size_t WS_XT = 1 * MiB + 131072;
constexpr size_t WS_RSQH = 1 * MiB;
constexpr size_t WS_WIN = 2 * MiB, WS_WGLU = 5 * MiB, WS_WOUT = 6 * MiB, WS_WGU = 8 * MiB, WS_WDN = 19 * MiB;
constexpr size_t WS_TW = 25 * MiB;
constexpr size_t WS_W1 = 45 * MiB;
constexpr size_t WS_AT = 49 * MiB;
constexpr size_t WS_XN = 50 * MiB;
constexpr size_t WS_UX = 162 * MiB;
constexpr size_t WS_Q = 182 * MiB, WS_K = 198 * MiB, WS_VT = 202 * MiB;
constexpr size_t WS_Y = 82 * MiB;
constexpr size_t WS_MG = 98 * MiB;
constexpr size_t WS_ACT = 162 * MiB;
constexpr size_t WS_HB = 130 * MiB;
constexpr size_t WS_END = 250 * MiB;
constexpr int LDS_BYTES = 147456, LDSCTL_OFF = 143360;
constexpr float NORM_EPS = 1e-6f;
constexpr float LOG2E = 1.4426950408889634f;

#define LAS __attribute__((address_space(3)))
typedef unsigned short bf16;
typedef float f32x4 __attribute__((ext_vector_type(4)));
typedef float f32x16 __attribute__((ext_vector_type(16)));
typedef unsigned u32x4 __attribute__((ext_vector_type(4)));
typedef unsigned u32x2 __attribute__((ext_vector_type(2)));
typedef float f32x2 __attribute__((ext_vector_type(2)));
typedef short bf16x8 __attribute__((ext_vector_type(8)));
using pg8::cvt_pk_bf16;

__device__ __forceinline__ float bf_lo(unsigned w) { return __uint_as_float(w << 16); }
__device__ __forceinline__ float bf_hi(unsigned w) { return __uint_as_float(w & 0xffff0000u); }
__device__ __forceinline__ float fast_sigmoid(float x) { return __builtin_amdgcn_rcpf(1.0f + __builtin_amdgcn_exp2f(-x * LOG2E)); }
__device__ __forceinline__ float gelu_tanh(float x) { const float u = 1.5957691216057308f * (x + 0.044715f * x * x * x); return x * fast_sigmoid(u); }
__device__ __forceinline__ float wave_sum(float v) {
#pragma unroll
    for (int o = 1; o < 64; o <<= 1) v += __shfl_xor(v, o);
    return v;
}
__device__ __forceinline__ int crow(int r, int hi) { return (r & 3) + 8 * (r >> 2) + 4 * hi; }

struct Params {
    const float* x; const int* pos; const float* g_pre_mix; const float* w_in; const float* lam_re; const float* lam_im; const float* log_dt;
    const float* b_re; const float* b_im; const float* c_re; const float* c_im; const float* ssm_d; const float* w_glu; const float* b_glu; const float* sinks;
    const float* g_ssm_out; const float* g_attn_out; const float* w_out; const float* g_post_mix; const float* g_pre_ffn; const float* w_gate_up; const float* w_down; const float* g_post_ffn;
    float* out; unsigned char* ws;
};

namespace pg8 {
struct EpiInProj {
    static constexpr bool PERM = true, AFTER_DRAIN = false, HAS_MID = false;
    bf16_t* UX; bf16_t* Q; bf16_t* Kb; bf16_t* VT; const int* pos; const float* rs0;
    __device__ __forceinline__ void operator()(const f32x4 (&acc_)[2][2][4][2], const Unit& u, int wr, int wc, int fr, int fq) const {
        const int row0 = u.pm * BM + wr * 64 + fr;
        f32x4 acc[2][2][4][2];
#pragma unroll
        for (int ai = 0; ai < 2; ++ai)
#pragma unroll
            for (int m = 0; m < 4; ++m) { const float r = rs0[row0 + ai * HALF + m * 16];
#pragma unroll
                for (int bj = 0; bj < 2; ++bj)
#pragma unroll
                    for (int n = 0; n < 2; ++n) acc[ai][bj][m][n] = acc_[ai][bj][m][n] * r; }
        if (u.pn < 2) {
#pragma unroll
            for (int ai = 0; ai < 2; ++ai)
#pragma unroll
                for (int m = 0; m < 4; ++m) { const int tok = row0 + ai * HALF + m * 16;
#pragma unroll
                    for (int bj = 0; bj < 2; ++bj) { const int g = u.pn * 16 + bj * 8 + wc * 2 + (fq >> 1), h0 = 8 * (fq & 1);
                        bf16_t* dst = UX + ((size_t)(g * 512 + (tok >> 5))) * 640 + 128 + (tok & 31) * 16 + h0;
                        const f32x4 v0 = acc[ai][bj][m][0], v1 = acc[ai][bj][m][1]; u32x4 w;
                        w.x = cvt_pk_bf16(v0[0], v0[1]); w.y = cvt_pk_bf16(v0[2], v0[3]); w.z = cvt_pk_bf16(v1[0], v1[1]); w.w = cvt_pk_bf16(v1[2], v1[3]);
                        *(u32x4*)dst = w; } }
        } else {
            const bool isq = u.pn < 4; const bool dorope = (wc & 1) == 0;
            const float qs = 0.125f * 1.4426950408889634f;
#pragma unroll
            for (int ai = 0; ai < 2; ++ai)
#pragma unroll
                for (int m = 0; m < 4; ++m) { const int tok = row0 + ai * HALF + m * 16;
                    float cs0[4], sn0[4], cs1[4], sn1[4];
                    if (dorope) { const float pf = (float)pos[tok];
                        constexpr float IFR[8] = {0.15915494309189535f, 0.03086376340470123f, 0.005985185712713705f, 0.001160663641240061f, 0.00022507907903927653f, 4.364795279280289e-05f, 8.464330808241401e-06f, 1.6414262627950345e-06f};
#pragma unroll
                        for (int j = 0; j < 4; ++j) { const float r0 = __builtin_amdgcn_fractf(pf * IFR[j]), r1 = __builtin_amdgcn_fractf(pf * IFR[4 + j]);
                            cs0[j] = __builtin_amdgcn_cosf(r0); sn0[j] = __builtin_amdgcn_sinf(r0); cs1[j] = __builtin_amdgcn_cosf(r1); sn1[j] = __builtin_amdgcn_sinf(r1); } }
#pragma unroll
                    for (int bj = 0; bj < 2; ++bj) {
                        f32x4 v0 = acc[ai][bj][m][0], v1 = acc[ai][bj][m][1];
                        if (isq || bj == 0) {
                            if (dorope) {
#pragma unroll
                                for (int j = 0; j < 4; ++j) {
                                    const float p0 = __shfl_xor(v0[j], 16), p1 = __shfl_xor(v1[j], 16);
                                    const float c0 = cs0[j], s0 = sn0[j], c1 = cs1[j], s1 = sn1[j];
                                    if (fq == 0) { v0[j] = v0[j] * c0 - p0 * s0; v1[j] = v1[j] * c1 - p1 * s1; }
                                    else if (fq == 1) { v0[j] = v0[j] * c0 + p0 * s0; v1[j] = v1[j] * c1 + p1 * s1; }
                                }
                            }
                            bf16_t* dst;
                            if (isq) { const int head = (u.pn - 2) * 4 + bj * 2 + (wc >> 1); v0 = v0 * qs; v1 = v1 * qs; dst = Q + (size_t)tok * 512 + head * 64 + (wc & 1) * 32 + 8 * fq; }
                            else dst = Kb + (size_t)tok * 128 + (wc >> 1) * 64 + (wc & 1) * 32 + 8 * fq;
                            u32x4 w; w.x = cvt_pk_bf16(v0[0], v0[1]); w.y = cvt_pk_bf16(v0[2], v0[3]); w.z = cvt_pk_bf16(v1[0], v1[1]); w.w = cvt_pk_bf16(v1[2], v1[3]);
                            *(u32x4*)dst = w;
                        } else {
                            const int hk = wc >> 1, d0 = (wc & 1) * 32 + 8 * fq, b = tok >> 11, l = tok & 2047;
                            bf16_t* dst = VT + ((size_t)((b * 2 + hk) * 64 + d0)) * 2048 + l;
#pragma unroll
                            for (int j = 0; j < 4; ++j) { dst[(size_t)j * 2048] = (bf16_t)(cvt_pk_bf16(v0[j], 0.f) & 0xffffu); dst[(size_t)(4 + j) * 2048] = (bf16_t)(cvt_pk_bf16(v1[j], 0.f) & 0xffffu); }
                        }
                    }
                }
        }
    }
};
struct EpiSsmC {
    static constexpr bool PERM = true, AFTER_DRAIN = false, HAS_MID = false;
    const bf16_t* UX; const float* dvec; bf16_t* Y;
    __device__ __forceinline__ void operator()(const f32x4 (&acc)[2][2][4][2], const Unit& u, int wr, int wc, int fr, int fq) const {
        const int g = u.pm >> 1, pmr = u.pm & 1, pnr = u.pn & 1, h0 = 8 * (fq & 1);
        const f32x4 d0 = *(const f32x4*)(dvec + g * 16 + h0), d1 = *(const f32x4*)(dvec + g * 16 + h0 + 4);
#pragma unroll
        for (int ai = 0; ai < 2; ++ai)
#pragma unroll
            for (int m = 0; m < 4; ++m) { const int nloc = pmr * 256 + ai * HALF + wr * 64 + m * 16 + fr;
#pragma unroll
                for (int bj = 0; bj < 2; ++bj) { const int t = pnr * 16 + bj * 8 + wc * 2 + (fq >> 1); const int tok = nloc * 32 + t;
                    const u32x4 uw = *(const u32x4*)(UX + ((size_t)(g * 512 + nloc)) * 640 + 128 + t * 16 + h0);
                    const f32x4 a0 = acc[ai][bj][m][0], a1 = acc[ai][bj][m][1];
                    float y[8];
                    y[0] = a0[0] + d0[0] * bf_lo(uw.x); y[1] = a0[1] + d0[1] * bf_hi(uw.x); y[2] = a0[2] + d0[2] * bf_lo(uw.y); y[3] = a0[3] + d0[3] * bf_hi(uw.y);
                    y[4] = a1[0] + d1[0] * bf_lo(uw.z); y[5] = a1[1] + d1[1] * bf_hi(uw.z); y[6] = a1[2] + d1[2] * bf_lo(uw.w); y[7] = a1[3] + d1[3] * bf_hi(uw.w);
#pragma unroll
                    for (int i = 0; i < 8; ++i) y[i] = gelu_tanh(y[i]);
                    u32x4 w; w.x = cvt_pk_bf16(y[0], y[1]); w.y = cvt_pk_bf16(y[2], y[3]); w.z = cvt_pk_bf16(y[4], y[5]); w.w = cvt_pk_bf16(y[6], y[7]);
                    *(u32x4*)(Y + (size_t)tok * 512 + g * 16 + h0) = w; } }
    }
};
template <int MODE  > struct EpiGated {
    static constexpr bool PERM = true, AFTER_DRAIN = false, HAS_MID = false;
    bf16_t* O; int ldc; const float* bias; float* rowsq;
    __device__ __forceinline__ void operator()(const f32x4 (&acc)[2][2][4][2], const Unit& u, int wr, int wc, int fr, int fq) const {
        const int row0 = u.pm * BM + wr * 64 + fr, col0 = u.pn * HALF + wc * 32 + 8 * fq;
        float rsc[2][4];
        if (MODE == 1) {
#pragma unroll
            for (int ai = 0; ai < 2; ++ai)
#pragma unroll
                for (int m = 0; m < 4; ++m) rsc[ai][m] = 1.0f / sqrtf(rowsq[row0 + ai * HALF + m * 16] * (1.0f / 1024.0f) + 1e-6f);
        }
        f32x4 ba[2], bg[2];
        if (MODE == 0) { ba[0] = *(const f32x4*)(bias + col0); ba[1] = *(const f32x4*)(bias + col0 + 4); bg[0] = *(const f32x4*)(bias + 512 + col0); bg[1] = *(const f32x4*)(bias + 512 + col0 + 4); }
#pragma unroll
        for (int ai = 0; ai < 2; ++ai)
#pragma unroll
            for (int m = 0; m < 4; ++m) { float o[8];
#pragma unroll
                for (int n = 0; n < 2; ++n)
#pragma unroll
                    for (int j = 0; j < 4; ++j) { const float a = (MODE == 1) ? acc[ai][0][m][n][j] * rsc[ai][m] : acc[ai][0][m][n][j], gt = (MODE == 1) ? acc[ai][1][m][n][j] * rsc[ai][m] : acc[ai][1][m][n][j];
                        o[4 * n + j] = (MODE == 0) ? (a + ba[n][j]) * fast_sigmoid(gt + bg[n][j]) : (a * fast_sigmoid(a)) * gt; }
                u32x4 w; w.x = cvt_pk_bf16(o[0], o[1]); w.y = cvt_pk_bf16(o[2], o[3]); w.z = cvt_pk_bf16(o[4], o[5]); w.w = cvt_pk_bf16(o[6], o[7]);
                *(u32x4*)(O + (size_t)(row0 + ai * HALF + m * 16) * ldc + col0) = w;
                if (MODE == 0) { float s = ((o[0] * o[0] + o[1] * o[1]) + (o[2] * o[2] + o[3] * o[3])) + ((o[4] * o[4] + o[5] * o[5]) + (o[6] * o[6] + o[7] * o[7]));
                    s += __shfl_xor(s, 16); s += __shfl_xor(s, 32); if (fq == 0) unsafeAtomicAdd(rowsq + row0 + ai * HALF + m * 16, s); } }
    }
};
struct EpiF32 {
    static constexpr bool PERM = true, AFTER_DRAIN = false, HAS_MID = false;
    float* O; int ldc;
    __device__ __forceinline__ void operator()(const f32x4 (&acc)[2][2][4][2], const Unit& u, int wr, int wc, int fr, int fq) const {
        const int row0 = u.pm * BM + wr * 64 + fr, col0 = u.pn * BM + wc * 32 + 8 * fq;
#pragma unroll
        for (int ai = 0; ai < 2; ++ai)
#pragma unroll
            for (int m = 0; m < 4; ++m) { float* rowp = O + (size_t)(row0 + ai * HALF + m * 16) * ldc + col0;
#pragma unroll
                for (int bj = 0; bj < 2; ++bj) { *(f32x4*)(rowp + bj * HALF) = acc[ai][bj][m][0]; *(f32x4*)(rowp + bj * HALF + 4) = acc[ai][bj][m][1]; } }
    }
};

struct PanelSq {
    float* xbuf;
    unsigned* cnt;
    float eps;
    __device__ __forceinline__ void run(const f32x4 (&v)[2][2][4][2], const Unit& u, int wr, int wc, int fr, int fq, PG8_LAS unsigned char* lds, int wid, int lane) const {
        PG8_LAS float* Pp = (PG8_LAS float*)lds;
        PG8_LAS float* S = (PG8_LAS float*)(lds + 4096);
#pragma unroll
        for (int ai = 0; ai < 2; ++ai)
#pragma unroll
            for (int m = 0; m < 4; ++m) { float s = 0.f;
#pragma unroll
                for (int bj = 0; bj < 2; ++bj)
#pragma unroll
                    for (int n = 0; n < 2; ++n) { const f32x4 x = v[ai][bj][m][n]; s += (x[0] * x[0] + x[1] * x[1]) + (x[2] * x[2] + x[3] * x[3]); }
                s += __shfl_xor(s, 16); s += __shfl_xor(s, 32);
                if (fq == 0) Pp[(ai * HALF + wr * 64 + m * 16 + fr) * 4 + wc] = s; }
        asm volatile("s_waitcnt lgkmcnt(0)" ::: "memory"); __builtin_amdgcn_s_barrier(); asm volatile("" ::: "memory");
        const int row = wid * 32 + (lane & 31);
        if (lane < 32) { const float t = (Pp[row * 4 + 0] + Pp[row * 4 + 1]) + (Pp[row * 4 + 2] + Pp[row * 4 + 3]);
            __hip_atomic_store(xbuf + ((size_t)(u.pm * BM + row) * 4 + u.pn), t, __ATOMIC_RELAXED, __HIP_MEMORY_SCOPE_AGENT); }
        asm volatile("s_waitcnt vmcnt(0)" ::: "memory");
        if (lane == 0) __hip_atomic_fetch_add(cnt + 64 * u.pm, 1u, __ATOMIC_RELAXED, __HIP_MEMORY_SCOPE_AGENT);
        if (wid == 0) { unsigned sp = 0;
            while ((unsigned)__builtin_amdgcn_readfirstlane(__hip_atomic_load(cnt + 64 * u.pm, __ATOMIC_RELAXED, __HIP_MEMORY_SCOPE_AGENT)) < 32u) { __builtin_amdgcn_s_sleep(2); if (++sp > (1u << 22)) break; }
            __builtin_amdgcn_fence(__ATOMIC_ACQUIRE, "agent"); }
        asm volatile("s_waitcnt vmcnt(0) lgkmcnt(0)" ::: "memory"); __builtin_amdgcn_s_barrier(); asm volatile("" ::: "memory");
        if (lane < 32) { const float* slot = xbuf + (size_t)(u.pm * BM + row) * 4; float q = 0.f;
#pragma unroll
            for (int t = 0; t < 4; ++t) q += __hip_atomic_load(slot + t, __ATOMIC_RELAXED, __HIP_MEMORY_SCOPE_AGENT);
            S[row] = 1.0f / sqrtf(q * (1.0f / 1024.0f) + eps); }
        asm volatile("s_waitcnt lgkmcnt(0)" ::: "memory"); __builtin_amdgcn_s_barrier(); asm volatile("" ::: "memory");
    }
};
struct EpiNormResNorm {
    static constexpr bool PERM = true, AFTER_DRAIN = true, HAS_MID = true;
    const bf16_t* base; bf16_t* hb; float* rsq_h; const float* g1; PanelSq st1;
    const PG8_LAS float* tab; int kmid;
    __device__ __forceinline__ void mid(f32x4 (&acc)[2][2][4][2], const Unit& u, int wr, int wc, int fr, int fq) const {
#pragma unroll
        for (int ai = 0; ai < 2; ++ai)
#pragma unroll
            for (int m = 0; m < 4; ++m) { const float f = tab[ai * HALF + wr * 64 + m * 16 + fr];
#pragma unroll
                for (int bj = 0; bj < 2; ++bj)
#pragma unroll
                    for (int n = 0; n < 2; ++n) acc[ai][bj][m][n] = acc[ai][bj][m][n] * f; }
        asm volatile("s_waitcnt lgkmcnt(0)" ::: "memory");
    }
    __device__ __forceinline__ void fused(f32x4 (&acc)[2][2][4][2], const Unit& u, int wr, int wc, int fr, int fq, PG8_LAS unsigned char* lds, int wid, int lane) const {
        const PG8_LAS float* S = (const PG8_LAS float*)(lds + 4096);
        const int col0 = u.pn * BM + wc * 32 + 8 * fq;
#pragma unroll
        for (int ai = 0; ai < 2; ++ai)
#pragma unroll
            for (int m = 0; m < 4; ++m) { const float rb = tab[256 + ai * HALF + wr * 64 + m * 16 + fr];
#pragma unroll
                for (int bj = 0; bj < 2; ++bj)
#pragma unroll
                    for (int n = 0; n < 2; ++n) acc[ai][bj][m][n] = acc[ai][bj][m][n] * rb; }
        st1.run(acc, u, wr, wc, fr, fq, lds, wid, lane);
        f32x4 gv[2][2];
#pragma unroll
        for (int bj = 0; bj < 2; ++bj)
#pragma unroll
            for (int n = 0; n < 2; ++n) gv[bj][n] = *(const f32x4*)(g1 + col0 + bj * HALF + 4 * n);
#pragma unroll
        for (int ai = 0; ai < 2; ++ai)
#pragma unroll
            for (int m = 0; m < 4; ++m) { const int r = ai * HALF + wr * 64 + m * 16 + fr; const float rs = S[r]; const size_t off = (size_t)(u.pm * BM + r) * 1024 + col0;
#pragma unroll
                for (int bj = 0; bj < 2; ++bj) { const u32x4 xw = *(const u32x4*)(base + off + bj * HALF);
                    acc[ai][bj][m][0] = (f32x4){bf_lo(xw.x), bf_hi(xw.x), bf_lo(xw.y), bf_hi(xw.y)} + acc[ai][bj][m][0] * rs * gv[bj][0];
                    acc[ai][bj][m][1] = (f32x4){bf_lo(xw.z), bf_hi(xw.z), bf_lo(xw.w), bf_hi(xw.w)} + acc[ai][bj][m][1] * rs * gv[bj][1]; }
                float s = 0.f;
#pragma unroll
                for (int bj = 0; bj < 2; ++bj) { const f32x4 h0 = acc[ai][bj][m][0], h1 = acc[ai][bj][m][1];
                    s += ((h0[0] * h0[0] + h0[1] * h0[1]) + (h0[2] * h0[2] + h0[3] * h0[3])) + ((h1[0] * h1[0] + h1[1] * h1[1]) + (h1[2] * h1[2] + h1[3] * h1[3]));
                    u32x4 hw; hw.x = cvt_pk_bf16(h0[0], h0[1]); hw.y = cvt_pk_bf16(h0[2], h0[3]); hw.z = cvt_pk_bf16(h1[0], h1[1]); hw.w = cvt_pk_bf16(h1[2], h1[3]); *(u32x4*)(hb + off + bj * HALF) = hw; }
                s += __shfl_xor(s, 16); s += __shfl_xor(s, 32);
                if (fq == 0) unsafeAtomicAdd(rsq_h + u.pm * BM + r, s);
                if (m & 1) asm volatile("" ::: "memory"); }
    }
};
struct EpiNormRes {
    static constexpr bool PERM = true, AFTER_DRAIN = true, HAS_MID = false;
    const bf16_t* base; float* out; const float* g1; PanelSq st;
    __device__ __forceinline__ void fused(f32x4 (&acc)[2][2][4][2], const Unit& u, int wr, int wc, int fr, int fq, PG8_LAS unsigned char* lds, int wid, int lane) const {
        const PG8_LAS float* S = (const PG8_LAS float*)(lds + 4096);
        const int col0 = u.pn * BM + wc * 32 + 8 * fq;
        st.run(acc, u, wr, wc, fr, fq, lds, wid, lane);
        f32x4 gv[2][2];
#pragma unroll
        for (int bj = 0; bj < 2; ++bj)
#pragma unroll
            for (int n = 0; n < 2; ++n) gv[bj][n] = *(const f32x4*)(g1 + col0 + bj * HALF + 4 * n);
#pragma unroll
        for (int ai = 0; ai < 2; ++ai)
#pragma unroll
            for (int m = 0; m < 4; ++m) { const int r = ai * HALF + wr * 64 + m * 16 + fr; const float rs = S[r]; const size_t off = (size_t)(u.pm * BM + r) * 1024 + col0;
#pragma unroll
                for (int bj = 0; bj < 2; ++bj)
                { const u32x4 hw = *(const u32x4*)(base + off + bj * HALF);
                    const f32x4 b0 = (f32x4){bf_lo(hw.x), bf_hi(hw.x), bf_lo(hw.y), bf_hi(hw.y)}, b1 = (f32x4){bf_lo(hw.z), bf_hi(hw.z), bf_lo(hw.w), bf_hi(hw.w)};
                    __builtin_nontemporal_store(b0 + acc[ai][bj][m][0] * rs * gv[bj][0], (f32x4*)(out + off + bj * HALF)); __builtin_nontemporal_store(b1 + acc[ai][bj][m][1] * rs * gv[bj][1], (f32x4*)(out + off + bj * HALF + 4)); }
                if (m & 1) asm volatile("" ::: "memory"); }
    }
};
struct SsmOrder {
    int c;
    __device__ bool next(int i, Unit& u) const { if (i > 0 || c >= 128) return false; const int U = (c & 7) * 16 + (c >> 3), g = U >> 2; u.pm = 2 * g + ((U >> 1) & 1); u.pn = 2 * g + (U & 1); return true; }
    __device__ __forceinline__ void a_ready(const Unit&) const {}
    __device__ __forceinline__ void done(const Unit&) const {}
};
}
__device__ __forceinline__ void transpose_item(const float* W, int K, int N, bf16* WT, int src_col0, int dst_row0, int k0, LAS float* scr, int lane, const float* ks = nullptr) {
    if (ks) {
#pragma unroll 32
        for (int i = 0; i < 32; ++i) { const int kk = 2 * i + (lane >> 5); scr[kk * 33 + (lane & 31)] = __builtin_nontemporal_load(W + (size_t)(k0 + kk) * N + src_col0 + (lane & 31)) * ks[kk]; }
    } else {
#pragma unroll 32
        for (int i = 0; i < 32; ++i) { const int kk = 2 * i + (lane >> 5); scr[kk * 33 + (lane & 31)] = __builtin_nontemporal_load(W + (size_t)(k0 + kk) * N + src_col0 + (lane & 31)); }
    }
    asm volatile("s_waitcnt lgkmcnt(0)" ::: "memory");
    const int c = lane & 7;
#pragma unroll
    for (int j = 0; j < 4; ++j) { const int n = (lane >> 3) + 8 * j; const LAS float* s = scr + (8 * c) * 33 + n;
        u32x4 o; o.x = cvt_pk_bf16(s[0 * 33], s[1 * 33]); o.y = cvt_pk_bf16(s[2 * 33], s[3 * 33]); o.z = cvt_pk_bf16(s[4 * 33], s[5 * 33]); o.w = cvt_pk_bf16(s[6 * 33], s[7 * 33]);
        *(u32x4*)(WT + (size_t)(dst_row0 + n) * K + k0 + 8 * c) = o; }
    asm volatile("s_waitcnt lgkmcnt(0)" ::: "memory");
}
__device__ __forceinline__ int gated_src_col(int n0, int half_off) { const int pn = n0 >> 8, r = n0 & 255; return r < 128 ? 128 * pn + r : half_off + 128 * pn + (r - 128); }

__device__ __forceinline__ void sincos_rev(double ang, float& s, float& c) {
    const double rev = ang * 0.15915494309189533576888; const float fr = (float)(rev - floor(rev));
    s = __builtin_amdgcn_sinf(fr); c = __builtin_amdgcn_cosf(fr);
}

__device__ __forceinline__ void prologue_b(const Params& P, LAS unsigned char* lds, int tid, int lane, int wave, int blk, int G, int which, int wave0 = 0) {
    unsigned char* ws = P.ws;
    for (int item = blk; (which & 1) && item < NGRP * 8; item += G) {
        const int g = item >> 3, part = item & 7;
        LAS f32x2* APW = (LAS f32x2*)lds;
        LAS f32x2* BB = APW + 33 * 64;
        LAS f32x2* CC = BB + 64 * 16;
        LAS float* KT = (LAS float*)(CC + 16 * 64);
        const float dt = expf(P.log_dt[g]);
        for (int e = tid; e < 33 * 64; e += 512) { const int jx = e >> 6, p = e & 63;
            const float lr = fminf(P.lam_re[g * 64 + p], -1e-4f), li = P.lam_im[g * 64 + p];
            const float mag = expf((float)jx * (lr * dt)); float s, c; sincos_rev((double)jx * (double)(li * dt), s, c);
            f32x2 v; v.x = mag * c; v.y = mag * s; APW[e] = v; }
        for (int e = tid; e < 64 * 16; e += 512) { const int p = e >> 4;
            const float lr = fminf(P.lam_re[g * 64 + p], -1e-4f), li = P.lam_im[g * 64 + p];
            const float mag = expf(lr * dt); float s, c; sincos_rev((double)(li * dt), s, c); const float ar = mag * c, ai = mag * s;
            const float den = lr * lr + li * li, fr = ((ar - 1.0f) * lr + ai * li) / den, fi = (ai * lr - (ar - 1.0f) * li) / den;
            const float br = P.b_re[(size_t)g * 1024 + e], bi = P.b_im[(size_t)g * 1024 + e];
            f32x2 v; v.x = fr * br - fi * bi; v.y = fr * bi + fi * br; BB[e] = v;
            f32x2 w; w.x = P.c_re[(size_t)g * 1024 + e]; w.y = P.c_im[(size_t)g * 1024 + e]; CC[e] = w; }
        __syncthreads();
        if (part == 0 && tid < 64) ((f32x2*)(ws + WS_AT))[g * 64 + tid] = APW[32 * 64 + tid];
        {
            const int hh = tid & 255, h = hh >> 4, hp = hh & 15, jl = 2 * (tid >> 8), j0 = 4 * part + jl;
            float k0 = 0.f, k1 = 0.f;
            for (int p = 0; p < 64; ++p) {
                const f32x2 cv = CC[h * 64 + p], bv = BB[p * 16 + hp], w0 = APW[j0 * 64 + p], w1 = APW[(j0 + 1) * 64 + p];
                const float zr = cv.x * bv.x - cv.y * bv.y, zi = cv.x * bv.y + cv.y * bv.x;
                k0 += zr * w0.x - zi * w0.y; k1 += zr * w1.x - zi * w1.y;
            }
            KT[jl * 256 + hh] = k0; KT[(jl + 1) * 256 + hh] = k1;
        }
        __syncthreads();
        bf16* TWg = (bf16*)(ws + WS_TW) + (size_t)g * 512 * 640;
        for (int e = tid; e < 4096; e += 512) {
            const int jj = e >> 10, t = (e >> 5) & 31, h = (e >> 1) & 15, half = e & 1, jx = 4 * part + jj;
            if (t >= jx) { const LAS float* kp = KT + jj * 256 + h * 16 + 8 * half;
                u32x4 w; w.x = cvt_pk_bf16(kp[0], kp[1]); w.y = cvt_pk_bf16(kp[2], kp[3]); w.z = cvt_pk_bf16(kp[4], kp[5]); w.w = cvt_pk_bf16(kp[6], kp[7]);
                *(u32x4*)(TWg + (size_t)(t * 16 + h) * 640 + 128 + (t - jx) * 16 + 8 * half) = w; }
            const int lg = 4 * (7 - part) + jj, s = t + lg;
            if (lg >= 1 && s < 32) *(u32x4*)(TWg + (size_t)(t * 16 + h) * 640 + 128 + s * 16 + 8 * half) = (u32x4){0u, 0u, 0u, 0u};
        }
        for (int e = tid; e < 64 * 16; e += 512) {
            const int rl = e >> 4, c8 = (e & 15) * 8, t = 4 * part + (rl >> 4), h = rl & 15; float v[8];
#pragma unroll
            for (int i = 0; i < 8; ++i) { const int q = c8 + i, p = q & 63; const f32x2 cv = CC[h * 64 + p], wv = APW[(t + 1) * 64 + p];
                v[i] = (q < 64) ? (cv.x * wv.x - cv.y * wv.y) : -(cv.x * wv.y + cv.y * wv.x); }
            u32x4 w; w.x = cvt_pk_bf16(v[0], v[1]); w.y = cvt_pk_bf16(v[2], v[3]); w.z = cvt_pk_bf16(v[4], v[5]); w.w = cvt_pk_bf16(v[6], v[7]);
            *(u32x4*)(TWg + (size_t)(t * 16 + h) * 640 + c8) = w;
        }
        bf16* W1g = (bf16*)(ws + WS_W1) + (size_t)g * 128 * 512;
        for (int e = tid; e < 16 * 64; e += 512) {
            const int q = 16 * part + (e >> 6), c8 = (e & 63) * 8, s = c8 >> 4, hp0 = c8 & 15, p = q & 63; float v[8];
            const f32x2 wv = APW[(31 - s) * 64 + p];
#pragma unroll
            for (int i = 0; i < 8; ++i) { const f32x2 bv = BB[p * 16 + hp0 + i]; v[i] = (q < 64) ? (wv.x * bv.x - wv.y * bv.y) : (wv.x * bv.y + wv.y * bv.x); }
            u32x4 w; w.x = cvt_pk_bf16(v[0], v[1]); w.y = cvt_pk_bf16(v[2], v[3]); w.z = cvt_pk_bf16(v[4], v[5]); w.w = cvt_pk_bf16(v[6], v[7]);
            *(u32x4*)(W1g + (size_t)q * 512 + c8) = w;
        }
        __syncthreads();
    }
    {
        LAS float* scr = (LAS float*)(lds + wave * 16384);
        const int gw = blk * (8 - wave0) + (wave - wave0), NGW = G * (8 - wave0);
        constexpr int I_IN = 16 * 40, I_GLU = 8 * 32, I_OUT = 16 * 32, I_GU = 16 * 176, I_DN = 44 * 32, NIT = I_IN + I_GLU + I_OUT + I_GU + I_DN;
        const int it_lo = (which & 1) ? I_IN : I_IN + I_GLU + I_OUT, it_hi = (which & 2) ? NIT : I_IN + I_GLU + I_OUT;
        for (int it = it_lo + gw; wave >= wave0 && it < it_hi; it += NGW) {
            int r = it;
            if (r < I_IN) { const int nb = r % 40, kb = r / 40; transpose_item(P.w_in, 1024, 1280, (bf16*)(ws + WS_WIN), 32 * nb, 32 * nb, 64 * kb, scr, lane); continue; } r -= I_IN;
            if (r < I_GLU) { const int nb = r % 32, kb = r / 32; transpose_item(P.w_glu, 512, 1024, (bf16*)(ws + WS_WGLU), gated_src_col(32 * nb, 512), 32 * nb, 64 * kb, scr, lane); continue; } r -= I_GLU;
            if (r < I_OUT) { const int nb = r % 32, kb = r / 32; transpose_item(P.w_out, 1024, 1024, (bf16*)(ws + WS_WOUT), 32 * nb, 32 * nb, 64 * kb, scr, lane, kb < 8 ? P.g_ssm_out + 64 * kb : P.g_attn_out + 64 * (kb - 8)); continue; } r -= I_OUT;
            if (r < I_GU) { const int nb = r % 176, kb = r / 176; transpose_item(P.w_gate_up, 1024, 5632, (bf16*)(ws + WS_WGU), gated_src_col(32 * nb, 2816), 32 * nb, 64 * kb, scr, lane, P.g_pre_ffn + 64 * kb); continue; } r -= I_GU;
            { const int nb = r % 32, kb = r / 32; transpose_item(P.w_down, 2816, 1024, (bf16*)(ws + WS_WDN), 32 * nb, 32 * nb, 64 * kb, scr, lane); }
        }
    }
}

__device__ __forceinline__ void prologue_a(const Params& P, LAS unsigned char* lds, int tid, int lane, int wave) {
    unsigned char* ws = P.ws;
    const int G = gridDim.x, blk = blockIdx.x;
    {
        LAS float* scr = (LAS float*)(lds + wave * 16384);
        const int gw = blk * 8 + wave, NGW = G * 8;
        for (int r = gw; r < 16 * 40; r += NGW) { const int nb = r % 40, kb = r / 40; transpose_item(P.w_in, 1024, 1280, (bf16*)(ws + WS_WIN), 32 * nb, 32 * nb, 64 * kb, scr, lane, P.g_pre_mix + 64 * kb); }
        for (int m = gw; m < NTOK; m += NGW) {
            const f32x4* xr = (const f32x4*)(P.x + (size_t)m * DM) + lane; f32x4 v[4]; float s = 0.f;
#pragma unroll
            for (int j = 0; j < 4; ++j) { v[j] = __builtin_nontemporal_load(xr + 64 * j); s += (v[j].x * v[j].x + v[j].y * v[j].y) + (v[j].z * v[j].z + v[j].w * v[j].w); }
            const float rstd = 1.0f / sqrtf(wave_sum(s) * (1.0f / DM) + NORM_EPS);
            if (lane == 0) ((float*)(ws + WS_RS0))[m] = rstd;
            u32x2* o8 = (u32x2*)((bf16*)(ws + WS_XN) + (size_t)m * DM) + lane;
#pragma unroll
            for (int j = 0; j < 4; ++j) { u32x2 w; w.x = cvt_pk_bf16(v[j].x, v[j].y); w.y = cvt_pk_bf16(v[j].z, v[j].w); o8[64 * j] = w; }
        }
        for (int e = blk * 512 + tid; e < NTOK; e += G * 512) { ((float*)(ws + WS_RSQ))[e] = 0.f; ((float*)(ws + WS_RSQH))[e] = 0.f; }
    }
}

__device__ __forceinline__ void ssm_pass_a(const Params& P, int lane, int wave) {
    if (wave >= 2) return;
    unsigned char* ws = P.ws;
    for (int unit = wave * 256 + blockIdx.x; unit < 512; unit += 2 * gridDim.x > 512 ? 512 : 2 * gridDim.x) {
        const int g = unit >> 4, b = (unit >> 1) & 7, hs = unit & 1;
        const int r32 = lane & 31, hi = lane >> 5;
        const int sig = 16 * ((r32 >> 2) & 1) + 4 * (r32 >> 3) + (r32 & 3);
        bf16* UXg = (bf16*)(ws + WS_UX) + ((size_t)(g * 512 + b * 64)) * 640;
        const bf16* a0p = UXg + (size_t)sig * 640 + 128 + 8 * hi;
        const bf16* a1p = a0p + (size_t)32 * 640;
        const bf16* W1g = (const bf16*)(ws + WS_W1) + (size_t)g * 128 * 512;
        const bf16* b0p = W1g + (size_t)(32 * hs + r32) * 512 + 8 * hi;
        const bf16* b1p = b0p + (size_t)64 * 512;
        f32x16 acc[2][2];
#pragma unroll
        for (int i = 0; i < 2; ++i)
#pragma unroll
            for (int j = 0; j < 2; ++j)
#pragma unroll
                for (int r = 0; r < 16; ++r) acc[i][j][r] = 0.f;
#pragma unroll 4
        for (int ks = 0; ks < 32; ++ks) {
            const bf16x8 A0 = *(const bf16x8*)(a0p + 16 * ks), A1 = *(const bf16x8*)(a1p + 16 * ks), B0 = *(const bf16x8*)(b0p + 16 * ks), B1 = *(const bf16x8*)(b1p + 16 * ks);
            acc[0][0] = __builtin_amdgcn_mfma_f32_32x32x16_bf16(A0, B0, acc[0][0], 0, 0, 0);
            acc[0][1] = __builtin_amdgcn_mfma_f32_32x32x16_bf16(A0, B1, acc[0][1], 0, 0, 0);
            acc[1][0] = __builtin_amdgcn_mfma_f32_32x32x16_bf16(A1, B0, acc[1][0], 0, 0, 0);
            acc[1][1] = __builtin_amdgcn_mfma_f32_32x32x16_bf16(A1, B1, acc[1][1], 0, 0, 0);
        }
        const int p = 32 * hs + r32;
        const float2 aT = ((const float2*)(ws + WS_AT))[g * 64 + p];
        float er[2], ei[2];
#pragma unroll
        for (int rt = 0; rt < 2; ++rt) { float lr = 0.f, li = 0.f;
#pragma unroll
            for (int r = 0; r < 16; ++r) { const float nr = aT.x * lr - aT.y * li + acc[rt][0][r], ni = aT.x * li + aT.y * lr + acc[rt][1][r]; lr = nr; li = ni; }
            er[rt] = lr; ei[rt] = li; }
        float pr = aT.x, pi = aT.y;
#pragma unroll
        for (int k = 0; k < 4; ++k) { const float nr = pr * pr - pi * pi, ni = 2.f * pr * pi; pr = nr; pi = ni; }
        const float x0r = __shfl_xor(er[0], 32), x0i = __shfl_xor(ei[0], 32);
        const float s0r = hi ? x0r : 0.f, s0i = hi ? x0i : 0.f;
        const float ebr = pr * s0r - pi * s0i + er[0], ebi = pr * s0i + pi * s0r + ei[0];
        const float y0r = __shfl_xor(ebr, 32), y0i = __shfl_xor(ebi, 32);
        const float ecr = pr * y0r - pi * y0i + er[1], eci = pr * y0i + pi * y0r + ei[1];
        const float z0r = __shfl_xor(ecr, 32), z0i = __shfl_xor(eci, 32);
        const float s1r = hi ? z0r : y0r, s1i = hi ? z0i : y0i;
#pragma unroll
        for (int rt = 0; rt < 2; ++rt) { float cr = rt ? s1r : s0r, ci = rt ? s1i : s0i;
            bf16* xo = UXg + (size_t)(32 * rt + 16 * hi) * 640 + p;
#pragma unroll
            for (int r = 0; r < 16; ++r) {
                xo[(size_t)r * 640] = (bf16)(cvt_pk_bf16(cr, 0.f) & 0xffffu); xo[(size_t)r * 640 + 64] = (bf16)(cvt_pk_bf16(ci, 0.f) & 0xffffu);
                const float nr = aT.x * cr - aT.y * ci + acc[rt][0][r], ni = aT.x * ci + aT.y * cr + acc[rt][1][r]; cr = nr; ci = ni; }
        }
    }
}

__device__ __forceinline__ void attn_phase(const Params& P, LAS unsigned char* lds, int tid, int lane, int wave, int unit0, int nunits) {
    unsigned char* ws = P.ws;
    const bf16* Q = (const bf16*)(ws + WS_Q); const bf16* Kb = (const bf16*)(ws + WS_K); const bf16* VT = (const bf16*)(ws + WS_VT); bf16* MG = (bf16*)(ws + WS_MG);
    const int r32 = lane & 31, hi = lane >> 5;
    const int h = wave, hk = h >> 2;
    const float sink2 = P.sinks[h] * LOG2E;
    constexpr int KST = 272, VST = 392, VOFF = 192 * KST;
#pragma unroll 1
    for (int unit = unit0; unit < unit0 + nunits; ++unit) {
        const int b = unit >> 5, l0 = (unit & 31) * 64, tokb = b * SEQL;
        LAS float* rsq = (LAS float*)(lds + 139264);
        if (tid < 64) rsq[tid] = 0.f;
        {
            u32x4 kv[6], vv[6];
#pragma unroll
            for (int i = 0; i < 6; ++i) { const int p = tid + 512 * i, row = p >> 4, c16 = p & 15; int t = l0 - 128 + row; t = t < 0 ? t + 128 : t;
                kv[i] = *(const u32x4*)(Kb + (size_t)(tokb + t) * 128 + c16 * 8); }
#pragma unroll
            for (int i = 0; i < 6; ++i) { const int p = tid + 512 * i, row = p / 24, c = p % 24; int k0 = l0 - 128 + 8 * c; k0 = k0 < 0 ? k0 + 128 : k0;
                vv[i] = *(const u32x4*)(VT + ((size_t)(b * 128 + row)) * SEQL + k0); }
#pragma unroll
            for (int i = 0; i < 6; ++i) { const int p = tid + 512 * i, row = p >> 4, c16 = p & 15; *(LAS u32x4*)(lds + row * KST + c16 * 16) = kv[i]; }
#pragma unroll
            for (int i = 0; i < 6; ++i) { const int p = tid + 512 * i, row = p / 24, c = p % 24; LAS u32x2* d = (LAS u32x2*)(lds + VOFF + row * VST + c * 16);
                u32x2 a, bq; a.x = vv[i].x; a.y = vv[i].y; bq.x = vv[i].z; bq.y = vv[i].w; d[0] = a; d[1] = bq; }
        }
        __syncthreads();
#pragma unroll 1
        for (int sub = 0; sub < 2; ++sub) {
            const int q0 = l0 + 32 * sub;
            bf16x8 qf[4];
#pragma unroll
            for (int ds = 0; ds < 4; ++ds) qf[ds] = *(const bf16x8*)(Q + (size_t)(tokb + q0 + r32) * 512 + h * 64 + 16 * ds + 8 * hi);
            f32x16 s[5];
#pragma unroll
            for (int kt = 0; kt < 5; ++kt) {
#pragma unroll
                for (int r = 0; r < 16; ++r) s[kt][r] = 0.f;
                const LAS unsigned char* kp = lds + (32 * (kt + sub) + r32) * KST + hk * 128 + hi * 16;
#pragma unroll
                for (int ds = 0; ds < 4; ++ds) { const bf16x8 kf = *(const LAS bf16x8*)(kp + ds * 32); s[kt] = __builtin_amdgcn_mfma_f32_32x32x16_bf16(kf, qf[ds], s[kt], 0, 0, 0); }
                if (kt < 4) { const bool dead = (q0 - 128 + 32 * kt) < 0;
#pragma unroll
                    for (int r = 0; r < 16; ++r) s[kt][r] = dead ? -1e30f : s[kt][r]; }
            }
#pragma unroll
            for (int r = 0; r < 16; ++r) { const int cr = crow(r, hi); if (cr <= r32) s[0][r] = -1e30f; if (cr > r32) s[4][r] = -1e30f; }
            float m = sink2;
#pragma unroll
            for (int kt = 0; kt < 5; ++kt)
#pragma unroll
                for (int r = 0; r < 16; ++r) m = fmaxf(m, s[kt][r]);
            m = fmaxf(m, __shfl_xor(m, 32));
            float sum = 0.f;
#pragma unroll
            for (int kt = 0; kt < 5; ++kt)
#pragma unroll
                for (int r = 0; r < 16; ++r) { const float pv = __builtin_amdgcn_exp2f(s[kt][r] - m); s[kt][r] = pv; sum += pv; }
            sum += __shfl_xor(sum, 32);
            const float inv = 1.0f / (sum + __builtin_amdgcn_exp2f(sink2 - m));
            __builtin_amdgcn_sched_barrier(0);
            f32x16 o[2];
#pragma unroll
            for (int r = 0; r < 16; ++r) { o[0][r] = 0.f; o[1][r] = 0.f; }
#pragma unroll
            for (int kt = 0; kt < 5; ++kt) {
#pragma unroll
                for (int ks = 0; ks < 2; ++ks) {
                    u32x4 pw; pw.x = cvt_pk_bf16(s[kt][8 * ks + 0], s[kt][8 * ks + 1]); pw.y = cvt_pk_bf16(s[kt][8 * ks + 2], s[kt][8 * ks + 3]);
                    pw.z = cvt_pk_bf16(s[kt][8 * ks + 4], s[kt][8 * ks + 5]); pw.w = cvt_pk_bf16(s[kt][8 * ks + 6], s[kt][8 * ks + 7]);
                    const bf16x8 pa = __builtin_bit_cast(bf16x8, pw);
#pragma unroll
                    for (int dt = 0; dt < 2; ++dt) {
                        const LAS unsigned char* vp = lds + VOFF + (hk * 64 + 32 * dt + r32) * VST + (32 * (kt + sub) + 16 * ks + 4 * hi) * 2;
                        const u32x2 lo = *(const LAS u32x2*)vp, hi2 = *(const LAS u32x2*)(vp + 16);
                        u32x4 vw; vw.x = lo.x; vw.y = lo.y; vw.z = hi2.x; vw.w = hi2.y;
                        o[dt] = __builtin_amdgcn_mfma_f32_32x32x16_bf16(pa, __builtin_bit_cast(bf16x8, vw), o[dt], 0, 0, 0);
                    }
                }
            }
            {
                LAS unsigned short* stg = (LAS unsigned short*)(lds + 102400 + wave * 4608);
#pragma unroll
                for (int r = 0; r < 16; ++r) { const int cr = crow(r, hi); const float iv = __shfl(inv, cr);
                    stg[cr * 72 + r32] = (unsigned short)(cvt_pk_bf16(o[0][r] * iv, 0.f) & 0xffffu); stg[cr * 72 + 32 + r32] = (unsigned short)(cvt_pk_bf16(o[1][r] * iv, 0.f) & 0xffffu); }
                asm volatile("s_waitcnt lgkmcnt(0)" ::: "memory");
                const int row = lane >> 1, hf = lane & 1; float sq = 0.f;
                bf16* dst = MG + (size_t)(tokb + q0 + row) * 1024 + 512 + h * 64 + hf * 32;
#pragma unroll
                for (int i = 0; i < 4; ++i) { const u32x4 w = *(const LAS u32x4*)(stg + row * 72 + hf * 32 + 8 * i);
                    const float a0 = bf_lo(w.x), a1 = bf_hi(w.x), a2 = bf_lo(w.y), a3 = bf_hi(w.y), a4 = bf_lo(w.z), a5 = bf_hi(w.z), a6 = bf_lo(w.w), a7 = bf_hi(w.w);
                    sq += ((a0 * a0 + a1 * a1) + (a2 * a2 + a3 * a3)) + ((a4 * a4 + a5 * a5) + (a6 * a6 + a7 * a7));
                    *(u32x4*)(dst + 8 * i) = w; }
                sq += __shfl_xor(sq, 1);
                if (hf == 0) __builtin_amdgcn_ds_faddf(rsq + 32 * sub + row, sq, 0, 0, false);
                asm volatile("s_waitcnt lgkmcnt(0)" ::: "memory");
            }
        }
        __syncthreads();
        if (tid < 64) ((float*)(ws + WS_RSQ))[NTOK + tokb + l0 + tid] = rsq[tid];
        __syncthreads();
    }
}

#define XB_TMO      128
#define XB_XCNT(j)  (256  + 64 * (j))
#define XB_XSUB(j)  (1280 + 64 * (j))
#define XB_XGEN(j)  (2304 + 64 * (j))
#define XB_TOP      3328
#define XB_TOPGEN   3392
#define XCD_BAR_WORDS 3456
#define XB_SPIN_CAP (1u << 18)

__device__ __forceinline__ unsigned xb_ld(unsigned* p)              { return __hip_atomic_load(p, __ATOMIC_RELAXED, __HIP_MEMORY_SCOPE_AGENT); }
__device__ __forceinline__ unsigned xb_add(unsigned* p, unsigned v) { return __hip_atomic_fetch_add(p, v, __ATOMIC_RELAXED, __HIP_MEMORY_SCOPE_AGENT); }
__device__ __forceinline__ unsigned xb_xcc_id() { return (unsigned)__builtin_amdgcn_s_getreg((3 << 11) | 20) & 0xFu; }
#define XB_SPIN(cond, bar) do { unsigned _sp = 0; while (cond) { __builtin_amdgcn_s_sleep(1); \
    if ((++_sp & 255u) == 0u) { if (xb_ld(&(bar)[XB_TMO])) break; if (_sp > XB_SPIN_CAP) { atomicAdd(&(bar)[XB_TMO], 1u); break; } } } } while (0)

struct XcdBarrier {
    unsigned* bar; unsigned x;
    volatile LAS unsigned* st;
};

__device__ __forceinline__ XcdBarrier xcd_barrier_post(unsigned* bar, volatile LAS unsigned* st) {
    XcdBarrier b; b.bar = bar; b.x = xb_xcc_id(); b.st = st;
    if (threadIdx.x == 0) (void)xb_add(&bar[XB_XCNT(b.x)], 1u);
    return b;
}
__device__ __forceinline__ void xcd_barrier_complete(unsigned* bar, unsigned x, unsigned& nloc, unsigned& nx) {
    const unsigned G = gridDim.x * gridDim.y * gridDim.z;
    unsigned sum, cnt, mine, sp = 0u;
    for (;;) {
        sum = 0u; cnt = 0u; mine = 0u;
#pragma unroll
        for (unsigned j = 0; j < 16; ++j) { const unsigned c = xb_ld(&bar[XB_XCNT(j)]); sum += c; cnt += (c > 0u) ? 1u : 0u; mine = (j == x) ? c : mine; }
        if (sum == G) break;
        __builtin_amdgcn_s_sleep(1);
        if ((++sp & 255u) == 0u) { if (xb_ld(&bar[XB_TMO])) break; if (sp > XB_SPIN_CAP) { atomicAdd(&bar[XB_TMO], 1u); break; } }
    }
    nloc = mine > 0u ? mine : 1u; nx = cnt > 0u ? cnt : 1u;
}

__device__ __forceinline__ void xcd_barrier(const XcdBarrier& b) {
    asm volatile("s_waitcnt vmcnt(0)" ::: "memory");
    __syncthreads();
    if (threadIdx.x == 0) {
        unsigned* bar = b.bar;
        __builtin_amdgcn_s_waitcnt(0);
        unsigned nloc = b.st[0], nx = b.st[1];
        if (nloc == 0u) { xcd_barrier_complete(bar, b.x, nloc, nx); b.st[0] = nloc; b.st[1] = nx; }
        const unsigned old = xb_add(&bar[XB_XSUB(b.x)], 1u);
        const unsigned gen = old / nloc;
        if (old + 1u == (gen + 1u) * nloc) {
            __builtin_amdgcn_fence(__ATOMIC_RELEASE, "agent");
            asm volatile("s_waitcnt vmcnt(0)" ::: "memory");
            const unsigned og = xb_add(&bar[XB_TOP], 1u);
            const unsigned tg = og / nx;
            if (og + 1u == (tg + 1u) * nx) xb_add(&bar[XB_TOPGEN], 1u);
            else XB_SPIN(xb_ld(&bar[XB_TOPGEN]) == tg, bar);
            __builtin_amdgcn_fence(__ATOMIC_ACQUIRE, "agent");
            xb_add(&bar[XB_XGEN(b.x)], 1u);
            asm volatile("s_waitcnt vmcnt(0)" ::: "memory");
        } else {
            XB_SPIN(xb_ld(&bar[XB_XGEN(b.x)]) == gen, bar);
            __builtin_amdgcn_fence(__ATOMIC_ACQUIRE, "agent");
            asm volatile("s_waitcnt vmcnt(0)" ::: "memory");
        }
    }
    __syncthreads();
}

__device__ __forceinline__ void quad_sync(unsigned* cnt, unsigned target, bool fast) {
    asm volatile("s_waitcnt vmcnt(0)" ::: "memory");
    __syncthreads();
    if (threadIdx.x == 0) {
        if (!fast) { __builtin_amdgcn_fence(__ATOMIC_RELEASE, "agent"); asm volatile("s_waitcnt vmcnt(0)" ::: "memory"); }
        (void)xb_add(cnt, 1u);
        unsigned sp = 0u; while (xb_ld(cnt) < target) { __builtin_amdgcn_s_sleep(1); if (++sp > (1u << 22)) break; }
        __builtin_amdgcn_fence(__ATOMIC_ACQUIRE, "agent");
        asm volatile("s_waitcnt vmcnt(0)" ::: "memory");
    }
    __syncthreads();
}

__global__ void __launch_bounds__(512, 2) fwd_megakernel(Params P) {
    extern __shared__ __attribute__((aligned(16))) unsigned char lds_raw[];
    LAS unsigned char* lds = (LAS unsigned char*)lds_raw;
    const int tid = threadIdx.x, lane = tid & 63, wave = __builtin_amdgcn_readfirstlane(tid >> 6);
    const int G = gridDim.x, blk = blockIdx.x;
    unsigned char* ws = P.ws;
    typedef pg8::bf16_t bt;

    if (tid < 4) ((LAS unsigned*)(lds + LDSCTL_OFF))[tid] = 0u;
    __syncthreads();
    const XcdBarrier bar = xcd_barrier_post((unsigned*)(ws + WS_BAR), (volatile LAS unsigned*)(lds + LDSCTL_OFF));
    if (tid == 0) __hip_atomic_store((unsigned*)(ws + WS_XT) + blk, bar.x, __ATOMIC_RELAXED, __HIP_MEMORY_SCOPE_AGENT);
    prologue_a(P, lds, tid, lane, wave);
    xcd_barrier(bar);
    {
        pg8::Gemm g{(const bt*)(ws + WS_XN), (const bt*)(ws + WS_WIN), NTOK, INW, DM, DM, DM}; pg8::StaticOrder S; S.init(NTOK, INW, G, blk);
        pg8::EpiInProj E{(bt*)(ws + WS_UX), (bt*)(ws + WS_Q), (bt*)(ws + WS_K), (bt*)(ws + WS_VT), P.pos, (const float*)(ws + WS_RS0)};
        pg8::gemm_phase<pg8::EpiInProj, pg8::StaticOrder, true, true>(lds, g, S, E);
    }
    if (G == 256) { if (blk >= 64) prologue_b(P, lds, tid, lane, wave, blk - 64, 192, 1); } else prologue_b(P, lds, tid, lane, wave, blk, G, 3);
    xcd_barrier(bar);
    ssm_pass_a(P, lane, wave);
    prologue_b(P, lds, tid, lane, wave, blk, G, 2, 2);
    xcd_barrier(bar);
    {
        pg8::Gemm g{(const bt*)(ws + WS_UX), (const bt*)(ws + WS_TW), NGRP * GROWS, NGRP * 512, KX, KX, KX}; pg8::SsmOrder S{blk};
        pg8::EpiSsmC E{(const bt*)(ws + WS_UX), P.ssm_d, (bt*)(ws + WS_Y)};
        pg8::gemm_phase<pg8::EpiSsmC, pg8::SsmOrder, true, true>(lds, g, S, E);
        if (G == 256) { if (blk >= 128) attn_phase(P, lds, tid, lane, wave, (blk - 128) * 2, 2); }
        else for (int u = blk; u < 256; u += G) attn_phase(P, lds, tid, lane, wave, u, 1);
    }
    xcd_barrier(bar);
    const bool quads = (G == 256);
    bool qfast = false; unsigned* qcnt = (unsigned*)(ws + WS_CNT) + 4096;
    if (quads) { const int x = blk & 7, p = (blk >> 3) & 7; unsigned* xt = (unsigned*)(ws + WS_XT);
        const unsigned x0 = xb_ld(xt + x + 8 * p), x1 = xb_ld(xt + x + 8 * (p + 8)), x2 = xb_ld(xt + x + 8 * (p + 16)), x3 = xb_ld(xt + x + 8 * (p + 24));
        qfast = (x0 == x1) && (x1 == x2) && (x2 == x3); qcnt += 64 * (8 * x + p); }
    {
        pg8::Gemm g{(const bt*)(ws + WS_Y), (const bt*)(ws + WS_WGLU), NTOK, 1024, 512, 512, 512}; pg8::StaticOrder S; S.init(NTOK, 1024, G, blk);
        pg8::EpiGated<0> E{(bt*)(ws + WS_MG), 1024, P.b_glu, (float*)(ws + WS_RSQ)};
        pg8::gemm_phase<pg8::EpiGated<0>, pg8::StaticOrder, true, true>(lds, g, S, E);
    }
    if (quads) quad_sync(qcnt, 4u, qfast); else xcd_barrier(bar);
    {
        pg8::Gemm g{(const bt*)(ws + WS_MG), (const bt*)(ws + WS_WOUT), NTOK, DM, DM, DM, DM}; pg8::StaticOrder S; S.init(NTOK, DM, G, blk);
        pg8::PanelSq st1{(float*)(ws + WS_XB), (unsigned*)(ws + WS_CNT), NORM_EPS};
        LAS float* tab = (LAS float*)(lds + LDSCTL_OFF + 64);
        { pg8::Unit u0; if (S.next(0, u0) && tid < 256) { const int row = u0.pm * 256 + tid; const float sa = ((const float*)(ws + WS_RSQ))[row] * (1.0f / 512.0f) + NORM_EPS, sb = ((const float*)(ws + WS_RSQ))[NTOK + row] * (1.0f / 512.0f) + NORM_EPS;
            tab[tid] = sqrtf(sb / sa); tab[256 + tid] = 1.0f / sqrtf(sb); } }
        __syncthreads();
        pg8::EpiNormResNorm E{(const bt*)(ws + WS_XN), (bt*)(ws + WS_HB), (float*)(ws + WS_RSQH), P.g_post_mix, st1, tab, 8};
        pg8::gemm_phase<pg8::EpiNormResNorm, pg8::StaticOrder, false, true>(lds, g, S, E);
    }
    if (quads) quad_sync(qcnt, 8u, qfast); else xcd_barrier(bar);
    {
        pg8::Gemm g{(const bt*)(ws + WS_HB), (const bt*)(ws + WS_WGU), NTOK, 2 * DFF, DM, DM, DM}; pg8::StaticOrder S; S.init(NTOK, 2 * DFF, G, blk);
        pg8::EpiGated<1> E{(bt*)(ws + WS_ACT), DFF, nullptr, (float*)(ws + WS_RSQH)};
        pg8::gemm_phase<pg8::EpiGated<1>, pg8::StaticOrder, true, true>(lds, g, S, E);
    }
    if (quads) quad_sync(qcnt, 12u, qfast); else xcd_barrier(bar);
    {
        pg8::Gemm g{(const bt*)(ws + WS_ACT), (const bt*)(ws + WS_WDN), NTOK, DM, DFF, DFF, DFF}; pg8::StaticOrder S; S.init(NTOK, DM, G, blk);
        pg8::PanelSq st{(float*)(ws + WS_XB) + 2 * NTOK * 4, (unsigned*)(ws + WS_CNT) + 2 * 4096, NORM_EPS};
        pg8::EpiNormRes E{(const bt*)(ws + WS_HB), P.out, P.g_post_ffn, st};
        pg8::gemm_phase<pg8::EpiNormRes, pg8::StaticOrder, false, true>(lds, g, S, E);
    }
}

extern "C" void kernel_launch(void* const* d_in, const int* in_sizes, int n_in, void* d_out, int out_size, void* d_ws, size_t ws_size, hipStream_t stream) {
    static int grid_blocks = 0;
    if (grid_blocks == 0) {
        int dev = 0, cus = 0, per_cu = 0;
        hipGetDevice(&dev);
        hipDeviceGetAttribute(&cus, hipDeviceAttributeMultiprocessorCount, dev);
        hipFuncSetAttribute((const void*)fwd_megakernel, hipFuncAttributeMaxDynamicSharedMemorySize, LDS_BYTES);
        hipOccupancyMaxActiveBlocksPerMultiprocessor(&per_cu, (const void*)fwd_megakernel, 512, LDS_BYTES);
        if (per_cu < 1) { fprintf(stderr, "kernel_launch: occupancy query reports %d blocks per CU\n", per_cu); per_cu = 1; }
        grid_blocks = cus * 1;
        (void)hipGetLastError();
    }
    Params p{};
    p.x = (const float*)d_in[0]; p.pos = (const int*)d_in[1]; p.g_pre_mix = (const float*)d_in[2]; p.w_in = (const float*)d_in[3]; p.lam_re = (const float*)d_in[4]; p.lam_im = (const float*)d_in[5];
    p.log_dt = (const float*)d_in[6]; p.b_re = (const float*)d_in[7]; p.b_im = (const float*)d_in[8]; p.c_re = (const float*)d_in[9]; p.c_im = (const float*)d_in[10]; p.ssm_d = (const float*)d_in[11];
    p.w_glu = (const float*)d_in[12]; p.b_glu = (const float*)d_in[13]; p.sinks = (const float*)d_in[14]; p.g_ssm_out = (const float*)d_in[15]; p.g_attn_out = (const float*)d_in[16]; p.w_out = (const float*)d_in[17];
    p.g_post_mix = (const float*)d_in[18]; p.g_pre_ffn = (const float*)d_in[19]; p.w_gate_up = (const float*)d_in[20]; p.w_down = (const float*)d_in[21]; p.g_post_ffn = (const float*)d_in[22];
    p.out = (float*)d_out; p.ws = (unsigned char*)d_ws;
    (void)hipMemsetAsync(d_ws, 0, 65536, stream);
    void* args[] = {&p};
    hipError_t e = hipLaunchCooperativeKernel((const void*)fwd_megakernel, dim3(grid_blocks), dim3(512), args, LDS_BYTES, stream);
    if (e != hipSuccess) fprintf(stderr, "cooperative launch failed: %s (grid %d)\n", hipGetErrorString(e), grid_blocks);
}
```

```cpp
#include <hip/hip_runtime.h>
#include <hip/hip_cooperative_groups.h>
#include <cstdio>
#include <cstdint>
namespace cg = cooperative_groups;
namespace pg8 {
#define PG8_LAS __attribute__((address_space(3)))
typedef unsigned short bf16_t;
typedef short bf16x8 __attribute__((ext_vector_type(8)));
typedef float f32x4 __attribute__((ext_vector_type(4)));
typedef unsigned u32x4 __attribute__((ext_vector_type(4)));
constexpr int BM = 256, BK = 64, HALF = 128, HTB = HALF * BK * 2  , STAGE_BYTES = 8 * HTB, NXCD = 8, WGM = 8;

__host__ __device__ __forceinline__ int lds_byte(int r, int c) { const int st = (r >> 4) * 2 + (c >> 5), rr = r & 15, cc = c & 31, ob = rr * 64 + cc * 2; return st * 1024 + (ob ^ (((ob >> 9) & 1) << 5)); }
__host__ __device__ __forceinline__ void stage_rc(int b, int& R, int& C) { const int st = b / 1024, sb = b % 1024, swz = sb ^ (((sb >> 9) & 1) << 5); R = (st >> 1) * 16 + swz / 64; C = (st & 1) * 32 + (swz % 64) / 2; }
__host__ __device__ __forceinline__ int perm32(int rho) { const int n = rho >> 4, i = rho & 15; return 8 * (i >> 2) + 4 * n + (i & 3); }

struct Unit { int pm, pn; };
struct Gemm { const bf16_t* A; const bf16_t* Bt; int M, N, K, lda, ldb; };

struct StaticOrder {
    int nM, nN, nwg, G, c;
    __host__ __device__ void init(int M, int N, int G_, int c_) { nM = M / BM; nN = N / BM; nwg = nM * nN; G = G_; c = c_; }
    __host__ __device__ bool next(int i, Unit& u) const {
        const long L = (long)i * G + c; if (L >= nwg) return false;
        int wgid = (int)L; { const int q = nwg / NXCD, r = nwg % NXCD, xcd = wgid % NXCD, off = wgid / NXCD; wgid = (xcd < r ? xcd * (q + 1) : r * (q + 1) + (xcd - r) * q) + off; }
        const int nig = WGM * nN, gid = wgid / nig, fm = gid * WGM, gsz = (nM - fm) < WGM ? (nM - fm) : WGM;
        u.pm = fm + ((wgid % nig) % gsz); u.pn = (wgid % nig) / gsz; return true;
    }
    __device__ __forceinline__ void a_ready(const Unit&) const {}
    __device__ __forceinline__ void done(const Unit&) const {}
};

__device__ __forceinline__ unsigned cvt_pk_bf16(float lo, float hi) { unsigned r; asm volatile("v_cvt_pk_bf16_f32 %0, %1, %2" : "=v"(r) : "v"(lo), "v"(hi)); return r; }
template <class Epi, class Sched, bool ALIGN_EPI = false, bool SP2 = false>
__device__ __forceinline__ void gemm_phase(PG8_LAS unsigned char* lds, const Gemm g, const Sched& S, const Epi& E) {
    const int tid = threadIdx.x, wid = __builtin_amdgcn_readfirstlane(tid >> 6), lane = tid & 63, wr = wid >> 2, wc = wid & 3, fr = lane & 15, fq = lane >> 4;
    const int K = g.K, nt = K / BK;
    unsigned voffA[2], voffB[2];
#pragma unroll
    for (int i = 0; i < 2; ++i) { int R, C; stage_rc(tid * 16 + i * 8192, R, C); const int Rb = Epi::PERM ? ((R & ~31) + perm32(R & 31)) : R;
        voffA[i] = (unsigned)(R * g.lda + C) * 2u; voffB[i] = (unsigned)(Rb * g.ldb + C) * 2u; }
    const size_t kstep = (size_t)(BK * 2);
    const size_t hstepA = (size_t)HALF * g.lda * 2, hstepB = (size_t)HALF * g.ldb * 2;
    const size_t tstepA = 2 * hstepA, tstepB = 2 * hstepB;
    const unsigned ldsw = (unsigned)wid * 1024u;
    const int aoff = lds_byte(wr * 64 + fr, fq * 8), boff = lds_byte(wc * 32 + fr, fq * 8);
#define PG8_SA(b, h) (((b) * 2 + (h)) * HTB)
#define PG8_SB(b, h) ((4 + (b) * 2 + (h)) * HTB)
#define PG8_STAGE(bufoff, gbase, voff) do { _Pragma("unroll") for (int _i = 0; _i < 2; ++_i) \
        __builtin_amdgcn_global_load_lds((const unsigned*)((const char*)(gbase) + (voff)[_i]), (PG8_LAS unsigned*)(lds + (bufoff) + ldsw + _i * 8192), 16, 0, 0); } while (0)
#define PG8_LDA(dst, b, h) do { _Pragma("unroll") for (int m = 0; m < 4; ++m) _Pragma("unroll") for (int k = 0; k < 2; ++k) dst[m][k] = *(const PG8_LAS bf16x8*)(lds + PG8_SA(b, h) + aoff + m * 2048 + k * 1024); } while (0)
#define PG8_LDB(dst, b, h) do { _Pragma("unroll") for (int n = 0; n < 2; ++n) _Pragma("unroll") for (int k = 0; k < 2; ++k) dst[n][k] = *(const PG8_LAS bf16x8*)(lds + PG8_SB(b, h) + boff + n * 2048 + k * 1024); } while (0)
#define PG8_MMA(ai, bj, At, Bt) do { __builtin_amdgcn_s_setprio(1); _Pragma("unroll") for (int m = 0; m < 4; ++m) _Pragma("unroll") for (int n = 0; n < 2; ++n) _Pragma("unroll") for (int k = 0; k < 2; ++k) \
        acc[ai][bj][m][n] = __builtin_amdgcn_mfma_f32_16x16x32_bf16(Bt[n][k], At[m][k], acc[ai][bj][m][n], 0, 0, 0); __builtin_amdgcn_s_setprio(0); } while (0)
#define PG8_WAIT_V(n) asm volatile("s_waitcnt vmcnt(" #n ")" ::: "memory")
#define PG8_WAIT_L(n) asm volatile("s_waitcnt lgkmcnt(" #n ")" ::: "memory")
#define PG8_BAR __builtin_amdgcn_s_barrier()
#define PG8_SCHED __builtin_amdgcn_sched_barrier(0)
    Unit cur, nxt; int ui = 0;
    if (!S.next(0, cur)) return;
    f32x4 acc[2][2][4][2];
#pragma unroll
    for (int a = 0; a < 2; ++a)
#pragma unroll
        for (int b = 0; b < 2; ++b)
#pragma unroll
            for (int m = 0; m < 4; ++m)
#pragma unroll
                for (int n = 0; n < 2; ++n) acc[a][b][m][n] = (f32x4){0.f, 0.f, 0.f, 0.f};
    bf16x8 At[4][2], B0[2][2], B1[2][2];
    const char* cA = (const char*)g.A + (size_t)cur.pm * tstepA; const char* cB = (const char*)g.Bt + (size_t)cur.pn * tstepB;
    S.a_ready(cur);
    if constexpr (SP2) {
        PG8_STAGE(PG8_SB(0, 0), cB, voffB); PG8_STAGE(PG8_SB(0, 1), cB + hstepB, voffB); PG8_STAGE(PG8_SA(0, 0), cA, voffA); PG8_STAGE(PG8_SA(0, 1), cA + hstepA, voffA);
        if (wr == 1) PG8_BAR;
        PG8_WAIT_V(2); PG8_BAR;
        PG8_STAGE(PG8_SB(1, 0), cB + kstep, voffB); PG8_STAGE(PG8_SA(1, 0), cA + kstep, voffA); PG8_STAGE(PG8_SB(1, 1), cB + hstepB + kstep, voffB);
        PG8_WAIT_V(6); PG8_BAR;
    } else {
        PG8_STAGE(PG8_SB(0, 0), cB, voffB); PG8_STAGE(PG8_SA(0, 0), cA, voffA); PG8_STAGE(PG8_SB(0, 1), cB + hstepB, voffB); PG8_STAGE(PG8_SA(0, 1), cA + hstepA, voffA);
        if (wr == 1) PG8_BAR;
        PG8_WAIT_V(4); PG8_BAR;
        PG8_STAGE(PG8_SB(1, 0), cB + kstep, voffB); PG8_STAGE(PG8_SA(1, 0), cA + kstep, voffA); PG8_STAGE(PG8_SB(1, 1), cB + hstepB + kstep, voffB);
        PG8_WAIT_V(6); PG8_BAR;
    }
    for (;;) {
        const bool has_next = S.next(ui + 1, nxt);
        const char* nA = has_next ? (const char*)g.A + (size_t)nxt.pm * tstepA : cA; const char* nB = has_next ? (const char*)g.Bt + (size_t)nxt.pn * tstepB : cB;
        for (int t = 0; t < nt; t += 2) {
            if constexpr (Epi::HAS_MID) { if (t == E.kmid) E.mid(acc, cur, wr, wc, fr, fq); }
            const bool last = (t == nt - 2);
            const char* a1 = cA + (size_t)(t + 1) * kstep;
            const char* a2 = last ? nA : cA + (size_t)(t + 2) * kstep; const char* b2 = last ? nB : cB + (size_t)(t + 2) * kstep;
            const char* a3 = a2 + kstep; const char* b3 = b2 + kstep;
            if (last && has_next) S.a_ready(nxt);
            if constexpr (SP2) {
            PG8_LDB(B0, 0, 0); PG8_LDB(B1, 0, 1); PG8_SCHED; PG8_LDA(At, 0, 0); PG8_STAGE(PG8_SA(1, 1), a1 + hstepA, voffA);
            PG8_WAIT_V(8); PG8_WAIT_L(0); PG8_BAR; PG8_MMA(0, 0, At, B0); PG8_MMA(0, 1, At, B1); PG8_BAR; PG8_SCHED;
            PG8_LDA(At, 0, 1); PG8_STAGE(PG8_SB(0, 0), b2, voffB); PG8_STAGE(PG8_SB(0, 1), b2 + hstepB, voffB); PG8_STAGE(PG8_SA(0, 0), a2, voffA);
            PG8_WAIT_V(8); PG8_WAIT_L(0); PG8_BAR; PG8_MMA(1, 0, At, B0); PG8_MMA(1, 1, At, B1); PG8_BAR; PG8_SCHED;
            PG8_LDB(B0, 1, 0); PG8_LDB(B1, 1, 1); PG8_SCHED; PG8_LDA(At, 1, 0); PG8_STAGE(PG8_SA(0, 1), a2 + hstepA, voffA);
            PG8_WAIT_V(8); PG8_WAIT_L(0); PG8_BAR; PG8_MMA(0, 0, At, B0); PG8_MMA(0, 1, At, B1); PG8_BAR; PG8_SCHED;
            PG8_LDA(At, 1, 1); PG8_STAGE(PG8_SB(1, 0), b3, voffB); PG8_STAGE(PG8_SB(1, 1), b3 + hstepB, voffB); PG8_STAGE(PG8_SA(1, 0), a3, voffA);
            PG8_WAIT_V(8); PG8_WAIT_L(0); PG8_BAR; PG8_MMA(1, 0, At, B0); PG8_MMA(1, 1, At, B1); PG8_BAR; PG8_SCHED;
            } else {
            PG8_LDB(B0, 0, 0); PG8_SCHED; PG8_LDA(At, 0, 0); PG8_STAGE(PG8_SA(1, 1), a1 + hstepA, voffA);
            PG8_WAIT_L(8); PG8_BAR; PG8_WAIT_L(0); PG8_MMA(0, 0, At, B0); PG8_BAR; PG8_SCHED;
            PG8_LDB(B1, 0, 1); PG8_STAGE(PG8_SB(0, 0), b2, voffB);
            PG8_BAR; PG8_WAIT_L(0); PG8_MMA(0, 1, At, B1); PG8_BAR;
            PG8_LDA(At, 0, 1); PG8_STAGE(PG8_SA(0, 0), a2, voffA);
            PG8_BAR; PG8_WAIT_L(0); PG8_MMA(1, 0, At, B0); PG8_BAR; PG8_SCHED;
            PG8_STAGE(PG8_SB(0, 1), b2 + hstepB, voffB);
            PG8_WAIT_V(6); PG8_BAR; PG8_MMA(1, 1, At, B1); PG8_BAR;
            PG8_LDB(B0, 1, 0); PG8_SCHED; PG8_LDA(At, 1, 0); PG8_STAGE(PG8_SA(0, 1), a2 + hstepA, voffA);
            PG8_WAIT_L(8); PG8_BAR; PG8_WAIT_L(0); PG8_MMA(0, 0, At, B0); PG8_BAR; PG8_SCHED;
            PG8_LDB(B1, 1, 1); PG8_STAGE(PG8_SB(1, 0), b3, voffB);
            PG8_BAR; PG8_WAIT_L(0); PG8_MMA(0, 1, At, B1); PG8_BAR;
            PG8_LDA(At, 1, 1); PG8_STAGE(PG8_SA(1, 0), a3, voffA);
            PG8_BAR; PG8_WAIT_L(0); PG8_MMA(1, 0, At, B0); PG8_BAR; PG8_SCHED;
            PG8_STAGE(PG8_SB(1, 1), b3 + hstepB, voffB);
            PG8_WAIT_V(6); PG8_BAR; PG8_MMA(1, 1, At, B1); PG8_BAR;
            }
        }
        if constexpr (ALIGN_EPI) { if (wr == 0) PG8_BAR; }
        if constexpr (!Epi::AFTER_DRAIN) { E(acc, cur, wr, wc, fr, fq); S.done(cur); }
        if (!has_next) break;
#pragma unroll
        for (int a = 0; a < 2; ++a)
#pragma unroll
            for (int b = 0; b < 2; ++b)
#pragma unroll
                for (int m = 0; m < 4; ++m)
#pragma unroll
                    for (int n = 0; n < 2; ++n) acc[a][b][m][n] = (f32x4){0.f, 0.f, 0.f, 0.f};
        cur = nxt; cA = nA; cB = nB; ++ui;
        if constexpr (ALIGN_EPI) { if (wr == 1) PG8_BAR; }
    }
    PG8_WAIT_V(0);
    if constexpr (!ALIGN_EPI) { if (wr == 0) PG8_BAR; }
    PG8_BAR;
    if constexpr (Epi::AFTER_DRAIN) { E.fused(acc, cur, wr, wc, fr, fq, lds, wid, lane); S.done(cur); }
#undef PG8_SA
#undef PG8_SB
#undef PG8_STAGE
#undef PG8_LDA
#undef PG8_LDB
#undef PG8_MMA
#undef PG8_WAIT_V
#undef PG8_WAIT_L
#undef PG8_BAR
#undef PG8_SCHED
}
}

constexpr int NTOK = 16384, DM = 1024, INW = 1280, SSMW = 512, NGRP = 32, NST = 64, SEQL = 2048, NBATCH = 8, DFF = 2816;
constexpr int TCH = 32, NCH = SEQL / TCH  , GROWS = NBATCH * NCH  , KX = 128 + TCH * 16  ;
constexpr size_t MiB = 1u << 20;
constexpr size_t WS_BAR = 0;
constexpr size_t WS_CNT = 16384;
constexpr size_t WS_XB = 65536;
constexpr size_t WS_RSQ = 896 * 1024;
constexpr size_t WS_RS0 = 1 * MiB + 65536;
constexpr size_t WS_XT = 1 * MiB + 131072;
constexpr size_t WS_RSQH = 1 * MiB;
constexpr size_t WS_WIN = 2 * MiB, WS_WGLU = 5 * MiB, WS_WOUT = 6 * MiB, WS_WGU = 8 * MiB, WS_WDN = 19 * MiB;
constexpr size_t WS_TW = 25 * MiB;
constexpr size_t WS_W1 = 45 * MiB;
constexpr size_t WS_AT = 49 * MiB;
constexpr size_t WS_XN = 50 * MiB;
constexpr size_t WS_UX = 162 * MiB;
constexpr size_t WS_Q = 182 * MiB, WS_K = 198 * MiB, WS_VT = 202 * MiB;
constexpr size_t WS_Y = 82 * MiB;
constexpr size_t WS_MG = 98 * MiB;
constexpr size_t WS_ACT = 162 * MiB;
constexpr size_t WS_HB = 130 * MiB;
constexpr size_t WS_END = 250 * MiB;
constexpr int LDS_BYTES = 147456, LDSCTL_OFF = 143360;
constexpr float NORM_EPS = 1e-6f;
constexpr float LOG2E = 1.4426950408889634f;

#define LAS __attribute__((address_space(3)))
typedef unsigned short bf16;
typedef float f32x4 __attribute__((ext_vector_type(4)));
typedef float f32x16 __attribute__((ext_vector_type(16)));
typedef unsigned u32x4 __attribute__((ext_vector_type(4)));
typedef unsigned u32x2 __attribute__((ext_vector_type(2)));
typedef float f32x2 __attribute__((ext_vector_type(2)));
typedef short bf16x8 __attribute__((ext_vector_type(8)));
using pg8::cvt_pk_bf16;

__device__ __forceinline__ float bf_lo(unsigned w) { return __uint_as_float(w << 16); }
__device__ __forceinline__ float bf_hi(unsigned w) { return __uint_as_float(w & 0xffff0000u); }
__device__ __forceinline__ float fast_sigmoid(float x) { return __builtin_amdgcn_rcpf(1.0f + __builtin_amdgcn_exp2f(-x * LOG2E)); }
__device__ __forceinline__ float gelu_tanh(float x) { const float u = 1.5957691216057308f * (x + 0.044715f * x * x * x); return x * fast_sigmoid(u); }
__device__ __forceinline__ float wave_sum(float v) {
#pragma unroll
    for (int o = 1; o < 64; o <<= 1) v += __shfl_xor(v, o);
    return v;
}
__device__ __forceinline__ int crow(int r, int hi) { return (r & 3) + 8 * (r >> 2) + 4 * hi; }

struct Params {
    const float* x; const int* pos; const float* g_pre_mix; const float* w_in; const float* lam_re; const float* lam_im; const float* log_dt;
    const float* b_re; const float* b_im; const float* c_re; const float* c_im; const float* ssm_d; const float* w_glu; const float* b_glu; const float* sinks;
    const float* g_ssm_out; const float* g_attn_out; const float* w_out; const float* g_post_mix; const float* g_pre_ffn; const float* w_gate_up; const float* w_down; const float* g_post_ffn;
    float* out; unsigned char* ws;
};

namespace pg8 {
struct EpiInProj {
    static constexpr bool PERM = true, AFTER_DRAIN = false, HAS_MID = false;
    bf16_t* UX; bf16_t* Q; bf16_t* Kb; bf16_t* VT; const int* pos; const float* rs0;
    __device__ __forceinline__ void operator()(const f32x4 (&acc_)[2][2][4][2], const Unit& u, int wr, int wc, int fr, int fq) const {
        const int row0 = u.pm * BM + wr * 64 + fr;
        f32x4 acc[2][2][4][2];
#pragma unroll
        for (int ai = 0; ai < 2; ++ai)
#pragma unroll
            for (int m = 0; m < 4; ++m) { const float r = rs0[row0 + ai * HALF + m * 16];
#pragma unroll
                for (int bj = 0; bj < 2; ++bj)
#pragma unroll
                    for (int n = 0; n < 2; ++n) acc[ai][bj][m][n] = acc_[ai][bj][m][n] * r; }
        if (u.pn < 2) {
#pragma unroll
            for (int ai = 0; ai < 2; ++ai)
#pragma unroll
                for (int m = 0; m < 4; ++m) { const int tok = row0 + ai * HALF + m * 16;
#pragma unroll
                    for (int bj = 0; bj < 2; ++bj) { const int g = u.pn * 16 + bj * 8 + wc * 2 + (fq >> 1), h0 = 8 * (fq & 1);
                        bf16_t* dst = UX + ((size_t)(g * 512 + (tok >> 5))) * 640 + 128 + (tok & 31) * 16 + h0;
                        const f32x4 v0 = acc[ai][bj][m][0], v1 = acc[ai][bj][m][1]; u32x4 w;
                        w.x = cvt_pk_bf16(v0[0], v0[1]); w.y = cvt_pk_bf16(v0[2], v0[3]); w.z = cvt_pk_bf16(v1[0], v1[1]); w.w = cvt_pk_bf16(v1[2], v1[3]);
                        *(u32x4*)dst = w; } }
        } else {
            const bool isq = u.pn < 4; const bool dorope = (wc & 1) == 0;
            const float qs = 0.125f * 1.4426950408889634f;
#pragma unroll
            for (int ai = 0; ai < 2; ++ai)
#pragma unroll
                for (int m = 0; m < 4; ++m) { const int tok = row0 + ai * HALF + m * 16;
                    float cs0[4], sn0[4], cs1[4], sn1[4];
                    if (dorope) { const float pf = (float)pos[tok];
                        constexpr float IFR[8] = {0.15915494309189535f, 0.03086376340470123f, 0.005985185712713705f, 0.001160663641240061f, 0.00022507907903927653f, 4.364795279280289e-05f, 8.464330808241401e-06f, 1.6414262627950345e-06f};
#pragma unroll
                        for (int j = 0; j < 4; ++j) { const float r0 = __builtin_amdgcn_fractf(pf * IFR[j]), r1 = __builtin_amdgcn_fractf(pf * IFR[4 + j]);
                            cs0[j] = __builtin_amdgcn_cosf(r0); sn0[j] = __builtin_amdgcn_sinf(r0); cs1[j] = __builtin_amdgcn_cosf(r1); sn1[j] = __builtin_amdgcn_sinf(r1); } }
#pragma unroll
                    for (int bj = 0; bj < 2; ++bj) {
                        f32x4 v0 = acc[ai][bj][m][0], v1 = acc[ai][bj][m][1];
                        if (isq || bj == 0) {
                            if (dorope) {
#pragma unroll
                                for (int j = 0; j < 4; ++j) {
                                    const float p0 = __shfl_xor(v0[j], 16), p1 = __shfl_xor(v1[j], 16);
                                    const float c0 = cs0[j], s0 = sn0[j], c1 = cs1[j], s1 = sn1[j];
                                    if (fq == 0) { v0[j] = v0[j] * c0 - p0 * s0; v1[j] = v1[j] * c1 - p1 * s1; }
                                    else if (fq == 1) { v0[j] = v0[j] * c0 + p0 * s0; v1[j] = v1[j] * c1 + p1 * s1; }
                                }
                            }
                            bf16_t* dst;
                            if (isq) { const int head = (u.pn - 2) * 4 + bj * 2 + (wc >> 1); v0 = v0 * qs; v1 = v1 * qs; dst = Q + (size_t)tok * 512 + head * 64 + (wc & 1) * 32 + 8 * fq; }
                            else dst = Kb + (size_t)tok * 128 + (wc >> 1) * 64 + (wc & 1) * 32 + 8 * fq;
                            u32x4 w; w.x = cvt_pk_bf16(v0[0], v0[1]); w.y = cvt_pk_bf16(v0[2], v0[3]); w.z = cvt_pk_bf16(v1[0], v1[1]); w.w = cvt_pk_bf16(v1[2], v1[3]);
                            *(u32x4*)dst = w;
                        } else {
                            const int hk = wc >> 1, d0 = (wc & 1) * 32 + 8 * fq, b = tok >> 11, l = tok & 2047;
                            bf16_t* dst = VT + ((size_t)((b * 2 + hk) * 64 + d0)) * 2048 + l;
#pragma unroll
                            for (int j = 0; j < 4; ++j) { dst[(size_t)j * 2048] = (bf16_t)(cvt_pk_bf16(v0[j], 0.f) & 0xffffu); dst[(size_t)(4 + j) * 2048] = (bf16_t)(cvt_pk_bf16(v1[j], 0.f) & 0xffffu); }
                        }
                    }
                }
        }
    }
};
struct EpiSsmC {
    static constexpr bool PERM = true, AFTER_DRAIN = false, HAS_MID = false;
    const bf16_t* UX; const float* dvec; bf16_t* Y;
    __device__ __forceinline__ void operator()(const f32x4 (&acc)[2][2][4][2], const Unit& u, int wr, int wc, int fr, int fq) const {
        const int g = u.pm >> 1, pmr = u.pm & 1, pnr = u.pn & 1, h0 = 8 * (fq & 1);
        const f32x4 d0 = *(const f32x4*)(dvec + g * 16 + h0), d1 = *(const f32x4*)(dvec + g * 16 + h0 + 4);
#pragma unroll
        for (int ai = 0; ai < 2; ++ai)
#pragma unroll
            for (int m = 0; m < 4; ++m) { const int nloc = pmr * 256 + ai * HALF + wr * 64 + m * 16 + fr;
#pragma unroll
                for (int bj = 0; bj < 2; ++bj) { const int t = pnr * 16 + bj * 8 + wc * 2 + (fq >> 1); const int tok = nloc * 32 + t;
                    const u32x4 uw = *(const u32x4*)(UX + ((size_t)(g * 512 + nloc)) * 640 + 128 + t * 16 + h0);
                    const f32x4 a0 = acc[ai][bj][m][0], a1 = acc[ai][bj][m][1];
                    float y[8];
                    y[0] = a0[0] + d0[0] * bf_lo(uw.x); y[1] = a0[1] + d0[1] * bf_hi(uw.x); y[2] = a0[2] + d0[2] * bf_lo(uw.y); y[3] = a0[3] + d0[3] * bf_hi(uw.y);
                    y[4] = a1[0] + d1[0] * bf_lo(uw.z); y[5] = a1[1] + d1[1] * bf_hi(uw.z); y[6] = a1[2] + d1[2] * bf_lo(uw.w); y[7] = a1[3] + d1[3] * bf_hi(uw.w);
#pragma unroll
                    for (int i = 0; i < 8; ++i) y[i] = gelu_tanh(y[i]);
                    u32x4 w; w.x = cvt_pk_bf16(y[0], y[1]); w.y = cvt_pk_bf16(y[2], y[3]); w.z = cvt_pk_bf16(y[4], y[5]); w.w = cvt_pk_bf16(y[6], y[7]);
                    *(u32x4*)(Y + (size_t)tok * 512 + g * 16 + h0) = w; } }
    }
};
template <int MODE  > struct EpiGated {
    static constexpr bool PERM = true, AFTER_DRAIN = false, HAS_MID = false;
    bf16_t* O; int ldc; const float* bias; float* rowsq;
    __device__ __forceinline__ void operator()(const f32x4 (&acc)[2][2][4][2], const Unit& u, int wr, int wc, int fr, int fq) const {
        const int row0 = u.pm * BM + wr * 64 + fr, col0 = u.pn * HALF + wc * 32 + 8 * fq;
        float rsc[2][4];
        if (MODE == 1) {
#pragma unroll
            for (int ai = 0; ai < 2; ++ai)
#pragma unroll
                for (int m = 0; m < 4; ++m) rsc[ai][m] = 1.0f / sqrtf(rowsq[row0 + ai * HALF + m * 16] * (1.0f / 1024.0f) + 1e-6f);
        }
        f32x4 ba[2], bg[2];
        if (MODE == 0) { ba[0] = *(const f32x4*)(bias + col0); ba[1] = *(const f32x4*)(bias + col0 + 4); bg[0] = *(const f32x4*)(bias + 512 + col0); bg[1] = *(const f32x4*)(bias + 512 + col0 + 4); }
#pragma unroll
        for (int ai = 0; ai < 2; ++ai)
#pragma unroll
            for (int m = 0; m < 4; ++m) { float o[8];
#pragma unroll
                for (int n = 0; n < 2; ++n)
#pragma unroll
                    for (int j = 0; j < 4; ++j) { const float a = (MODE == 1) ? acc[ai][0][m][n][j] * rsc[ai][m] : acc[ai][0][m][n][j], gt = (MODE == 1) ? acc[ai][1][m][n][j] * rsc[ai][m] : acc[ai][1][m][n][j];
                        o[4 * n + j] = (MODE == 0) ? (a + ba[n][j]) * fast_sigmoid(gt + bg[n][j]) : (a * fast_sigmoid(a)) * gt; }
                u32x4 w; w.x = cvt_pk_bf16(o[0], o[1]); w.y = cvt_pk_bf16(o[2], o[3]); w.z = cvt_pk_bf16(o[4], o[5]); w.w = cvt_pk_bf16(o[6], o[7]);
                *(u32x4*)(O + (size_t)(row0 + ai * HALF + m * 16) * ldc + col0) = w;
                if (MODE == 0) { float s = ((o[0] * o[0] + o[1] * o[1]) + (o[2] * o[2] + o[3] * o[3])) + ((o[4] * o[4] + o[5] * o[5]) + (o[6] * o[6] + o[7] * o[7]));
                    s += __shfl_xor(s, 16); s += __shfl_xor(s, 32); if (fq == 0) unsafeAtomicAdd(rowsq + row0 + ai * HALF + m * 16, s); } }
    }
};
struct EpiF32 {
    static constexpr bool PERM = true, AFTER_DRAIN = false, HAS_MID = false;
    float* O; int ldc;
    __device__ __forceinline__ void operator()(const f32x4 (&acc)[2][2][4][2], const Unit& u, int wr, int wc, int fr, int fq) const {
        const int row0 = u.pm * BM + wr * 64 + fr, col0 = u.pn * BM + wc * 32 + 8 * fq;
#pragma unroll
        for (int ai = 0; ai < 2; ++ai)
#pragma unroll
            for (int m = 0; m < 4; ++m) { float* rowp = O + (size_t)(row0 + ai * HALF + m * 16) * ldc + col0;
#pragma unroll
                for (int bj = 0; bj < 2; ++bj) { *(f32x4*)(rowp + bj * HALF) = acc[ai][bj][m][0]; *(f32x4*)(rowp + bj * HALF + 4) = acc[ai][bj][m][1]; } }
    }
};

struct PanelSq {
    float* xbuf;
    unsigned* cnt;
    float eps;
    __device__ __forceinline__ void run(const f32x4 (&v)[2][2][4][2], const Unit& u, int wr, int wc, int fr, int fq, PG8_LAS unsigned char* lds, int wid, int lane) const {
        PG8_LAS float* Pp = (PG8_LAS float*)lds;
        PG8_LAS float* S = (PG8_LAS float*)(lds + 4096);
#pragma unroll
        for (int ai = 0; ai < 2; ++ai)
#pragma unroll
            for (int m = 0; m < 4; ++m) { float s = 0.f;
#pragma unroll
                for (int bj = 0; bj < 2; ++bj)
#pragma unroll
                    for (int n = 0; n < 2; ++n) { const f32x4 x = v[ai][bj][m][n]; s += (x[0] * x[0] + x[1] * x[1]) + (x[2] * x[2] + x[3] * x[3]); }
                s += __shfl_xor(s, 16); s += __shfl_xor(s, 32);
                if (fq == 0) Pp[(ai * HALF + wr * 64 + m * 16 + fr) * 4 + wc] = s; }
        asm volatile("s_waitcnt lgkmcnt(0)" ::: "memory"); __builtin_amdgcn_s_barrier(); asm volatile("" ::: "memory");
        const int row = wid * 32 + (lane & 31);
        if (lane < 32) { const float t = (Pp[row * 4 + 0] + Pp[row * 4 + 1]) + (Pp[row * 4 + 2] + Pp[row * 4 + 3]);
            __hip_atomic_store(xbuf + ((size_t)(u.pm * BM + row) * 4 + u.pn), t, __ATOMIC_RELAXED, __HIP_MEMORY_SCOPE_AGENT); }
        asm volatile("s_waitcnt vmcnt(0)" ::: "memory");
        if (lane == 0) __hip_atomic_fetch_add(cnt + 64 * u.pm, 1u, __ATOMIC_RELAXED, __HIP_MEMORY_SCOPE_AGENT);
        if (wid == 0) { unsigned sp = 0;
            while ((unsigned)__builtin_amdgcn_readfirstlane(__hip_atomic_load(cnt + 64 * u.pm, __ATOMIC_RELAXED, __HIP_MEMORY_SCOPE_AGENT)) < 32u) { __builtin_amdgcn_s_sleep(2); if (++sp > (1u << 22)) break; }
            __builtin_amdgcn_fence(__ATOMIC_ACQUIRE, "agent"); }
        asm volatile("s_waitcnt vmcnt(0) lgkmcnt(0)" ::: "memory"); __builtin_amdgcn_s_barrier(); asm volatile("" ::: "memory");
        if (lane < 32) { const float* slot = xbuf + (size_t)(u.pm * BM + row) * 4; float q = 0.f;
#pragma unroll
            for (int t = 0; t < 4; ++t) q += __hip_atomic_load(slot + t, __ATOMIC_RELAXED, __HIP_MEMORY_SCOPE_AGENT);
            S[row] = 1.0f / sqrtf(q * (1.0f / 1024.0f) + eps); }
        asm volatile("s_waitcnt lgkmcnt(0)" ::: "memory"); __builtin_amdgcn_s_barrier(); asm volatile("" ::: "memory");
    }
};
struct EpiNormResNorm {
    static constexpr bool PERM = true, AFTER_DRAIN = true, HAS_MID = true;
    const bf16_t* base; bf16_t* hb; float* rsq_h; const float* g1; PanelSq st1;
    const PG8_LAS float* tab; int kmid;
    __device__ __forceinline__ void mid(f32x4 (&acc)[2][2][4][2], const Unit& u, int wr, int wc, int fr, int fq) const {
#pragma unroll
        for (int ai = 0; ai < 2; ++ai)
#pragma unroll
            for (int m = 0; m < 4; ++m) { const float f = tab[ai * HALF + wr * 64 + m * 16 + fr];
#pragma unroll
                for (int bj = 0; bj < 2; ++bj)
#pragma unroll
                    for (int n = 0; n < 2; ++n) acc[ai][bj][m][n] = acc[ai][bj][m][n] * f; }
        asm volatile("s_waitcnt lgkmcnt(0)" ::: "memory");
    }
    __device__ __forceinline__ void fused(f32x4 (&acc)[2][2][4][2], const Unit& u, int wr, int wc, int fr, int fq, PG8_LAS unsigned char* lds, int wid, int lane) const {
        const PG8_LAS float* S = (const PG8_LAS float*)(lds + 4096);
        const int col0 = u.pn * BM + wc * 32 + 8 * fq;
#pragma unroll
        for (int ai = 0; ai < 2; ++ai)
#pragma unroll
            for (int m = 0; m < 4; ++m) { const float rb = tab[256 + ai * HALF + wr * 64 + m * 16 + fr];
#pragma unroll
                for (int bj = 0; bj < 2; ++bj)
#pragma unroll
                    for (int n = 0; n < 2; ++n) acc[ai][bj][m][n] = acc[ai][bj][m][n] * rb; }
        st1.run(acc, u, wr, wc, fr, fq, lds, wid, lane);
        f32x4 gv[2][2];
#pragma unroll
        for (int bj = 0; bj < 2; ++bj)
#pragma unroll
            for (int n = 0; n < 2; ++n) gv[bj][n] = *(const f32x4*)(g1 + col0 + bj * HALF + 4 * n);
#pragma unroll
        for (int ai = 0; ai < 2; ++ai)
#pragma unroll
            for (int m = 0; m < 4; ++m) { const int r = ai * HALF + wr * 64 + m * 16 + fr; const float rs = S[r]; const size_t off = (size_t)(u.pm * BM + r) * 1024 + col0;
#pragma unroll
                for (int bj = 0; bj < 2; ++bj) { const u32x4 xw = *(const u32x4*)(base + off + bj * HALF);
                    acc[ai][bj][m][0] = (f32x4){bf_lo(xw.x), bf_hi(xw.x), bf_lo(xw.y), bf_hi(xw.y)} + acc[ai][bj][m][0] * rs * gv[bj][0];
                    acc[ai][bj][m][1] = (f32x4){bf_lo(xw.z), bf_hi(xw.z), bf_lo(xw.w), bf_hi(xw.w)} + acc[ai][bj][m][1] * rs * gv[bj][1]; }
                float s = 0.f;
#pragma unroll
                for (int bj = 0; bj < 2; ++bj) { const f32x4 h0 = acc[ai][bj][m][0], h1 = acc[ai][bj][m][1];
                    s += ((h0[0] * h0[0] + h0[1] * h0[1]) + (h0[2] * h0[2] + h0[3] * h0[3])) + ((h1[0] * h1[0] + h1[1] * h1[1]) + (h1[2] * h1[2] + h1[3] * h1[3]));
                    u32x4 hw; hw.x = cvt_pk_bf16(h0[0], h0[1]); hw.y = cvt_pk_bf16(h0[2], h0[3]); hw.z = cvt_pk_bf16(h1[0], h1[1]); hw.w = cvt_pk_bf16(h1[2], h1[3]); *(u32x4*)(hb + off + bj * HALF) = hw; }
                s += __shfl_xor(s, 16); s += __shfl_xor(s, 32);
                if (fq == 0) unsafeAtomicAdd(rsq_h + u.pm * BM + r, s);
                if (m & 1) asm volatile("" ::: "memory"); }
    }
};
struct EpiNormRes {
    static constexpr bool PERM = true, AFTER_DRAIN = true, HAS_MID = false;
    const bf16_t* base; float* out; const float* g1; PanelSq st;
    __device__ __forceinline__ void fused(f32x4 (&acc)[2][2][4][2], const Unit& u, int wr, int wc, int fr, int fq, PG8_LAS unsigned char* lds, int wid, int lane) const {
        const PG8_LAS float* S = (const PG8_LAS float*)(lds + 4096);
        const int col0 = u.pn * BM + wc * 32 + 8 * fq;
        st.run(acc, u, wr, wc, fr, fq, lds, wid, lane);
        f32x4 gv[2][2];
#pragma unroll
        for (int bj = 0; bj < 2; ++bj)
#pragma unroll
            for (int n = 0; n < 2; ++n) gv[bj][n] = *(const f32x4*)(g1 + col0 + bj * HALF + 4 * n);
#pragma unroll
        for (int ai = 0; ai < 2; ++ai)
#pragma unroll
            for (int m = 0; m < 4; ++m) { const int r = ai * HALF + wr * 64 + m * 16 + fr; const float rs = S[r]; const size_t off = (size_t)(u.pm * BM + r) * 1024 + col0;
#pragma unroll
                for (int bj = 0; bj < 2; ++bj)
                { const u32x4 hw = *(const u32x4*)(base + off + bj * HALF);
                    const f32x4 b0 = (f32x4){bf_lo(hw.x), bf_hi(hw.x), bf_lo(hw.y), bf_hi(hw.y)}, b1 = (f32x4){bf_lo(hw.z), bf_hi(hw.z), bf_lo(hw.w), bf_hi(hw.w)};
                    __builtin_nontemporal_store(b0 + acc[ai][bj][m][0] * rs * gv[bj][0], (f32x4*)(out + off + bj * HALF)); __builtin_nontemporal_store(b1 + acc[ai][bj][m][1] * rs * gv[bj][1], (f32x4*)(out + off + bj * HALF + 4)); }
                if (m & 1) asm volatile("" ::: "memory"); }
    }
};
struct SsmOrder {
    int c;
    __device__ bool next(int i, Unit& u) const { if (i > 0 || c >= 128) return false; const int U = (c & 7) * 16 + (c >> 3), g = U >> 2; u.pm = 2 * g + ((U >> 1) & 1); u.pn = 2 * g + (U & 1); return true; }
    __device__ __forceinline__ void a_ready(const Unit&) const {}
    __device__ __forceinline__ void done(const Unit&) const {}
};
}
__device__ __forceinline__ void transpose_item(const float* W, int K, int N, bf16* WT, int src_col0, int dst_row0, int k0, LAS float* scr, int lane, const float* ks = nullptr) {
    if (ks) {
#pragma unroll 32
        for (int i = 0; i < 32; ++i) { const int kk = 2 * i + (lane >> 5); scr[kk * 33 + (lane & 31)] = __builtin_nontemporal_load(W + (size_t)(k0 + kk) * N + src_col0 + (lane & 31)) * ks[kk]; }
    } else {
#pragma unroll 32
        for (int i = 0; i < 32; ++i) { const int kk = 2 * i + (lane >> 5); scr[kk * 33 + (lane & 31)] = __builtin_nontemporal_load(W + (size_t)(k0 + kk) * N + src_col0 + (lane & 31)); }
    }
    asm volatile("s_waitcnt lgkmcnt(0)" ::: "memory");
    const int c = lane & 7;
#pragma unroll
    for (int j = 0; j < 4; ++j) { const int n = (lane >> 3) + 8 * j; const LAS float* s = scr + (8 * c) * 33 + n;
        u32x4 o; o.x = cvt_pk_bf16(s[0 * 33], s[1 * 33]); o.y = cvt_pk_bf16(s[2 * 33], s[3 * 33]); o.z = cvt_pk_bf16(s[4 * 33], s[5 * 33]); o.w = cvt_pk_bf16(s[6 * 33], s[7 * 33]);
        *(u32x4*)(WT + (size_t)(dst_row0 + n) * K + k0 + 8 * c) = o; }
    asm volatile("s_waitcnt lgkmcnt(0)" ::: "memory");
}
__device__ __forceinline__ int gated_src_col(int n0, int half_off) { const int pn = n0 >> 8, r = n0 & 255; return r < 128 ? 128 * pn + r : half_off + 128 * pn + (r - 128); }

__device__ __forceinline__ void sincos_rev(double ang, float& s, float& c) {
    const double rev = ang * 0.15915494309189533576888; const float fr = (float)(rev - floor(rev));
    s = __builtin_amdgcn_sinf(fr); c = __builtin_amdgcn_cosf(fr);
}

__device__ __forceinline__ void prologue_b(const Params& P, LAS unsigned char* lds, int tid, int lane, int wave, int blk, int G, int which, int wave0 = 0) {
    unsigned char* ws = P.ws;
    for (int item = blk; (which & 1) && item < NGRP * 8; item += G) {
        const int g = item >> 3, part = item & 7;
        LAS f32x2* APW = (LAS f32x2*)lds;
        LAS f32x2* BB = APW + 33 * 64;
        LAS f32x2* CC = BB + 64 * 16;
        LAS float* KT = (LAS float*)(CC + 16 * 64);
        const float dt = expf(P.log_dt[g]);
        for (int e = tid; e < 33 * 64; e += 512) { const int jx = e >> 6, p = e & 63;
            const float lr = fminf(P.lam_re[g * 64 + p], -1e-4f), li = P.lam_im[g * 64 + p];
            const float mag = expf((float)jx * (lr * dt)); float s, c; sincos_rev((double)jx * (double)(li * dt), s, c);
            f32x2 v; v.x = mag * c; v.y = mag * s; APW[e] = v; }
        for (int e = tid; e < 64 * 16; e += 512) { const int p = e >> 4;
            const float lr = fminf(P.lam_re[g * 64 + p], -1e-4f), li = P.lam_im[g * 64 + p];
            const float mag = expf(lr * dt); float s, c; sincos_rev((double)(li * dt), s, c); const float ar = mag * c, ai = mag * s;
            const float den = lr * lr + li * li, fr = ((ar - 1.0f) * lr + ai * li) / den, fi = (ai * lr - (ar - 1.0f) * li) / den;
            const float br = P.b_re[(size_t)g * 1024 + e], bi = P.b_im[(size_t)g * 1024 + e];
            f32x2 v; v.x = fr * br - fi * bi; v.y = fr * bi + fi * br; BB[e] = v;
            f32x2 w; w.x = P.c_re[(size_t)g * 1024 + e]; w.y = P.c_im[(size_t)g * 1024 + e]; CC[e] = w; }
        __syncthreads();
        if (part == 0 && tid < 64) ((f32x2*)(ws + WS_AT))[g * 64 + tid] = APW[32 * 64 + tid];
        {
            const int hh = tid & 255, h = hh >> 4, hp = hh & 15, jl = 2 * (tid >> 8), j0 = 4 * part + jl;
            float k0 = 0.f, k1 = 0.f;
            for (int p = 0; p < 64; ++p) {
                const f32x2 cv = CC[h * 64 + p], bv = BB[p * 16 + hp], w0 = APW[j0 * 64 + p], w1 = APW[(j0 + 1) * 64 + p];
                const float zr = cv.x * bv.x - cv.y * bv.y, zi = cv.x * bv.y + cv.y * bv.x;
                k0 += zr * w0.x - zi * w0.y; k1 += zr * w1.x - zi * w1.y;
            }
            KT[jl * 256 + hh] = k0; KT[(jl + 1) * 256 + hh] = k1;
        }
        __syncthreads();
        bf16* TWg = (bf16*)(ws + WS_TW) + (size_t)g * 512 * 640;
        for (int e = tid; e < 4096; e += 512) {
            const int jj = e >> 10, t = (e >> 5) & 31, h = (e >> 1) & 15, half = e & 1, jx = 4 * part + jj;
            if (t >= jx) { const LAS float* kp = KT + jj * 256 + h * 16 + 8 * half;
                u32x4 w; w.x = cvt_pk_bf16(kp[0], kp[1]); w.y = cvt_pk_bf16(kp[2], kp[3]); w.z = cvt_pk_bf16(kp[4], kp[5]); w.w = cvt_pk_bf16(kp[6], kp[7]);
                *(u32x4*)(TWg + (size_t)(t * 16 + h) * 640 + 128 + (t - jx) * 16 + 8 * half) = w; }
            const int lg = 4 * (7 - part) + jj, s = t + lg;
            if (lg >= 1 && s < 32) *(u32x4*)(TWg + (size_t)(t * 16 + h) * 640 + 128 + s * 16 + 8 * half) = (u32x4){0u, 0u, 0u, 0u};
        }
        for (int e = tid; e < 64 * 16; e += 512) {
            const int rl = e >> 4, c8 = (e & 15) * 8, t = 4 * part + (rl >> 4), h = rl & 15; float v[8];
#pragma unroll
            for (int i = 0; i < 8; ++i) { const int q = c8 + i, p = q & 63; const f32x2 cv = CC[h * 64 + p], wv = APW[(t + 1) * 64 + p];
                v[i] = (q < 64) ? (cv.x * wv.x - cv.y * wv.y) : -(cv.x * wv.y + cv.y * wv.x); }
            u32x4 w; w.x = cvt_pk_bf16(v[0], v[1]); w.y = cvt_pk_bf16(v[2], v[3]); w.z = cvt_pk_bf16(v[4], v[5]); w.w = cvt_pk_bf16(v[6], v[7]);
            *(u32x4*)(TWg + (size_t)(t * 16 + h) * 640 + c8) = w;
        }
        bf16* W1g = (bf16*)(ws + WS_W1) + (size_t)g * 128 * 512;
        for (int e = tid; e < 16 * 64; e += 512) {
            const int q = 16 * part + (e >> 6), c8 = (e & 63) * 8, s = c8 >> 4, hp0 = c8 & 15, p = q & 63; float v[8];
            const f32x2 wv = APW[(31 - s) * 64 + p];
#pragma unroll
            for (int i = 0; i < 8; ++i) { const f32x2 bv = BB[p * 16 + hp0 + i]; v[i] = (q < 64) ? (wv.x * bv.x - wv.y * bv.y) : (wv.x * bv.y + wv.y * bv.x); }
            u32x4 w; w.x = cvt_pk_bf16(v[0], v[1]); w.y = cvt_pk_bf16(v[2], v[3]); w.z = cvt_pk_bf16(v[4], v[5]); w.w = cvt_pk_bf16(v[6], v[7]);
            *(u32x4*)(W1g + (size_t)q * 512 + c8) = w;
        }
        __syncthreads();
    }
    {
        LAS float* scr = (LAS float*)(lds + wave * 16384);
        const int gw = blk * (8 - wave0) + (wave - wave0), NGW = G * (8 - wave0);
        constexpr int I_IN = 16 * 40, I_GLU = 8 * 32, I_OUT = 16 * 32, I_GU = 16 * 176, I_DN = 44 * 32, NIT = I_IN + I_GLU + I_OUT + I_GU + I_DN;
        const int it_lo = (which & 1) ? I_IN : I_IN + I_GLU + I_OUT, it_hi = (which & 2) ? NIT : I_IN + I_GLU + I_OUT;
        for (int it = it_lo + gw; wave >= wave0 && it < it_hi; it += NGW) {
            int r = it;
            if (r < I_IN) { const int nb = r % 40, kb = r / 40; transpose_item(P.w_in, 1024, 1280, (bf16*)(ws + WS_WIN), 32 * nb, 32 * nb, 64 * kb, scr, lane); continue; } r -= I_IN;
            if (r < I_GLU) { const int nb = r % 32, kb = r / 32; transpose_item(P.w_glu, 512, 1024, (bf16*)(ws + WS_WGLU), gated_src_col(32 * nb, 512), 32 * nb, 64 * kb, scr, lane); continue; } r -= I_GLU;
            if (r < I_OUT) { const int nb = r % 32, kb = r / 32; transpose_item(P.w_out, 1024, 1024, (bf16*)(ws + WS_WOUT), 32 * nb, 32 * nb, 64 * kb, scr, lane, kb < 8 ? P.g_ssm_out + 64 * kb : P.g_attn_out + 64 * (kb - 8)); continue; } r -= I_OUT;
            if (r < I_GU) { const int nb = r % 176, kb = r / 176; transpose_item(P.w_gate_up, 1024, 5632, (bf16*)(ws + WS_WGU), gated_src_col(32 * nb, 2816), 32 * nb, 64 * kb, scr, lane, P.g_pre_ffn + 64 * kb); continue; } r -= I_GU;
            { const int nb = r % 32, kb = r / 32; transpose_item(P.w_down, 2816, 1024, (bf16*)(ws + WS_WDN), 32 * nb, 32 * nb, 64 * kb, scr, lane); }
        }
    }
}

__device__ __forceinline__ void prologue_a(const Params& P, LAS unsigned char* lds, int tid, int lane, int wave) {
    unsigned char* ws = P.ws;
    const int G = gridDim.x, blk = blockIdx.x;
    {
        LAS float* scr = (LAS float*)(lds + wave * 16384);
        const int gw = blk * 8 + wave, NGW = G * 8;
        for (int r = gw; r < 16 * 40; r += NGW) { const int nb = r % 40, kb = r / 40; transpose_item(P.w_in, 1024, 1280, (bf16*)(ws + WS_WIN), 32 * nb, 32 * nb, 64 * kb, scr, lane, P.g_pre_mix + 64 * kb); }
        for (int m = gw; m < NTOK; m += NGW) {
            const f32x4* xr = (const f32x4*)(P.x + (size_t)m * DM) + lane; f32x4 v[4]; float s = 0.f;
#pragma unroll
            for (int j = 0; j < 4; ++j) { v[j] = __builtin_nontemporal_load(xr + 64 * j); s += (v[j].x * v[j].x + v[j].y * v[j].y) + (v[j].z * v[j].z + v[j].w * v[j].w); }
            const float rstd = 1.0f / sqrtf(wave_sum(s) * (1.0f / DM) + NORM_EPS);
            if (lane == 0) ((float*)(ws + WS_RS0))[m] = rstd;
            u32x2* o8 = (u32x2*)((bf16*)(ws + WS_XN) + (size_t)m * DM) + lane;
#pragma unroll
            for (int j = 0; j < 4; ++j) { u32x2 w; w.x = cvt_pk_bf16(v[j].x, v[j].y); w.y = cvt_pk_bf16(v[j].z, v[j].w); o8[64 * j] = w; }
        }
        for (int e = blk * 512 + tid; e < NTOK; e += G * 512) { ((float*)(ws + WS_RSQ))[e] = 0.f; ((float*)(ws + WS_RSQH))[e] = 0.f; }
    }
}

__device__ __forceinline__ void ssm_pass_a(const Params& P, int lane, int wave) {
    if (wave >= 2) return;
    unsigned char* ws = P.ws;
    for (int unit = wave * 256 + blockIdx.x; unit < 512; unit += 2 * gridDim.x > 512 ? 512 : 2 * gridDim.x) {
        const int g = unit >> 4, b = (unit >> 1) & 7, hs = unit & 1;
        const int r32 = lane & 31, hi = lane >> 5;
        const int sig = 16 * ((r32 >> 2) & 1) + 4 * (r32 >> 3) + (r32 & 3);
        bf16* UXg = (bf16*)(ws + WS_UX) + ((size_t)(g * 512 + b * 64)) * 640;
        const bf16* a0p = UXg + (size_t)sig * 640 + 128 + 8 * hi;
        const bf16* a1p = a0p + (size_t)32 * 640;
        const bf16* W1g = (const bf16*)(ws + WS_W1) + (size_t)g * 128 * 512;
        const bf16* b0p = W1g + (size_t)(32 * hs + r32) * 512 + 8 * hi;
        const bf16* b1p = b0p + (size_t)64 * 512;
        f32x16 acc[2][2];
#pragma unroll
        for (int i = 0; i < 2; ++i)
#pragma unroll
            for (int j = 0; j < 2; ++j)
#pragma unroll
                for (int r = 0; r < 16; ++r) acc[i][j][r] = 0.f;
#pragma unroll 8
        for (int ks = 0; ks < 32; ++ks) {
            const bf16x8 A0 = *(const bf16x8*)(a0p + 16 * ks), A1 = *(const bf16x8*)(a1p + 16 * ks), B0 = *(const bf16x8*)(b0p + 16 * ks), B1 = *(const bf16x8*)(b1p + 16 * ks);
            acc[0][0] = __builtin_amdgcn_mfma_f32_32x32x16_bf16(A0, B0, acc[0][0], 0, 0, 0);
            acc[0][1] = __builtin_amdgcn_mfma_f32_32x32x16_bf16(A0, B1, acc[0][1], 0, 0, 0);
            acc[1][0] = __builtin_amdgcn_mfma_f32_32x32x16_bf16(A1, B0, acc[1][0], 0, 0, 0);
            acc[1][1] = __builtin_amdgcn_mfma_f32_32x32x16_bf16(A1, B1, acc[1][1], 0, 0, 0);
        }
        const int p = 32 * hs + r32;
        const float2 aT = ((const float2*)(ws + WS_AT))[g * 64 + p];
        float er[2], ei[2];
#pragma unroll
        for (int rt = 0; rt < 2; ++rt) { float lr = 0.f, li = 0.f;
#pragma unroll
            for (int r = 0; r < 16; ++r) { const float nr = aT.x * lr - aT.y * li + acc[rt][0][r], ni = aT.x * li + aT.y * lr + acc[rt][1][r]; lr = nr; li = ni; }
            er[rt] = lr; ei[rt] = li; }
        float pr = aT.x, pi = aT.y;
#pragma unroll
        for (int k = 0; k < 4; ++k) { const float nr = pr * pr - pi * pi, ni = 2.f * pr * pi; pr = nr; pi = ni; }
        const float x0r = __shfl_xor(er[0], 32), x0i = __shfl_xor(ei[0], 32);
        const float s0r = hi ? x0r : 0.f, s0i = hi ? x0i : 0.f;
        const float ebr = pr * s0r - pi * s0i + er[0], ebi = pr * s0i + pi * s0r + ei[0];
        const float y0r = __shfl_xor(ebr, 32), y0i = __shfl_xor(ebi, 32);
        const float ecr = pr * y0r - pi * y0i + er[1], eci = pr * y0i + pi * y0r + ei[1];
        const float z0r = __shfl_xor(ecr, 32), z0i = __shfl_xor(eci, 32);
        const float s1r = hi ? z0r : y0r, s1i = hi ? z0i : y0i;
#pragma unroll
        for (int rt = 0; rt < 2; ++rt) { float cr = rt ? s1r : s0r, ci = rt ? s1i : s0i;
            bf16* xo = UXg + (size_t)(32 * rt + 16 * hi) * 640 + p;
#pragma unroll
            for (int r = 0; r < 16; ++r) {
                xo[(size_t)r * 640] = (bf16)(cvt_pk_bf16(cr, 0.f) & 0xffffu); xo[(size_t)r * 640 + 64] = (bf16)(cvt_pk_bf16(ci, 0.f) & 0xffffu);
                const float nr = aT.x * cr - aT.y * ci + acc[rt][0][r], ni = aT.x * ci + aT.y * cr + acc[rt][1][r]; cr = nr; ci = ni; }
        }
    }
}

__device__ __forceinline__ void attn_phase(const Params& P, LAS unsigned char* lds, int tid, int lane, int wave, int unit0, int nunits) {
    unsigned char* ws = P.ws;
    const bf16* Q = (const bf16*)(ws + WS_Q); const bf16* Kb = (const bf16*)(ws + WS_K); const bf16* VT = (const bf16*)(ws + WS_VT); bf16* MG = (bf16*)(ws + WS_MG);
    const int r32 = lane & 31, hi = lane >> 5;
    const int h = wave, hk = h >> 2;
    const float sink2 = P.sinks[h] * LOG2E;
    constexpr int KST = 272, VST = 392, VOFF = 192 * KST;
#pragma unroll 1
    for (int unit = unit0; unit < unit0 + nunits; ++unit) {
        const int b = unit >> 5, l0 = (unit & 31) * 64, tokb = b * SEQL;
        LAS float* rsq = (LAS float*)(lds + 139264);
        if (tid < 64) rsq[tid] = 0.f;
        {
            u32x4 kv[6], vv[6];
#pragma unroll
            for (int i = 0; i < 6; ++i) { const int p = tid + 512 * i, row = p >> 4, c16 = p & 15; int t = l0 - 128 + row; t = t < 0 ? t + 128 : t;
                kv[i] = *(const u32x4*)(Kb + (size_t)(tokb + t) * 128 + c16 * 8); }
#pragma unroll
            for (int i = 0; i < 6; ++i) { const int p = tid + 512 * i, row = p / 24, c = p % 24; int k0 = l0 - 128 + 8 * c; k0 = k0 < 0 ? k0 + 128 : k0;
                vv[i] = *(const u32x4*)(VT + ((size_t)(b * 128 + row)) * SEQL + k0); }
#pragma unroll
            for (int i = 0; i < 6; ++i) { const int p = tid + 512 * i, row = p >> 4, c16 = p & 15; *(LAS u32x4*)(lds + row * KST + c16 * 16) = kv[i]; }
#pragma unroll
            for (int i = 0; i < 6; ++i) { const int p = tid + 512 * i, row = p / 24, c = p % 24; LAS u32x2* d = (LAS u32x2*)(lds + VOFF + row * VST + c * 16);
                u32x2 a, bq; a.x = vv[i].x; a.y = vv[i].y; bq.x = vv[i].z; bq.y = vv[i].w; d[0] = a; d[1] = bq; }
        }
        __syncthreads();
#pragma unroll 1
        for (int sub = 0; sub < 2; ++sub) {
            const int q0 = l0 + 32 * sub;
            bf16x8 qf[4];
#pragma unroll
            for (int ds = 0; ds < 4; ++ds) qf[ds] = *(const bf16x8*)(Q + (size_t)(tokb + q0 + r32) * 512 + h * 64 + 16 * ds + 8 * hi);
            f32x16 s[5];
#pragma unroll
            for (int kt = 0; kt < 5; ++kt) {
#pragma unroll
                for (int r = 0; r < 16; ++r) s[kt][r] = 0.f;
                const LAS unsigned char* kp = lds + (32 * (kt + sub) + r32) * KST + hk * 128 + hi * 16;
#pragma unroll
                for (int ds = 0; ds < 4; ++ds) { const bf16x8 kf = *(const LAS bf16x8*)(kp + ds * 32); s[kt] = __builtin_amdgcn_mfma_f32_32x32x16_bf16(kf, qf[ds], s[kt], 0, 0, 0); }
                if (kt < 4) { const bool dead = (q0 - 128 + 32 * kt) < 0;
#pragma unroll
                    for (int r = 0; r < 16; ++r) s[kt][r] = dead ? -1e30f : s[kt][r]; }
            }
#pragma unroll
            for (int r = 0; r < 16; ++r) { const int cr = crow(r, hi); if (cr <= r32) s[0][r] = -1e30f; if (cr > r32) s[4][r] = -1e30f; }
            float m = sink2;
#pragma unroll
            for (int kt = 0; kt < 5; ++kt)
#pragma unroll
                for (int r = 0; r < 16; ++r) m = fmaxf(m, s[kt][r]);
            m = fmaxf(m, __shfl_xor(m, 32));
            float sum = 0.f;
#pragma unroll
            for (int kt = 0; kt < 5; ++kt)
#pragma unroll
                for (int r = 0; r < 16; ++r) { const float pv = __builtin_amdgcn_exp2f(s[kt][r] - m); s[kt][r] = pv; sum += pv; }
            sum += __shfl_xor(sum, 32);
            const float inv = 1.0f / (sum + __builtin_amdgcn_exp2f(sink2 - m));
            __builtin_amdgcn_sched_barrier(0);
            f32x16 o[2];
#pragma unroll
            for (int r = 0; r < 16; ++r) { o[0][r] = 0.f; o[1][r] = 0.f; }
#pragma unroll
            for (int kt = 0; kt < 5; ++kt) {
#pragma unroll
                for (int ks = 0; ks < 2; ++ks) {
                    u32x4 pw; pw.x = cvt_pk_bf16(s[kt][8 * ks + 0], s[kt][8 * ks + 1]); pw.y = cvt_pk_bf16(s[kt][8 * ks + 2], s[kt][8 * ks + 3]);
                    pw.z = cvt_pk_bf16(s[kt][8 * ks + 4], s[kt][8 * ks + 5]); pw.w = cvt_pk_bf16(s[kt][8 * ks + 6], s[kt][8 * ks + 7]);
                    const bf16x8 pa = __builtin_bit_cast(bf16x8, pw);
#pragma unroll
                    for (int dt = 0; dt < 2; ++dt) {
                        const LAS unsigned char* vp = lds + VOFF + (hk * 64 + 32 * dt + r32) * VST + (32 * (kt + sub) + 16 * ks + 4 * hi) * 2;
                        const u32x2 lo = *(const LAS u32x2*)vp, hi2 = *(const LAS u32x2*)(vp + 16);
                        u32x4 vw; vw.x = lo.x; vw.y = lo.y; vw.z = hi2.x; vw.w = hi2.y;
                        o[dt] = __builtin_amdgcn_mfma_f32_32x32x16_bf16(pa, __builtin_bit_cast(bf16x8, vw), o[dt], 0, 0, 0);
                    }
                }
            }
            {
                LAS unsigned short* stg = (LAS unsigned short*)(lds + 102400 + wave * 4608);
#pragma unroll
                for (int r = 0; r < 16; ++r) { const int cr = crow(r, hi); const float iv = __shfl(inv, cr);
                    stg[cr * 72 + r32] = (unsigned short)(cvt_pk_bf16(o[0][r] * iv, 0.f) & 0xffffu); stg[cr * 72 + 32 + r32] = (unsigned short)(cvt_pk_bf16(o[1][r] * iv, 0.f) & 0xffffu); }
                asm volatile("s_waitcnt lgkmcnt(0)" ::: "memory");
                const int row = lane >> 1, hf = lane & 1; float sq = 0.f;
                bf16* dst = MG + (size_t)(tokb + q0 + row) * 1024 + 512 + h * 64 + hf * 32;
#pragma unroll
                for (int i = 0; i < 4; ++i) { const u32x4 w = *(const LAS u32x4*)(stg + row * 72 + hf * 32 + 8 * i);
                    const float a0 = bf_lo(w.x), a1 = bf_hi(w.x), a2 = bf_lo(w.y), a3 = bf_hi(w.y), a4 = bf_lo(w.z), a5 = bf_hi(w.z), a6 = bf_lo(w.w), a7 = bf_hi(w.w);
                    sq += ((a0 * a0 + a1 * a1) + (a2 * a2 + a3 * a3)) + ((a4 * a4 + a5 * a5) + (a6 * a6 + a7 * a7));
                    *(u32x4*)(dst + 8 * i) = w; }
                sq += __shfl_xor(sq, 1);
                if (hf == 0) __builtin_amdgcn_ds_faddf(rsq + 32 * sub + row, sq, 0, 0, false);
                asm volatile("s_waitcnt lgkmcnt(0)" ::: "memory");
            }
        }
        __syncthreads();
        if (tid < 64) ((float*)(ws + WS_RSQ))[NTOK + tokb + l0 + tid] = rsq[tid];
        __syncthreads();
    }
}

#define XB_TMO      128
#define XB_XCNT(j)  (256  + 64 * (j))
#define XB_XSUB(j)  (1280 + 64 * (j))
#define XB_XGEN(j)  (2304 + 64 * (j))
#define XB_TOP      3328
#define XB_TOPGEN   3392
#define XCD_BAR_WORDS 3456
#define XB_SPIN_CAP (1u << 18)

__device__ __forceinline__ unsigned xb_ld(unsigned* p)              { return __hip_atomic_load(p, __ATOMIC_RELAXED, __HIP_MEMORY_SCOPE_AGENT); }
__device__ __forceinline__ unsigned xb_add(unsigned* p, unsigned v) { return __hip_atomic_fetch_add(p, v, __ATOMIC_RELAXED, __HIP_MEMORY_SCOPE_AGENT); }
__device__ __forceinline__ unsigned xb_xcc_id() { return (unsigned)__builtin_amdgcn_s_getreg((3 << 11) | 20) & 0xFu; }
#define XB_SPIN(cond, bar) do { unsigned _sp = 0; while (cond) { __builtin_amdgcn_s_sleep(1); \
    if ((++_sp & 255u) == 0u) { if (xb_ld(&(bar)[XB_TMO])) break; if (_sp > XB_SPIN_CAP) { atomicAdd(&(bar)[XB_TMO], 1u); break; } } } } while (0)

struct XcdBarrier {
    unsigned* bar; unsigned x;
    volatile LAS unsigned* st;
};

__device__ __forceinline__ XcdBarrier xcd_barrier_post(unsigned* bar, volatile LAS unsigned* st) {
    XcdBarrier b; b.bar = bar; b.x = xb_xcc_id(); b.st = st;
    if (threadIdx.x == 0) (void)xb_add(&bar[XB_XCNT(b.x)], 1u);
    return b;
}
__device__ __forceinline__ void xcd_barrier_complete(unsigned* bar, unsigned x, unsigned& nloc, unsigned& nx) {
    const unsigned G = gridDim.x * gridDim.y * gridDim.z;
    unsigned sum, cnt, mine, sp = 0u;
    for (;;) {
        sum = 0u; cnt = 0u; mine = 0u;
#pragma unroll
        for (unsigned j = 0; j < 16; ++j) { const unsigned c = xb_ld(&bar[XB_XCNT(j)]); sum += c; cnt += (c > 0u) ? 1u : 0u; mine = (j == x) ? c : mine; }
        if (sum == G) break;
        __builtin_amdgcn_s_sleep(1);
        if ((++sp & 255u) == 0u) { if (xb_ld(&bar[XB_TMO])) break; if (sp > XB_SPIN_CAP) { atomicAdd(&bar[XB_TMO], 1u); break; } }
    }
    nloc = mine > 0u ? mine : 1u; nx = cnt > 0u ? cnt : 1u;
}

__device__ __forceinline__ void xcd_barrier(const XcdBarrier& b) {
    asm volatile("s_waitcnt vmcnt(0)" ::: "memory");
    __syncthreads();
    if (threadIdx.x == 0) {
        unsigned* bar = b.bar;
        __builtin_amdgcn_s_waitcnt(0);
        unsigned nloc = b.st[0], nx = b.st[1];
        if (nloc == 0u) { xcd_barrier_complete(bar, b.x, nloc, nx); b.st[0] = nloc; b.st[1] = nx; }
        const unsigned old = xb_add(&bar[XB_XSUB(b.x)], 1u);
        const unsigned gen = old / nloc;
        if (old + 1u == (gen + 1u) * nloc) {
            __builtin_amdgcn_fence(__ATOMIC_RELEASE, "agent");
            asm volatile("s_waitcnt vmcnt(0)" ::: "memory");
            const unsigned og = xb_add(&bar[XB_TOP], 1u);
            const unsigned tg = og / nx;
            if (og + 1u == (tg + 1u) * nx) xb_add(&bar[XB_TOPGEN], 1u);
            else XB_SPIN(xb_ld(&bar[XB_TOPGEN]) == tg, bar);
            __builtin_amdgcn_fence(__ATOMIC_ACQUIRE, "agent");
            xb_add(&bar[XB_XGEN(b.x)], 1u);
            asm volatile("s_waitcnt vmcnt(0)" ::: "memory");
        } else {
            XB_SPIN(xb_ld(&bar[XB_XGEN(b.x)]) == gen, bar);
            __builtin_amdgcn_fence(__ATOMIC_ACQUIRE, "agent");
            asm volatile("s_waitcnt vmcnt(0)" ::: "memory");
        }
    }
    __syncthreads();
}

__device__ __forceinline__ void quad_sync(unsigned* cnt, unsigned target, bool fast) {
    asm volatile("s_waitcnt vmcnt(0)" ::: "memory");
    __syncthreads();
    if (threadIdx.x == 0) {
        if (!fast) { __builtin_amdgcn_fence(__ATOMIC_RELEASE, "agent"); asm volatile("s_waitcnt vmcnt(0)" ::: "memory"); }
        (void)xb_add(cnt, 1u);
        unsigned sp = 0u; while (xb_ld(cnt) < target) { __builtin_amdgcn_s_sleep(1); if (++sp > (1u << 22)) break; }
        __builtin_amdgcn_fence(__ATOMIC_ACQUIRE, "agent");
        asm volatile("s_waitcnt vmcnt(0)" ::: "memory");
    }
    __syncthreads();
}

__global__ void __launch_bounds__(512, 2) fwd_megakernel(Params P) {
    extern __shared__ __attribute__((aligned(16))) unsigned char lds_raw[];
    LAS unsigned char* lds = (LAS unsigned char*)lds_raw;
    const int tid = threadIdx.x, lane = tid & 63, wave = __builtin_amdgcn_readfirstlane(tid >> 6);
    const int G = gridDim.x, blk = blockIdx.x;
    unsigned char* ws = P.ws;
    typedef pg8::bf16_t bt;

    if (tid < 4) ((LAS unsigned*)(lds + LDSCTL_OFF))[tid] = 0u;
    __syncthreads();
    const XcdBarrier bar = xcd_barrier_post((unsigned*)(ws + WS_BAR), (volatile LAS unsigned*)(lds + LDSCTL_OFF));
    if (tid == 0) __hip_atomic_store((unsigned*)(ws + WS_XT) + blk, bar.x, __ATOMIC_RELAXED, __HIP_MEMORY_SCOPE_AGENT);
    prologue_a(P, lds, tid, lane, wave);
    xcd_barrier(bar);
    {
        pg8::Gemm g{(const bt*)(ws + WS_XN), (const bt*)(ws + WS_WIN), NTOK, INW, DM, DM, DM}; pg8::StaticOrder S; S.init(NTOK, INW, G, blk);
        pg8::EpiInProj E{(bt*)(ws + WS_UX), (bt*)(ws + WS_Q), (bt*)(ws + WS_K), (bt*)(ws + WS_VT), P.pos, (const float*)(ws + WS_RS0)};
        pg8::gemm_phase<pg8::EpiInProj, pg8::StaticOrder, true, true>(lds, g, S, E);
    }
    if (G == 256) { if (blk >= 64) prologue_b(P, lds, tid, lane, wave, blk - 64, 192, 1); } else prologue_b(P, lds, tid, lane, wave, blk, G, 3);
    xcd_barrier(bar);
    ssm_pass_a(P, lane, wave);
    prologue_b(P, lds, tid, lane, wave, blk, G, 2, 2);
    xcd_barrier(bar);
    {
        pg8::Gemm g{(const bt*)(ws + WS_UX), (const bt*)(ws + WS_TW), NGRP * GROWS, NGRP * 512, KX, KX, KX}; pg8::SsmOrder S{blk};
        pg8::EpiSsmC E{(const bt*)(ws + WS_UX), P.ssm_d, (bt*)(ws + WS_Y)};
        pg8::gemm_phase<pg8::EpiSsmC, pg8::SsmOrder, true, true>(lds, g, S, E);
        if (G == 256) { if (blk >= 128) attn_phase(P, lds, tid, lane, wave, (blk - 128) * 2, 2); }
        else for (int u = blk; u < 256; u += G) attn_phase(P, lds, tid, lane, wave, u, 1);
    }
    xcd_barrier(bar);
    const bool quads = (G == 256);
    bool qfast = false; unsigned* qcnt = (unsigned*)(ws + WS_CNT) + 4096;
    if (quads) { const int x = blk & 7, p = (blk >> 3) & 7; unsigned* xt = (unsigned*)(ws + WS_XT);
        const unsigned x0 = xb_ld(xt + x + 8 * p), x1 = xb_ld(xt + x + 8 * (p + 8)), x2 = xb_ld(xt + x + 8 * (p + 16)), x3 = xb_ld(xt + x + 8 * (p + 24));
        qfast = (x0 == x1) && (x1 == x2) && (x2 == x3); qcnt += 64 * (8 * x + p); }
    {
        pg8::Gemm g{(const bt*)(ws + WS_Y), (const bt*)(ws + WS_WGLU), NTOK, 1024, 512, 512, 512}; pg8::StaticOrder S; S.init(NTOK, 1024, G, blk);
        pg8::EpiGated<0> E{(bt*)(ws + WS_MG), 1024, P.b_glu, (float*)(ws + WS_RSQ)};
        pg8::gemm_phase<pg8::EpiGated<0>, pg8::StaticOrder, true, true>(lds, g, S, E);
    }
    if (quads) quad_sync(qcnt, 4u, qfast); else xcd_barrier(bar);
    {
        pg8::Gemm g{(const bt*)(ws + WS_MG), (const bt*)(ws + WS_WOUT), NTOK, DM, DM, DM, DM}; pg8::StaticOrder S; S.init(NTOK, DM, G, blk);
        pg8::PanelSq st1{(float*)(ws + WS_XB), (unsigned*)(ws + WS_CNT), NORM_EPS};
        LAS float* tab = (LAS float*)(lds + LDSCTL_OFF + 64);
        { pg8::Unit u0; if (S.next(0, u0) && tid < 256) { const int row = u0.pm * 256 + tid; const float sa = ((const float*)(ws + WS_RSQ))[row] * (1.0f / 512.0f) + NORM_EPS, sb = ((const float*)(ws + WS_RSQ))[NTOK + row] * (1.0f / 512.0f) + NORM_EPS;
            tab[tid] = sqrtf(sb / sa); tab[256 + tid] = 1.0f / sqrtf(sb); } }
        __syncthreads();
        pg8::EpiNormResNorm E{(const bt*)(ws + WS_XN), (bt*)(ws + WS_HB), (float*)(ws + WS_RSQH), P.g_post_mix, st1, tab, 8};
        pg8::gemm_phase<pg8::EpiNormResNorm, pg8::StaticOrder, false, true>(lds, g, S, E);
    }
    if (quads) quad_sync(qcnt, 8u, qfast); else xcd_barrier(bar);
    {
        pg8::Gemm g{(const bt*)(ws + WS_HB), (const bt*)(ws + WS_WGU), NTOK, 2 * DFF, DM, DM, DM}; pg8::StaticOrder S; S.init(NTOK, 2 * DFF, G, blk);
        pg8::EpiGated<1> E{(bt*)(ws + WS_ACT), DFF, nullptr, (float*)(ws + WS_RSQH)};
        pg8::gemm_phase<pg8::EpiGated<1>, pg8::StaticOrder, true, true>(lds, g, S, E);
    }
    if (quads) quad_sync(qcnt, 12u, qfast); else xcd_barrier(bar);
    {
        pg8::Gemm g{(const bt*)(ws + WS_ACT), (const bt*)(ws + WS_WDN), NTOK, DM, DFF, DFF, DFF}; pg8::StaticOrder S; S.init(NTOK, DM, G, blk);
        pg8::PanelSq st{(float*)(ws + WS_XB) + 2 * NTOK * 4, (unsigned*)(ws + WS_CNT) + 2 * 4096, NORM_EPS};
        pg8::EpiNormRes E{(const bt*)(ws + WS_HB), P.out, P.g_post_ffn, st};
        pg8::gemm_phase<pg8::EpiNormRes, pg8::StaticOrder, false, true>(lds, g, S, E);
    }
}

extern "C" void kernel_launch(void* const* d_in, const int* in_sizes, int n_in, void* d_out, int out_size, void* d_ws, size_t ws_size, hipStream_t stream) {
    static int grid_blocks = 0;
    if (grid_blocks == 0) {
        int dev = 0, cus = 0, per_cu = 0;
        hipGetDevice(&dev);
        hipDeviceGetAttribute(&cus, hipDeviceAttributeMultiprocessorCount, dev);
        hipFuncSetAttribute((const void*)fwd_megakernel, hipFuncAttributeMaxDynamicSharedMemorySize, LDS_BYTES);
        hipOccupancyMaxActiveBlocksPerMultiprocessor(&per_cu, (const void*)fwd_megakernel, 512, LDS_BYTES);
        if (per_cu < 1) { fprintf(stderr, "kernel_launch: occupancy query reports %d blocks per CU\n", per_cu); per_cu = 1; }
        grid_blocks = cus * 1;
        (void)hipGetLastError();
    }
    Params p{};
    p.x = (const float*)d_in[0]; p.pos = (const int*)d_in[1]; p.g_pre_mix = (const float*)d_in[2]; p.w_in = (const float*)d_in[3]; p.lam_re = (const float*)d_in[4]; p.lam_im = (const float*)d_in[5];
    p.log_dt = (const float*)d_in[6]; p.b_re = (const float*)d_in[7]; p.b_im = (const float*)d_in[8]; p.c_re = (const float*)d_in[9]; p.c_im = (const float*)d_in[10]; p.ssm_d = (const float*)d_in[11];
    p.w_glu = (const float*)d_in[12]; p.b_glu = (const float*)d_in[13]; p.sinks = (const float*)d_in[14]; p.g_ssm_out = (const float*)d_in[15]; p.g_attn_out = (const float*)d_in[16]; p.w_out = (const float*)d_in[17];
    p.g_post_mix = (const float*)d_in[18]; p.g_pre_ffn = (const float*)d_in[19]; p.w_gate_up = (const float*)d_in[20]; p.w_down = (const float*)d_in[21]; p.g_post_ffn = (const float*)d_in[22];
    p.out = (float*)d_out; p.ws = (unsigned char*)d_ws;
    (void)hipMemsetAsync(d_ws, 0, 65536, stream);
    void* args[] = {&p};
    hipError_t e = hipLaunchCooperativeKernel((const void*)fwd_megakernel, dim3(grid_blocks), dim3(512), args, LDS_BYTES, stream);
    if (e != hipSuccess) fprintf(stderr, "cooperative launch failed: %s (grid %d)\n", hipGetErrorString(e), grid_blocks);
}
```

```cpp
#include <hip/hip_runtime.h>
#include <hip/hip_cooperative_groups.h>
#include <cstdio>
#include <cstdint>
namespace cg = cooperative_groups;
namespace pg8 {
#define PG8_LAS __attribute__((address_space(3)))
typedef unsigned short bf16_t;
typedef short bf16x8 __attribute__((ext_vector_type(8)));
typedef float f32x4 __attribute__((ext_vector_type(4)));
typedef unsigned u32x4 __attribute__((ext_vector_type(4)));
constexpr int BM = 256, BK = 64, HALF = 128, HTB = HALF * BK * 2  , STAGE_BYTES = 8 * HTB, NXCD = 8, WGM = 8;

__host__ __device__ __forceinline__ int lds_byte(int r, int c) { const int st = (r >> 4) * 2 + (c >> 5), rr = r & 15, cc = c & 31, ob = rr * 64 + cc * 2; return st * 1024 + (ob ^ (((ob >> 9) & 1) << 5)); }
__host__ __device__ __forceinline__ void stage_rc(int b, int& R, int& C) { const int st = b / 1024, sb = b % 1024, swz = sb ^ (((sb >> 9) & 1) << 5); R = (st >> 1) * 16 + swz / 64; C = (st & 1) * 32 + (swz % 64) / 2; }
__host__ __device__ __forceinline__ int perm32(int rho) { const int n = rho >> 4, i = rho & 15; return 8 * (i >> 2) + 4 * n + (i & 3); }

struct Unit { int pm, pn; };
struct Gemm { const bf16_t* A; const bf16_t* Bt; int M, N, K, lda, ldb; };

struct StaticOrder {
    int nM, nN, nwg, G, c;
    __host__ __device__ void init(int M, int N, int G_, int c_) { nM = M / BM; nN = N / BM; nwg = nM * nN; G = G_; c = c_; }
    __host__ __device__ bool next(int i, Unit& u) const {
        const long L = (long)i * G + c; if (L >= nwg) return false;
        int wgid = (int)L; { const int q = nwg / NXCD, r = nwg % NXCD, xcd = wgid % NXCD, off = wgid / NXCD; wgid = (xcd < r ? xcd * (q + 1) : r * (q + 1) + (xcd - r) * q) + off; }
        const int nig = WGM * nN, gid = wgid / nig, fm = gid * WGM, gsz = (nM - fm) < WGM ? (nM - fm) : WGM;
        u.pm = fm + ((wgid % nig) % gsz); u.pn = (wgid % nig) / gsz; return true;
    }
    __device__ __forceinline__ void a_ready(const Unit&) const {}
    __device__ __forceinline__ void done(const Unit&) const {}
};

__device__ __forceinline__ unsigned cvt_pk_bf16(float lo, float hi) { unsigned r; asm volatile("v_cvt_pk_bf16_f32 %0, %1, %2" : "=v"(r) : "v"(lo), "v"(hi)); return r; }
template <class Epi, class Sched, bool ALIGN_EPI = false, bool SP2 = false>
__device__ __forceinline__ void gemm_phase(PG8_LAS unsigned char* lds, const Gemm g, const Sched& S, const Epi& E) {
    const int tid = threadIdx.x, wid = __builtin_amdgcn_readfirstlane(tid >> 6), lane = tid & 63, wr = wid >> 2, wc = wid & 3, fr = lane & 15, fq = lane >> 4;
    const int K = g.K, nt = K / BK;
    unsigned voffA[2], voffB[2];
#pragma unroll
    for (int i = 0; i < 2; ++i) { int R, C; stage_rc(tid * 16 + i * 8192, R, C); const int Rb = Epi::PERM ? ((R & ~31) + perm32(R & 31)) : R;
        voffA[i] = (unsigned)(R * g.lda + C) * 2u; voffB[i] = (unsigned)(Rb * g.ldb + C) * 2u; }
    const size_t kstep = (size_t)(BK * 2);
    const size_t hstepA = (size_t)HALF * g.lda * 2, hstepB = (size_t)HALF * g.ldb * 2;
    const size_t tstepA = 2 * hstepA, tstepB = 2 * hstepB;
    const unsigned ldsw = (unsigned)wid * 1024u;
    const int aoff = lds_byte(wr * 64 + fr, fq * 8), boff = lds_byte(wc * 32 + fr, fq * 8);
#define PG8_SA(b, h) (((b) * 2 + (h)) * HTB)
#define PG8_SB(b, h) ((4 + (b) * 2 + (h)) * HTB)
#define PG8_STAGE(bufoff, gbase, voff) do { _Pragma("unroll") for (int _i = 0; _i < 2; ++_i) \
        __builtin_amdgcn_global_load_lds((const unsigned*)((const char*)(gbase) + (voff)[_i]), (PG8_LAS unsigned*)(lds + (bufoff) + ldsw + _i * 8192), 16, 0, 0); } while (0)
#define PG8_LDA(dst, b, h) do { _Pragma("unroll") for (int m = 0; m < 4; ++m) _Pragma("unroll") for (int k = 0; k < 2; ++k) dst[m][k] = *(const PG8_LAS bf16x8*)(lds + PG8_SA(b, h) + aoff + m * 2048 + k * 1024); } while (0)
#define PG8_LDB(dst, b, h) do { _Pragma("unroll") for (int n = 0; n < 2; ++n) _Pragma("unroll") for (int k = 0; k < 2; ++k) dst[n][k] = *(const PG8_LAS bf16x8*)(lds + PG8_SB(b, h) + boff + n * 2048 + k * 1024); } while (0)
#define PG8_MMA(ai, bj, At, Bt) do { __builtin_amdgcn_s_setprio(1); _Pragma("unroll") for (int m = 0; m < 4; ++m) _Pragma("unroll") for (int n = 0; n < 2; ++n) _Pragma("unroll") for (int k = 0; k < 2; ++k) \
        acc[ai][bj][m][n] = __builtin_amdgcn_mfma_f32_16x16x32_bf16(Bt[n][k], At[m][k], acc[ai][bj][m][n], 0, 0, 0); __builtin_amdgcn_s_setprio(0); } while (0)
#define PG8_WAIT_V(n) asm volatile("s_waitcnt vmcnt(" #n ")" ::: "memory")
#define PG8_WAIT_L(n) asm volatile("s_waitcnt lgkmcnt(" #n ")" ::: "memory")
#define PG8_BAR __builtin_amdgcn_s_barrier()
#define PG8_SCHED __builtin_amdgcn_sched_barrier(0)
    Unit cur, nxt; int ui = 0;
    if (!S.next(0, cur)) return;
    f32x4 acc[2][2][4][2];
#pragma unroll
    for (int a = 0; a < 2; ++a)
#pragma unroll
        for (int b = 0; b < 2; ++b)
#pragma unroll
            for (int m = 0; m < 4; ++m)
#pragma unroll
                for (int n = 0; n < 2; ++n) acc[a][b][m][n] = (f32x4){0.f, 0.f, 0.f, 0.f};
    bf16x8 At[4][2], B0[2][2], B1[2][2];
    const char* cA = (const char*)g.A + (size_t)cur.pm * tstepA; const char* cB = (const char*)g.Bt + (size_t)cur.pn * tstepB;
    S.a_ready(cur);
    if constexpr (SP2) {
        PG8_STAGE(PG8_SB(0, 0), cB, voffB); PG8_STAGE(PG8_SB(0, 1), cB + hstepB, voffB); PG8_STAGE(PG8_SA(0, 0), cA, voffA); PG8_STAGE(PG8_SA(0, 1), cA + hstepA, voffA);
        if (wr == 1) PG8_BAR;
        PG8_WAIT_V(2); PG8_BAR;
        PG8_STAGE(PG8_SB(1, 0), cB + kstep, voffB); PG8_STAGE(PG8_SA(1, 0), cA + kstep, voffA); PG8_STAGE(PG8_SB(1, 1), cB + hstepB + kstep, voffB);
        PG8_WAIT_V(6); PG8_BAR;
    } else {
        PG8_STAGE(PG8_SB(0, 0), cB, voffB); PG8_STAGE(PG8_SA(0, 0), cA, voffA); PG8_STAGE(PG8_SB(0, 1), cB + hstepB, voffB); PG8_STAGE(PG8_SA(0, 1), cA + hstepA, voffA);
        if (wr == 1) PG8_BAR;
        PG8_WAIT_V(4); PG8_BAR;
        PG8_STAGE(PG8_SB(1, 0), cB + kstep, voffB); PG8_STAGE(PG8_SA(1, 0), cA + kstep, voffA); PG8_STAGE(PG8_SB(1, 1), cB + hstepB + kstep, voffB);
        PG8_WAIT_V(6); PG8_BAR;
    }
    for (;;) {
        const bool has_next = S.next(ui + 1, nxt);
        const char* nA = has_next ? (const char*)g.A + (size_t)nxt.pm * tstepA : cA; const char* nB = has_next ? (const char*)g.Bt + (size_t)nxt.pn * tstepB : cB;
        for (int t = 0; t < nt; t += 2) {
            if constexpr (Epi::HAS_MID) { if (t == E.kmid) E.mid(acc, cur, wr, wc, fr, fq); }
            const bool last = (t == nt - 2);
            const char* a1 = cA + (size_t)(t + 1) * kstep;
            const char* a2 = last ? nA : cA + (size_t)(t + 2) * kstep; const char* b2 = last ? nB : cB + (size_t)(t + 2) * kstep;
            const char* a3 = a2 + kstep; const char* b3 = b2 + kstep;
            if (last && has_next) S.a_ready(nxt);
            if constexpr (SP2) {
            PG8_LDB(B0, 0, 0); PG8_LDB(B1, 0, 1); PG8_SCHED; PG8_LDA(At, 0, 0); PG8_STAGE(PG8_SA(1, 1), a1 + hstepA, voffA);
            PG8_WAIT_V(8); PG8_WAIT_L(0); PG8_BAR; PG8_MMA(0, 0, At, B0); PG8_MMA(0, 1, At, B1); PG8_BAR; PG8_SCHED;
            PG8_LDA(At, 0, 1); PG8_STAGE(PG8_SB(0, 0), b2, voffB); PG8_STAGE(PG8_SB(0, 1), b2 + hstepB, voffB); PG8_STAGE(PG8_SA(0, 0), a2, voffA);
            PG8_WAIT_V(8); PG8_WAIT_L(0); PG8_BAR; PG8_MMA(1, 0, At, B0); PG8_MMA(1, 1, At, B1); PG8_BAR; PG8_SCHED;
            PG8_LDB(B0, 1, 0); PG8_LDB(B1, 1, 1); PG8_SCHED; PG8_LDA(At, 1, 0); PG8_STAGE(PG8_SA(0, 1), a2 + hstepA, voffA);
            PG8_WAIT_V(8); PG8_WAIT_L(0); PG8_BAR; PG8_MMA(0, 0, At, B0); PG8_MMA(0, 1, At, B1); PG8_BAR; PG8_SCHED;
            PG8_LDA(At, 1, 1); PG8_STAGE(PG8_SB(1, 0), b3, voffB); PG8_STAGE(PG8_SB(1, 1), b3 + hstepB, voffB); PG8_STAGE(PG8_SA(1, 0), a3, voffA);
            PG8_WAIT_V(8); PG8_WAIT_L(0); PG8_BAR; PG8_MMA(1, 0, At, B0); PG8_MMA(1, 1, At, B1); PG8_BAR; PG8_SCHED;
            } else {
            PG8_LDB(B0, 0, 0); PG8_SCHED; PG8_LDA(At, 0, 0); PG8_STAGE(PG8_SA(1, 1), a1 + hstepA, voffA);
            PG8_WAIT_L(8); PG8_BAR; PG8_WAIT_L(0); PG8_MMA(0, 0, At, B0); PG8_BAR; PG8_SCHED;
            PG8_LDB(B1, 0, 1); PG8_STAGE(PG8_SB(0, 0), b2, voffB);
            PG8_BAR; PG8_WAIT_L(0); PG8_MMA(0, 1, At, B1); PG8_BAR;
            PG8_LDA(At, 0, 1); PG8_STAGE(PG8_SA(0, 0), a2, voffA);
            PG8_BAR; PG8_WAIT_L(0); PG8_MMA(1, 0, At, B0); PG8_BAR; PG8_SCHED;
            PG8_STAGE(PG8_SB(0, 1), b2 + hstepB, voffB);
            PG8_WAIT_V(6); PG8_BAR; PG8_MMA(1, 1, At, B1); PG8_BAR;
            PG8_LDB(B0, 1, 0); PG8_SCHED; PG8_LDA(At, 1, 0); PG8_STAGE(PG8_SA(0, 1), a2 + hstepA, voffA);
            PG8_WAIT_L(8); PG8_BAR; PG8_WAIT_L(0); PG8_MMA(0, 0, At, B0); PG8_BAR; PG8_SCHED;
            PG8_LDB(B1, 1, 1); PG8_STAGE(PG8_SB(1, 0), b3, voffB);
            PG8_BAR; PG8_WAIT_L(0); PG8_MMA(0, 1, At, B1); PG8_BAR;
            PG8_LDA(At, 1, 1); PG8_STAGE(PG8_SA(1, 0), a3, voffA);
            PG8_BAR; PG8_WAIT_L(0); PG8_MMA(1, 0, At, B0); PG8_BAR; PG8_SCHED;
            PG8_STAGE(PG8_SB(1, 1), b3 + hstepB, voffB);
            PG8_WAIT_V(6); PG8_BAR; PG8_MMA(1, 1, At, B1); PG8_BAR;
            }
        }
        if constexpr (ALIGN_EPI) { if (wr == 0) PG8_BAR; }
        if constexpr (!Epi::AFTER_DRAIN) { E(acc, cur, wr, wc, fr, fq); S.done(cur); }
        if (!has_next) break;
#pragma unroll
        for (int a = 0; a < 2; ++a)
#pragma unroll
            for (int b = 0; b < 2; ++b)
#pragma unroll
                for (int m = 0; m < 4; ++m)
#pragma unroll
                    for (int n = 0; n < 2; ++n) acc[a][b][m][n] = (f32x4){0.f, 0.f, 0.f, 0.f};
        cur = nxt; cA = nA; cB = nB; ++ui;
        if constexpr (ALIGN_EPI) { if (wr == 1) PG8_BAR; }
    }
    PG8_WAIT_V(0);
    if constexpr (!ALIGN_EPI) { if (wr == 0) PG8_BAR; }
    PG8_BAR;
    if constexpr (Epi::AFTER_DRAIN) { E.fused(acc, cur, wr, wc, fr, fq, lds, wid, lane); S.done(cur); }
#undef PG8_SA
#undef PG8_SB
#undef PG8_STAGE
#undef PG8_LDA
#undef PG8_LDB
#undef PG8_MMA
#undef PG8_WAIT_V
#undef PG8_WAIT_L
#undef PG8_BAR
#undef PG8_SCHED
}
}

constexpr int NTOK = 16384, DM = 1024, INW = 1280, SSMW = 512, NGRP = 32, NST = 64, SEQL = 2048, NBATCH = 8, DFF = 2816;
constexpr int TCH = 32, NCH = SEQL / TCH  , GROWS = NBATCH * NCH  , KX = 128 + TCH * 16  ;
constexpr size_t MiB = 1u << 20;
constexpr size_t WS_BAR = 0;
constexpr size_t WS_CNT = 16384;
constexpr size_t WS_XB = 65536;
constexpr size_t WS_RSQ = 896 * 1024;
constexpr size_t WS_RS0 = 1 * MiB + 65536;
constexpr size_t WS_XT = 1 * MiB + 131072;
constexpr size_t WS_RSQH = 1 * MiB;
constexpr size_t WS_WIN = 2 * MiB, WS_WGLU = 5 * MiB, WS_WOUT = 6 * MiB, WS_WGU = 8 * MiB, WS_WDN = 19 * MiB;
constexpr size_t WS_TW = 25 * MiB;
constexpr size_t WS_W1 = 45 * MiB;
constexpr size_t WS_AT = 49 * MiB;
constexpr size_t WS_XN = 50 * MiB;
constexpr size_t WS_UX = 162 * MiB;
constexpr size_t WS_Q = 182 * MiB, WS_K = 198 * MiB, WS_VT = 202 * MiB;
constexpr size_t WS_Y = 82 * MiB;
constexpr size_t WS_MG = 98 * MiB;
constexpr size_t WS_ACT = 162 * MiB;
constexpr size_t WS_HB = 130 * MiB;
constexpr size_t WS_END = 250 * MiB;
constexpr int LDS_BYTES = 147456, LDSCTL_OFF = 143360;
constexpr float NORM_EPS = 1e-6f;
constexpr float LOG2E = 1.4426950408889634f;

#define LAS __attribute__((address_space(3)))
typedef unsigned short bf16;
typedef float f32x4 __attribute__((ext_vector_type(4)));
typedef float f32x16 __attribute__((ext_vector_type(16)));
typedef unsigned u32x4 __attribute__((ext_vector_type(4)));
typedef unsigned u32x2 __attribute__((ext_vector_type(2)));
typedef float f32x2 __attribute__((ext_vector_type(2)));
typedef short bf16x8 __attribute__((ext_vector_type(8)));
using pg8::cvt_pk_bf16;

__device__ __forceinline__ float bf_lo(unsigned w) { return __uint_as_float(w << 16); }
__device__ __forceinline__ float bf_hi(unsigned w) { return __uint_as_float(w & 0xffff0000u); }
__device__ __forceinline__ float fast_sigmoid(float x) { return __builtin_amdgcn_rcpf(1.0f + __builtin_amdgcn_exp2f(-x * LOG2E)); }
__device__ __forceinline__ float gelu_tanh(float x) { const float u = 1.5957691216057308f * (x + 0.044715f * x * x * x); return x * fast_sigmoid(u); }
__device__ __forceinline__ float wave_sum(float v) {
#pragma unroll
    for (int o = 1; o < 64; o <<= 1) v += __shfl_xor(v, o);
    return v;
}
__device__ __forceinline__ int crow(int r, int hi) { return (r & 3) + 8 * (r >> 2) + 4 * hi; }

struct Params {
    const float* x; const int* pos; const float* g_pre_mix; const float* w_in; const float* lam_re; const float* lam_im; const float* log_dt;
    const float* b_re; const float* b_im; const float* c_re; const float* c_im; const float* ssm_d; const float* w_glu; const float* b_glu; const float* sinks;
    const float* g_ssm_out; const float* g_attn_out; const float* w_out; const float* g_post_mix; const float* g_pre_ffn; const float* w_gate_up; const float* w_down; const float* g_post_ffn;
    float* out; unsigned char* ws;
};

namespace pg8 {
struct EpiInProj {
    static constexpr bool PERM = true, AFTER_DRAIN = false, HAS_MID = false;
    bf16_t* UX; bf16_t* Q; bf16_t* Kb; bf16_t* VT; const PG8_LAS float* ptab;
    __device__ __forceinline__ void operator()(const f32x4 (&acc_)[2][2][4][2], const Unit& u, int wr, int wc, int fr, int fq) const {
        const int row0 = u.pm * BM + wr * 64 + fr;
        f32x4 acc[2][2][4][2];
#pragma unroll
        for (int ai = 0; ai < 2; ++ai)
#pragma unroll
            for (int m = 0; m < 4; ++m) { const float r = ptab[ai * HALF + wr * 64 + m * 16 + fr];
#pragma unroll
                for (int bj = 0; bj < 2; ++bj)
#pragma unroll
                    for (int n = 0; n < 2; ++n) acc[ai][bj][m][n] = acc_[ai][bj][m][n] * r; }
        if (u.pn < 2) {
#pragma unroll
            for (int ai = 0; ai < 2; ++ai)
#pragma unroll
                for (int m = 0; m < 4; ++m) { const int tok = row0 + ai * HALF + m * 16;
#pragma unroll
                    for (int bj = 0; bj < 2; ++bj) { const int g = u.pn * 16 + bj * 8 + wc * 2 + (fq >> 1), h0 = 8 * (fq & 1);
                        bf16_t* dst = UX + ((size_t)(g * 512 + (tok >> 5))) * 640 + 128 + (tok & 31) * 16 + h0;
                        const f32x4 v0 = acc[ai][bj][m][0], v1 = acc[ai][bj][m][1]; u32x4 w;
                        w.x = cvt_pk_bf16(v0[0], v0[1]); w.y = cvt_pk_bf16(v0[2], v0[3]); w.z = cvt_pk_bf16(v1[0], v1[1]); w.w = cvt_pk_bf16(v1[2], v1[3]);
                        *(u32x4*)dst = w; } }
        } else {
            const bool isq = u.pn < 4; const bool dorope = (wc & 1) == 0;
            const float qs = 0.125f * 1.4426950408889634f;
#pragma unroll
            for (int ai = 0; ai < 2; ++ai)
#pragma unroll
                for (int m = 0; m < 4; ++m) { const int tok = row0 + ai * HALF + m * 16;
                    float cs0[4], sn0[4], cs1[4], sn1[4];
                    if (dorope) { const float pf = ptab[256 + ai * HALF + wr * 64 + m * 16 + fr];
                        constexpr float IFR[8] = {0.15915494309189535f, 0.03086376340470123f, 0.005985185712713705f, 0.001160663641240061f, 0.00022507907903927653f, 4.364795279280289e-05f, 8.464330808241401e-06f, 1.6414262627950345e-06f};
#pragma unroll
                        for (int j = 0; j < 4; ++j) { const float r0 = __builtin_amdgcn_fractf(pf * IFR[j]), r1 = __builtin_amdgcn_fractf(pf * IFR[4 + j]);
                            cs0[j] = __builtin_amdgcn_cosf(r0); sn0[j] = __builtin_amdgcn_sinf(r0); cs1[j] = __builtin_amdgcn_cosf(r1); sn1[j] = __builtin_amdgcn_sinf(r1); } }
#pragma unroll
                    for (int bj = 0; bj < 2; ++bj) {
                        f32x4 v0 = acc[ai][bj][m][0], v1 = acc[ai][bj][m][1];
                        if (isq || bj == 0) {
                            if (dorope) {
#pragma unroll
                                for (int j = 0; j < 4; ++j) {
                                    const float p0 = __shfl_xor(v0[j], 16), p1 = __shfl_xor(v1[j], 16);
                                    const float c0 = cs0[j], s0 = sn0[j], c1 = cs1[j], s1 = sn1[j];
                                    if (fq == 0) { v0[j] = v0[j] * c0 - p0 * s0; v1[j] = v1[j] * c1 - p1 * s1; }
                                    else if (fq == 1) { v0[j] = v0[j] * c0 + p0 * s0; v1[j] = v1[j] * c1 + p1 * s1; }
                                }
                            }
                            bf16_t* dst;
                            if (isq) { const int head = (u.pn - 2) * 4 + bj * 2 + (wc >> 1); v0 = v0 * qs; v1 = v1 * qs; dst = Q + (size_t)tok * 512 + head * 64 + (wc & 1) * 32 + 8 * fq; }
                            else dst = Kb + (size_t)tok * 128 + (wc >> 1) * 64 + (wc & 1) * 32 + 8 * fq;
                            u32x4 w; w.x = cvt_pk_bf16(v0[0], v0[1]); w.y = cvt_pk_bf16(v0[2], v0[3]); w.z = cvt_pk_bf16(v1[0], v1[1]); w.w = cvt_pk_bf16(v1[2], v1[3]);
                            *(u32x4*)dst = w;
                        } else {
                            const int hk = wc >> 1, d0 = (wc & 1) * 32 + 8 * fq, b = tok >> 11, l = tok & 2047;
                            bf16_t* dst = VT + ((size_t)((b * 2 + hk) * 64 + d0)) * 2048 + l;
#pragma unroll
                            for (int j = 0; j < 4; ++j) { dst[(size_t)j * 2048] = (bf16_t)(cvt_pk_bf16(v0[j], 0.f) & 0xffffu); dst[(size_t)(4 + j) * 2048] = (bf16_t)(cvt_pk_bf16(v1[j], 0.f) & 0xffffu); }
                        }
                    }
                }
        }
    }
};
struct EpiSsmC {
    static constexpr bool PERM = true, AFTER_DRAIN = false, HAS_MID = false;
    const bf16_t* UX; const float* dvec; bf16_t* Y;
    __device__ __forceinline__ void operator()(const f32x4 (&acc)[2][2][4][2], const Unit& u, int wr, int wc, int fr, int fq) const {
        const int g = u.pm >> 1, pmr = u.pm & 1, pnr = u.pn & 1, h0 = 8 * (fq & 1);
        const f32x4 d0 = *(const f32x4*)(dvec + g * 16 + h0), d1 = *(const f32x4*)(dvec + g * 16 + h0 + 4);
#pragma unroll
        for (int ai = 0; ai < 2; ++ai)
#pragma unroll
            for (int m = 0; m < 4; ++m) { const int nloc = pmr * 256 + ai * HALF + wr * 64 + m * 16 + fr;
#pragma unroll
                for (int bj = 0; bj < 2; ++bj) { const int t = pnr * 16 + bj * 8 + wc * 2 + (fq >> 1); const int tok = nloc * 32 + t;
                    const u32x4 uw = *(const u32x4*)(UX + ((size_t)(g * 512 + nloc)) * 640 + 128 + t * 16 + h0);
                    const f32x4 a0 = acc[ai][bj][m][0], a1 = acc[ai][bj][m][1];
                    float y[8];
                    y[0] = a0[0] + d0[0] * bf_lo(uw.x); y[1] = a0[1] + d0[1] * bf_hi(uw.x); y[2] = a0[2] + d0[2] * bf_lo(uw.y); y[3] = a0[3] + d0[3] * bf_hi(uw.y);
                    y[4] = a1[0] + d1[0] * bf_lo(uw.z); y[5] = a1[1] + d1[1] * bf_hi(uw.z); y[6] = a1[2] + d1[2] * bf_lo(uw.w); y[7] = a1[3] + d1[3] * bf_hi(uw.w);
#pragma unroll
                    for (int i = 0; i < 8; ++i) y[i] = gelu_tanh(y[i]);
                    u32x4 w; w.x = cvt_pk_bf16(y[0], y[1]); w.y = cvt_pk_bf16(y[2], y[3]); w.z = cvt_pk_bf16(y[4], y[5]); w.w = cvt_pk_bf16(y[6], y[7]);
                    *(u32x4*)(Y + (size_t)tok * 512 + g * 16 + h0) = w; } }
    }
};
template <int MODE  > struct EpiGated {
    static constexpr bool PERM = true, AFTER_DRAIN = false, HAS_MID = false;
    bf16_t* O; int ldc; const float* bias; float* rowsq; const PG8_LAS float* rtab;
    __device__ __forceinline__ void operator()(const f32x4 (&acc)[2][2][4][2], const Unit& u, int wr, int wc, int fr, int fq) const {
        const int row0 = u.pm * BM + wr * 64 + fr, col0 = u.pn * HALF + wc * 32 + 8 * fq;
        float rsc[2][4];
        if (MODE == 1) {
#pragma unroll
            for (int ai = 0; ai < 2; ++ai)
#pragma unroll
                for (int m = 0; m < 4; ++m) rsc[ai][m] = rtab[ai * HALF + wr * 64 + m * 16 + fr];
        }
        f32x4 ba[2], bg[2];
        if (MODE == 0) { ba[0] = *(const f32x4*)(bias + col0); ba[1] = *(const f32x4*)(bias + col0 + 4); bg[0] = *(const f32x4*)(bias + 512 + col0); bg[1] = *(const f32x4*)(bias + 512 + col0 + 4); }
#pragma unroll
        for (int ai = 0; ai < 2; ++ai)
#pragma unroll
            for (int m = 0; m < 4; ++m) { float o[8];
#pragma unroll
                for (int n = 0; n < 2; ++n)
#pragma unroll
                    for (int j = 0; j < 4; ++j) { const float a = (MODE == 1) ? acc[ai][0][m][n][j] * rsc[ai][m] : acc[ai][0][m][n][j], gt = (MODE == 1) ? acc[ai][1][m][n][j] * rsc[ai][m] : acc[ai][1][m][n][j];
                        o[4 * n + j] = (MODE == 0) ? (a + ba[n][j]) * fast_sigmoid(gt + bg[n][j]) : (a * fast_sigmoid(a)) * gt; }
                u32x4 w; w.x = cvt_pk_bf16(o[0], o[1]); w.y = cvt_pk_bf16(o[2], o[3]); w.z = cvt_pk_bf16(o[4], o[5]); w.w = cvt_pk_bf16(o[6], o[7]);
                *(u32x4*)(O + (size_t)(row0 + ai * HALF + m * 16) * ldc + col0) = w;
                if (MODE == 0) { float s = ((o[0] * o[0] + o[1] * o[1]) + (o[2] * o[2] + o[3] * o[3])) + ((o[4] * o[4] + o[5] * o[5]) + (o[6] * o[6] + o[7] * o[7]));
                    s += __shfl_xor(s, 16); s += __shfl_xor(s, 32); if (fq == 0) unsafeAtomicAdd(rowsq + row0 + ai * HALF + m * 16, s); } }
    }
};
struct EpiF32 {
    static constexpr bool PERM = true, AFTER_DRAIN = false, HAS_MID = false;
    float* O; int ldc;
    __device__ __forceinline__ void operator()(const f32x4 (&acc)[2][2][4][2], const Unit& u, int wr, int wc, int fr, int fq) const {
        const int row0 = u.pm * BM + wr * 64 + fr, col0 = u.pn * BM + wc * 32 + 8 * fq;
#pragma unroll
        for (int ai = 0; ai < 2; ++ai)
#pragma unroll
            for (int m = 0; m < 4; ++m) { float* rowp = O + (size_t)(row0 + ai * HALF + m * 16) * ldc + col0;
#pragma unroll
                for (int bj = 0; bj < 2; ++bj) { *(f32x4*)(rowp + bj * HALF) = acc[ai][bj][m][0]; *(f32x4*)(rowp + bj * HALF + 4) = acc[ai][bj][m][1]; } }
    }
};

struct PanelSq {
    float* xbuf;
    unsigned* cnt;
    float eps;
    __device__ __forceinline__ void run(const f32x4 (&v)[2][2][4][2], const Unit& u, int wr, int wc, int fr, int fq, PG8_LAS unsigned char* lds, int wid, int lane) const {
        PG8_LAS float* Pp = (PG8_LAS float*)lds;
        PG8_LAS float* S = (PG8_LAS float*)(lds + 4096);
#pragma unroll
        for (int ai = 0; ai < 2; ++ai)
#pragma unroll
            for (int m = 0; m < 4; ++m) { float s = 0.f;
#pragma unroll
                for (int bj = 0; bj < 2; ++bj)
#pragma unroll
                    for (int n = 0; n < 2; ++n) { const f32x4 x = v[ai][bj][m][n]; s += (x[0] * x[0] + x[1] * x[1]) + (x[2] * x[2] + x[3] * x[3]); }
                s += __shfl_xor(s, 16); s += __shfl_xor(s, 32);
                if (fq == 0) Pp[(ai * HALF + wr * 64 + m * 16 + fr) * 4 + wc] = s; }
        asm volatile("s_waitcnt lgkmcnt(0)" ::: "memory"); __builtin_amdgcn_s_barrier(); asm volatile("" ::: "memory");
        const int row = wid * 32 + (lane & 31);
        if (lane < 32) { const float t = (Pp[row * 4 + 0] + Pp[row * 4 + 1]) + (Pp[row * 4 + 2] + Pp[row * 4 + 3]);
            __hip_atomic_store(xbuf + ((size_t)(u.pm * BM + row) * 4 + u.pn), t, __ATOMIC_RELAXED, __HIP_MEMORY_SCOPE_AGENT); }
        asm volatile("s_waitcnt vmcnt(0)" ::: "memory");
        if (lane == 0) __hip_atomic_fetch_add(cnt + 64 * u.pm, 1u, __ATOMIC_RELAXED, __HIP_MEMORY_SCOPE_AGENT);
        if (wid == 0) { unsigned sp = 0;
            while ((unsigned)__builtin_amdgcn_readfirstlane(__hip_atomic_load(cnt + 64 * u.pm, __ATOMIC_RELAXED, __HIP_MEMORY_SCOPE_AGENT)) < 32u) { __builtin_amdgcn_s_sleep(2); if (++sp > (1u << 22)) break; }
            __builtin_amdgcn_fence(__ATOMIC_ACQUIRE, "agent"); }
        asm volatile("s_waitcnt vmcnt(0) lgkmcnt(0)" ::: "memory"); __builtin_amdgcn_s_barrier(); asm volatile("" ::: "memory");
        if (lane < 32) { const float* slot = xbuf + (size_t)(u.pm * BM + row) * 4; float q = 0.f;
#pragma unroll
            for (int t = 0; t < 4; ++t) q += __hip_atomic_load(slot + t, __ATOMIC_RELAXED, __HIP_MEMORY_SCOPE_AGENT);
            S[row] = 1.0f / sqrtf(q * (1.0f / 1024.0f) + eps); }
        asm volatile("s_waitcnt lgkmcnt(0)" ::: "memory"); __builtin_amdgcn_s_barrier(); asm volatile("" ::: "memory");
    }
};
struct EpiNormResNorm {
    static constexpr bool PERM = true, AFTER_DRAIN = true, HAS_MID = true;
    const bf16_t* base; bf16_t* hb; float* rsq_h; const float* g1; PanelSq st1;
    const PG8_LAS float* tab; int kmid;
    __device__ __forceinline__ void mid(f32x4 (&acc)[2][2][4][2], const Unit& u, int wr, int wc, int fr, int fq) const {
#pragma unroll
        for (int ai = 0; ai < 2; ++ai)
#pragma unroll
            for (int m = 0; m < 4; ++m) { const float f = tab[ai * HALF + wr * 64 + m * 16 + fr];
#pragma unroll
                for (int bj = 0; bj < 2; ++bj)
#pragma unroll
                    for (int n = 0; n < 2; ++n) acc[ai][bj][m][n] = acc[ai][bj][m][n] * f; }
        asm volatile("s_waitcnt lgkmcnt(0)" ::: "memory");
    }
    __device__ __forceinline__ void fused(f32x4 (&acc)[2][2][4][2], const Unit& u, int wr, int wc, int fr, int fq, PG8_LAS unsigned char* lds, int wid, int lane) const {
        const PG8_LAS float* S = (const PG8_LAS float*)(lds + 4096);
        const int col0 = u.pn * BM + wc * 32 + 8 * fq;
#pragma unroll
        for (int ai = 0; ai < 2; ++ai)
#pragma unroll
            for (int m = 0; m < 4; ++m) { const float rb = tab[256 + ai * HALF + wr * 64 + m * 16 + fr];
#pragma unroll
                for (int bj = 0; bj < 2; ++bj)
#pragma unroll
                    for (int n = 0; n < 2; ++n) acc[ai][bj][m][n] = acc[ai][bj][m][n] * rb; }
        st1.run(acc, u, wr, wc, fr, fq, lds, wid, lane);
        f32x4 gv[2][2];
#pragma unroll
        for (int bj = 0; bj < 2; ++bj)
#pragma unroll
            for (int n = 0; n < 2; ++n) gv[bj][n] = *(const f32x4*)(g1 + col0 + bj * HALF + 4 * n);
#pragma unroll
        for (int ai = 0; ai < 2; ++ai)
#pragma unroll
            for (int m = 0; m < 4; ++m) { const int r = ai * HALF + wr * 64 + m * 16 + fr; const float rs = S[r]; const size_t off = (size_t)(u.pm * BM + r) * 1024 + col0;
#pragma unroll
                for (int bj = 0; bj < 2; ++bj) { const u32x4 xw = *(const u32x4*)(base + off + bj * HALF);
                    acc[ai][bj][m][0] = (f32x4){bf_lo(xw.x), bf_hi(xw.x), bf_lo(xw.y), bf_hi(xw.y)} + acc[ai][bj][m][0] * rs * gv[bj][0];
                    acc[ai][bj][m][1] = (f32x4){bf_lo(xw.z), bf_hi(xw.z), bf_lo(xw.w), bf_hi(xw.w)} + acc[ai][bj][m][1] * rs * gv[bj][1]; }
                float s = 0.f;
#pragma unroll
                for (int bj = 0; bj < 2; ++bj) { const f32x4 h0 = acc[ai][bj][m][0], h1 = acc[ai][bj][m][1];
                    s += ((h0[0] * h0[0] + h0[1] * h0[1]) + (h0[2] * h0[2] + h0[3] * h0[3])) + ((h1[0] * h1[0] + h1[1] * h1[1]) + (h1[2] * h1[2] + h1[3] * h1[3]));
                    u32x4 hw; hw.x = cvt_pk_bf16(h0[0], h0[1]); hw.y = cvt_pk_bf16(h0[2], h0[3]); hw.z = cvt_pk_bf16(h1[0], h1[1]); hw.w = cvt_pk_bf16(h1[2], h1[3]); *(u32x4*)(hb + off + bj * HALF) = hw; }
                s += __shfl_xor(s, 16); s += __shfl_xor(s, 32);
                if (fq == 0) unsafeAtomicAdd(rsq_h + u.pm * BM + r, s);
                if (m & 1) asm volatile("" ::: "memory"); }
    }
};
struct EpiNormRes {
    static constexpr bool PERM = true, AFTER_DRAIN = true, HAS_MID = false;
    const bf16_t* base; float* out; const float* g1; PanelSq st;
    __device__ __forceinline__ void fused(f32x4 (&acc)[2][2][4][2], const Unit& u, int wr, int wc, int fr, int fq, PG8_LAS unsigned char* lds, int wid, int lane) const {
        const PG8_LAS float* S = (const PG8_LAS float*)(lds + 4096);
        const int col0 = u.pn * BM + wc * 32 + 8 * fq;
        st.run(acc, u, wr, wc, fr, fq, lds, wid, lane);
        f32x4 gv[2][2];
#pragma unroll
        for (int bj = 0; bj < 2; ++bj)
#pragma unroll
            for (int n = 0; n < 2; ++n) gv[bj][n] = *(const f32x4*)(g1 + col0 + bj * HALF + 4 * n);
#pragma unroll
        for (int ai = 0; ai < 2; ++ai)
#pragma unroll
            for (int m = 0; m < 4; ++m) { const int r = ai * HALF + wr * 64 + m * 16 + fr; const float rs = S[r]; const size_t off = (size_t)(u.pm * BM + r) * 1024 + col0;
#pragma unroll
                for (int bj = 0; bj < 2; ++bj)
                { const u32x4 hw = *(const u32x4*)(base + off + bj * HALF);
                    const f32x4 b0 = (f32x4){bf_lo(hw.x), bf_hi(hw.x), bf_lo(hw.y), bf_hi(hw.y)}, b1 = (f32x4){bf_lo(hw.z), bf_hi(hw.z), bf_lo(hw.w), bf_hi(hw.w)};
                    __builtin_nontemporal_store(b0 + acc[ai][bj][m][0] * rs * gv[bj][0], (f32x4*)(out + off + bj * HALF)); __builtin_nontemporal_store(b1 + acc[ai][bj][m][1] * rs * gv[bj][1], (f32x4*)(out + off + bj * HALF + 4)); }
                if (m & 1) asm volatile("" ::: "memory"); }
    }
};
struct SsmOrder {
    int c;
    __device__ bool next(int i, Unit& u) const { if (i > 0 || c >= 128) return false; const int U = (c & 7) * 16 + (c >> 3), g = U >> 2; u.pm = 2 * g + ((U >> 1) & 1); u.pn = 2 * g + (U & 1); return true; }
    __device__ __forceinline__ void a_ready(const Unit&) const {}
    __device__ __forceinline__ void done(const Unit&) const {}
};
}
__device__ __forceinline__ void transpose_item(const float* W, int K, int N, bf16* WT, int src_col0, int dst_row0, int k0, LAS float* scr, int lane, const float* ks = nullptr) {
    if (ks) {
#pragma unroll 32
        for (int i = 0; i < 32; ++i) { const int kk = 2 * i + (lane >> 5); scr[kk * 33 + (lane & 31)] = __builtin_nontemporal_load(W + (size_t)(k0 + kk) * N + src_col0 + (lane & 31)) * ks[kk]; }
    } else {
#pragma unroll 32
        for (int i = 0; i < 32; ++i) { const int kk = 2 * i + (lane >> 5); scr[kk * 33 + (lane & 31)] = __builtin_nontemporal_load(W + (size_t)(k0 + kk) * N + src_col0 + (lane & 31)); }
    }
    asm volatile("s_waitcnt lgkmcnt(0)" ::: "memory");
    const int c = lane & 7;
#pragma unroll
    for (int j = 0; j < 4; ++j) { const int n = (lane >> 3) + 8 * j; const LAS float* s = scr + (8 * c) * 33 + n;
        u32x4 o; o.x = cvt_pk_bf16(s[0 * 33], s[1 * 33]); o.y = cvt_pk_bf16(s[2 * 33], s[3 * 33]); o.z = cvt_pk_bf16(s[4 * 33], s[5 * 33]); o.w = cvt_pk_bf16(s[6 * 33], s[7 * 33]);
        *(u32x4*)(WT + (size_t)(dst_row0 + n) * K + k0 + 8 * c) = o; }
    asm volatile("s_waitcnt lgkmcnt(0)" ::: "memory");
}
__device__ __forceinline__ int gated_src_col(int n0, int half_off) { const int pn = n0 >> 8, r = n0 & 255; return r < 128 ? 128 * pn + r : half_off + 128 * pn + (r - 128); }

__device__ __forceinline__ void sincos_rev(double ang, float& s, float& c) {
    const double rev = ang * 0.15915494309189533576888; const float fr = (float)(rev - floor(rev));
    s = __builtin_amdgcn_sinf(fr); c = __builtin_amdgcn_cosf(fr);
}

__device__ __forceinline__ void prologue_b(const Params& P, LAS unsigned char* lds, int tid, int lane, int wave, int blk, int G, int which, int wave0 = 0) {
    unsigned char* ws = P.ws;
    for (int item = blk; (which & 1) && item < NGRP * 8; item += G) {
        const int g = item >> 3, part = item & 7;
        LAS f32x2* APW = (LAS f32x2*)lds;
        LAS f32x2* BB = APW + 33 * 64;
        LAS f32x2* CC = BB + 64 * 16;
        LAS float* KT = (LAS float*)(CC + 16 * 64);
        const float dt = expf(P.log_dt[g]);
        for (int e = tid; e < 33 * 64; e += 512) { const int jx = e >> 6, p = e & 63;
            const float lr = fminf(P.lam_re[g * 64 + p], -1e-4f), li = P.lam_im[g * 64 + p];
            const float mag = expf((float)jx * (lr * dt)); float s, c; sincos_rev((double)jx * (double)(li * dt), s, c);
            f32x2 v; v.x = mag * c; v.y = mag * s; APW[e] = v; }
        for (int e = tid; e < 64 * 16; e += 512) { const int p = e >> 4;
            const float lr = fminf(P.lam_re[g * 64 + p], -1e-4f), li = P.lam_im[g * 64 + p];
            const float mag = expf(lr * dt); float s, c; sincos_rev((double)(li * dt), s, c); const float ar = mag * c, ai = mag * s;
            const float den = lr * lr + li * li, fr = ((ar - 1.0f) * lr + ai * li) / den, fi = (ai * lr - (ar - 1.0f) * li) / den;
            const float br = P.b_re[(size_t)g * 1024 + e], bi = P.b_im[(size_t)g * 1024 + e];
            f32x2 v; v.x = fr * br - fi * bi; v.y = fr * bi + fi * br; BB[e] = v;
            f32x2 w; w.x = P.c_re[(size_t)g * 1024 + e]; w.y = P.c_im[(size_t)g * 1024 + e]; CC[e] = w; }
        __syncthreads();
        if (part == 0 && tid < 64) ((f32x2*)(ws + WS_AT))[g * 64 + tid] = APW[32 * 64 + tid];
        {
            const int hh = tid & 255, h = hh >> 4, hp = hh & 15, jl = 2 * (tid >> 8), j0 = 4 * part + jl;
            float k0 = 0.f, k1 = 0.f;
            for (int p = 0; p < 64; ++p) {
                const f32x2 cv = CC[h * 64 + p], bv = BB[p * 16 + hp], w0 = APW[j0 * 64 + p], w1 = APW[(j0 + 1) * 64 + p];
                const float zr = cv.x * bv.x - cv.y * bv.y, zi = cv.x * bv.y + cv.y * bv.x;
                k0 += zr * w0.x - zi * w0.y; k1 += zr * w1.x - zi * w1.y;
            }
            KT[jl * 256 + hh] = k0; KT[(jl + 1) * 256 + hh] = k1;
        }
        __syncthreads();
        bf16* TWg = (bf16*)(ws + WS_TW) + (size_t)g * 512 * 640;
        for (int e = tid; e < 4096; e += 512) {
            const int jj = e >> 10, t = (e >> 5) & 31, h = (e >> 1) & 15, half = e & 1, jx = 4 * part + jj;
            if (t >= jx) { const LAS float* kp = KT + jj * 256 + h * 16 + 8 * half;
                u32x4 w; w.x = cvt_pk_bf16(kp[0], kp[1]); w.y = cvt_pk_bf16(kp[2], kp[3]); w.z = cvt_pk_bf16(kp[4], kp[5]); w.w = cvt_pk_bf16(kp[6], kp[7]);
                *(u32x4*)(TWg + (size_t)(t * 16 + h) * 640 + 128 + (t - jx) * 16 + 8 * half) = w; }
            const int lg = 4 * (7 - part) + jj, s = t + lg;
            if (lg >= 1 && s < 32) *(u32x4*)(TWg + (size_t)(t * 16 + h) * 640 + 128 + s * 16 + 8 * half) = (u32x4){0u, 0u, 0u, 0u};
        }
        for (int e = tid; e < 64 * 16; e += 512) {
            const int rl = e >> 4, c8 = (e & 15) * 8, t = 4 * part + (rl >> 4), h = rl & 15; float v[8];
#pragma unroll
            for (int i = 0; i < 8; ++i) { const int q = c8 + i, p = q & 63; const f32x2 cv = CC[h * 64 + p], wv = APW[(t + 1) * 64 + p];
                v[i] = (q < 64) ? (cv.x * wv.x - cv.y * wv.y) : -(cv.x * wv.y + cv.y * wv.x); }
            u32x4 w; w.x = cvt_pk_bf16(v[0], v[1]); w.y = cvt_pk_bf16(v[2], v[3]); w.z = cvt_pk_bf16(v[4], v[5]); w.w = cvt_pk_bf16(v[6], v[7]);
            *(u32x4*)(TWg + (size_t)(t * 16 + h) * 640 + c8) = w;
        }
        bf16* W1g = (bf16*)(ws + WS_W1) + (size_t)g * 128 * 512;
        for (int e = tid; e < 16 * 64; e += 512) {
            const int q = 16 * part + (e >> 6), c8 = (e & 63) * 8, s = c8 >> 4, hp0 = c8 & 15, p = q & 63; float v[8];
            const f32x2 wv = APW[(31 - s) * 64 + p];
#pragma unroll
            for (int i = 0; i < 8; ++i) { const f32x2 bv = BB[p * 16 + hp0 + i]; v[i] = (q < 64) ? (wv.x * bv.x - wv.y * bv.y) : (wv.x * bv.y + wv.y * bv.x); }
            u32x4 w; w.x = cvt_pk_bf16(v[0], v[1]); w.y = cvt_pk_bf16(v[2], v[3]); w.z = cvt_pk_bf16(v[4], v[5]); w.w = cvt_pk_bf16(v[6], v[7]);
            *(u32x4*)(W1g + (size_t)q * 512 + c8) = w;
        }
        __syncthreads();
    }
    {
        LAS float* scr = (LAS float*)(lds + wave * 16384);
        const int gw = blk * (8 - wave0) + (wave - wave0), NGW = G * (8 - wave0);
        constexpr int I_IN = 16 * 40, I_GLU = 8 * 32, I_OUT = 16 * 32, I_GU = 16 * 176, I_DN = 44 * 32, NIT = I_IN + I_GLU + I_OUT + I_GU + I_DN;
        const int it_lo = (which & 1) ? I_IN : I_IN + I_GLU + I_OUT, it_hi = (which & 2) ? NIT : I_IN + I_GLU + I_OUT;
        for (int it = it_lo + gw; wave >= wave0 && it < it_hi; it += NGW) {
            int r = it;
            if (r < I_IN) { const int nb = r % 40, kb = r / 40; transpose_item(P.w_in, 1024, 1280, (bf16*)(ws + WS_WIN), 32 * nb, 32 * nb, 64 * kb, scr, lane); continue; } r -= I_IN;
            if (r < I_GLU) { const int nb = r % 32, kb = r / 32; transpose_item(P.w_glu, 512, 1024, (bf16*)(ws + WS_WGLU), gated_src_col(32 * nb, 512), 32 * nb, 64 * kb, scr, lane); continue; } r -= I_GLU;
            if (r < I_OUT) { const int nb = r % 32, kb = r / 32; transpose_item(P.w_out, 1024, 1024, (bf16*)(ws + WS_WOUT), 32 * nb, 32 * nb, 64 * kb, scr, lane, kb < 8 ? P.g_ssm_out + 64 * kb : P.g_attn_out + 64 * (kb - 8)); continue; } r -= I_OUT;
            if (r < I_GU) { const int nb = r % 176, kb = r / 176; transpose_item(P.w_gate_up, 1024, 5632, (bf16*)(ws + WS_WGU), gated_src_col(32 * nb, 2816), 32 * nb, 64 * kb, scr, lane, P.g_pre_ffn + 64 * kb); continue; } r -= I_GU;
            { const int nb = r % 32, kb = r / 32; transpose_item(P.w_down, 2816, 1024, (bf16*)(ws + WS_WDN), 32 * nb, 32 * nb, 64 * kb, scr, lane); }
        }
    }
}

__device__ __forceinline__ void prologue_a(const Params& P, LAS unsigned char* lds, int tid, int lane, int wave) {
    unsigned char* ws = P.ws;
    const int G = gridDim.x, blk = blockIdx.x;
    {
        LAS float* scr = (LAS float*)(lds + wave * 16384);
        const int gw = blk * 8 + wave, NGW = G * 8;
        for (int r = gw; r < 16 * 40; r += NGW) { const int nb = r % 40, kb = r / 40; transpose_item(P.w_in, 1024, 1280, (bf16*)(ws + WS_WIN), 32 * nb, 32 * nb, 64 * kb, scr, lane, P.g_pre_mix + 64 * kb); }
        for (int m = gw; m < NTOK; m += NGW) {
            const f32x4* xr = (const f32x4*)(P.x + (size_t)m * DM) + lane; f32x4 v[4]; float s = 0.f;
#pragma unroll
            for (int j = 0; j < 4; ++j) { v[j] = __builtin_nontemporal_load(xr + 64 * j); s += (v[j].x * v[j].x + v[j].y * v[j].y) + (v[j].z * v[j].z + v[j].w * v[j].w); }
            const float rstd = 1.0f / sqrtf(wave_sum(s) * (1.0f / DM) + NORM_EPS);
            if (lane == 0) ((float*)(ws + WS_RS0))[m] = rstd;
            u32x2* o8 = (u32x2*)((bf16*)(ws + WS_XN) + (size_t)m * DM) + lane;
#pragma unroll
            for (int j = 0; j < 4; ++j) { u32x2 w; w.x = cvt_pk_bf16(v[j].x, v[j].y); w.y = cvt_pk_bf16(v[j].z, v[j].w); o8[64 * j] = w; }
        }
        for (int e = blk * 512 + tid; e < NTOK; e += G * 512) { ((float*)(ws + WS_RSQ))[e] = 0.f; ((float*)(ws + WS_RSQH))[e] = 0.f; }
    }
}

__device__ __forceinline__ void ssm_pass_a(const Params& P, int lane, int wave) {
    if (wave >= 2) return;
    unsigned char* ws = P.ws;
    for (int unit = wave * 256 + blockIdx.x; unit < 512; unit += 2 * gridDim.x > 512 ? 512 : 2 * gridDim.x) {
        const int g = unit >> 4, b = (unit >> 1) & 7, hs = unit & 1;
        const int r32 = lane & 31, hi = lane >> 5;
        const int sig = 16 * ((r32 >> 2) & 1) + 4 * (r32 >> 3) + (r32 & 3);
        bf16* UXg = (bf16*)(ws + WS_UX) + ((size_t)(g * 512 + b * 64)) * 640;
        const bf16* a0p = UXg + (size_t)sig * 640 + 128 + 8 * hi;
        const bf16* a1p = a0p + (size_t)32 * 640;
        const bf16* W1g = (const bf16*)(ws + WS_W1) + (size_t)g * 128 * 512;
        const bf16* b0p = W1g + (size_t)(32 * hs + r32) * 512 + 8 * hi;
        const bf16* b1p = b0p + (size_t)64 * 512;
        f32x16 acc[2][2];
#pragma unroll
        for (int i = 0; i < 2; ++i)
#pragma unroll
            for (int j = 0; j < 2; ++j)
#pragma unroll
                for (int r = 0; r < 16; ++r) acc[i][j][r] = 0.f;
#pragma unroll 8
        for (int ks = 0; ks < 32; ++ks) {
            const bf16x8 A0 = *(const bf16x8*)(a0p + 16 * ks), A1 = *(const bf16x8*)(a1p + 16 * ks), B0 = *(const bf16x8*)(b0p + 16 * ks), B1 = *(const bf16x8*)(b1p + 16 * ks);
            acc[0][0] = __builtin_amdgcn_mfma_f32_32x32x16_bf16(A0, B0, acc[0][0], 0, 0, 0);
            acc[0][1] = __builtin_amdgcn_mfma_f32_32x32x16_bf16(A0, B1, acc[0][1], 0, 0, 0);
            acc[1][0] = __builtin_amdgcn_mfma_f32_32x32x16_bf16(A1, B0, acc[1][0], 0, 0, 0);
            acc[1][1] = __builtin_amdgcn_mfma_f32_32x32x16_bf16(A1, B1, acc[1][1], 0, 0, 0);
        }
        const int p = 32 * hs + r32;
        const float2 aT = ((const float2*)(ws + WS_AT))[g * 64 + p];
        float er[2], ei[2];
#pragma unroll
        for (int rt = 0; rt < 2; ++rt) { float lr = 0.f, li = 0.f;
#pragma unroll
            for (int r = 0; r < 16; ++r) { const float nr = aT.x * lr - aT.y * li + acc[rt][0][r], ni = aT.x * li + aT.y * lr + acc[rt][1][r]; lr = nr; li = ni; }
            er[rt] = lr; ei[rt] = li; }
        float pr = aT.x, pi = aT.y;
#pragma unroll
        for (int k = 0; k < 4; ++k) { const float nr = pr * pr - pi * pi, ni = 2.f * pr * pi; pr = nr; pi = ni; }
        const float x0r = __shfl_xor(er[0], 32), x0i = __shfl_xor(ei[0], 32);
        const float s0r = hi ? x0r : 0.f, s0i = hi ? x0i : 0.f;
        const float ebr = pr * s0r - pi * s0i + er[0], ebi = pr * s0i + pi * s0r + ei[0];
        const float y0r = __shfl_xor(ebr, 32), y0i = __shfl_xor(ebi, 32);
        const float ecr = pr * y0r - pi * y0i + er[1], eci = pr * y0i + pi * y0r + ei[1];
        const float z0r = __shfl_xor(ecr, 32), z0i = __shfl_xor(eci, 32);
        const float s1r = hi ? z0r : y0r, s1i = hi ? z0i : y0i;
#pragma unroll
        for (int rt = 0; rt < 2; ++rt) { float cr = rt ? s1r : s0r, ci = rt ? s1i : s0i;
            bf16* xo = UXg + (size_t)(32 * rt + 16 * hi) * 640 + p;
#pragma unroll
            for (int r = 0; r < 16; ++r) {
                xo[(size_t)r * 640] = (bf16)(cvt_pk_bf16(cr, 0.f) & 0xffffu); xo[(size_t)r * 640 + 64] = (bf16)(cvt_pk_bf16(ci, 0.f) & 0xffffu);
                const float nr = aT.x * cr - aT.y * ci + acc[rt][0][r], ni = aT.x * ci + aT.y * cr + acc[rt][1][r]; cr = nr; ci = ni; }
        }
    }
}

__device__ __forceinline__ void attn_phase(const Params& P, LAS unsigned char* lds, int tid, int lane, int wave, int unit0, int nunits) {
    unsigned char* ws = P.ws;
    const bf16* Q = (const bf16*)(ws + WS_Q); const bf16* Kb = (const bf16*)(ws + WS_K); const bf16* VT = (const bf16*)(ws + WS_VT); bf16* MG = (bf16*)(ws + WS_MG);
    const int r32 = lane & 31, hi = lane >> 5;
    const int h = wave, hk = h >> 2;
    const float sink2 = P.sinks[h] * LOG2E;
    constexpr int KST = 272, VST = 392, VOFF = 192 * KST;
#pragma unroll 1
    for (int unit = unit0; unit < unit0 + nunits; ++unit) {
        const int b = unit >> 5, l0 = (unit & 31) * 64, tokb = b * SEQL;
        LAS float* rsq = (LAS float*)(lds + 139264);
        if (tid < 64) rsq[tid] = 0.f;
        {
            u32x4 kv[6], vv[6];
#pragma unroll
            for (int i = 0; i < 6; ++i) { const int p = tid + 512 * i, row = p >> 4, c16 = p & 15; int t = l0 - 128 + row; t = t < 0 ? t + 128 : t;
                kv[i] = *(const u32x4*)(Kb + (size_t)(tokb + t) * 128 + c16 * 8); }
#pragma unroll
            for (int i = 0; i < 6; ++i) { const int p = tid + 512 * i, row = p / 24, c = p % 24; int k0 = l0 - 128 + 8 * c; k0 = k0 < 0 ? k0 + 128 : k0;
                vv[i] = *(const u32x4*)(VT + ((size_t)(b * 128 + row)) * SEQL + k0); }
#pragma unroll
            for (int i = 0; i < 6; ++i) { const int p = tid + 512 * i, row = p >> 4, c16 = p & 15; *(LAS u32x4*)(lds + row * KST + c16 * 16) = kv[i]; }
#pragma unroll
            for (int i = 0; i < 6; ++i) { const int p = tid + 512 * i, row = p / 24, c = p % 24; LAS u32x2* d = (LAS u32x2*)(lds + VOFF + row * VST + c * 16);
                u32x2 a, bq; a.x = vv[i].x; a.y = vv[i].y; bq.x = vv[i].z; bq.y = vv[i].w; d[0] = a; d[1] = bq; }
        }
        __syncthreads();
#pragma unroll 1
        for (int sub = 0; sub < 2; ++sub) {
            const int q0 = l0 + 32 * sub;
            bf16x8 qf[4];
#pragma unroll
            for (int ds = 0; ds < 4; ++ds) qf[ds] = *(const bf16x8*)(Q + (size_t)(tokb + q0 + r32) * 512 + h * 64 + 16 * ds + 8 * hi);
            f32x16 s[5];
#pragma unroll
            for (int kt = 0; kt < 5; ++kt) {
#pragma unroll
                for (int r = 0; r < 16; ++r) s[kt][r] = 0.f;
                const LAS unsigned char* kp = lds + (32 * (kt + sub) + r32) * KST + hk * 128 + hi * 16;
#pragma unroll
                for (int ds = 0; ds < 4; ++ds) { const bf16x8 kf = *(const LAS bf16x8*)(kp + ds * 32); s[kt] = __builtin_amdgcn_mfma_f32_32x32x16_bf16(kf, qf[ds], s[kt], 0, 0, 0); }
                if (kt < 4) { const bool dead = (q0 - 128 + 32 * kt) < 0;
#pragma unroll
                    for (int r = 0; r < 16; ++r) s[kt][r] = dead ? -1e30f : s[kt][r]; }
            }
#pragma unroll
            for (int r = 0; r < 16; ++r) { const int cr = crow(r, hi); if (cr <= r32) s[0][r] = -1e30f; if (cr > r32) s[4][r] = -1e30f; }
            float m = sink2;
#pragma unroll
            for (int kt = 0; kt < 5; ++kt)
#pragma unroll
                for (int r = 0; r < 16; ++r) m = fmaxf(m, s[kt][r]);
            m = fmaxf(m, __shfl_xor(m, 32));
            float sum = 0.f;
#pragma unroll
            for (int kt = 0; kt < 5; ++kt)
#pragma unroll
                for (int r = 0; r < 16; ++r) { const float pv = __builtin_amdgcn_exp2f(s[kt][r] - m); s[kt][r] = pv; sum += pv; }
            sum += __shfl_xor(sum, 32);
            const float inv = 1.0f / (sum + __builtin_amdgcn_exp2f(sink2 - m));
            __builtin_amdgcn_sched_barrier(0);
            f32x16 o[2];
#pragma unroll
            for (int r = 0; r < 16; ++r) { o[0][r] = 0.f; o[1][r] = 0.f; }
#pragma unroll
            for (int kt = 0; kt < 5; ++kt) {
#pragma unroll
                for (int ks = 0; ks < 2; ++ks) {
                    u32x4 pw; pw.x = cvt_pk_bf16(s[kt][8 * ks + 0], s[kt][8 * ks + 1]); pw.y = cvt_pk_bf16(s[kt][8 * ks + 2], s[kt][8 * ks + 3]);
                    pw.z = cvt_pk_bf16(s[kt][8 * ks + 4], s[kt][8 * ks + 5]); pw.w = cvt_pk_bf16(s[kt][8 * ks + 6], s[kt][8 * ks + 7]);
                    const bf16x8 pa = __builtin_bit_cast(bf16x8, pw);
#pragma unroll
                    for (int dt = 0; dt < 2; ++dt) {
                        const LAS unsigned char* vp = lds + VOFF + (hk * 64 + 32 * dt + r32) * VST + (32 * (kt + sub) + 16 * ks + 4 * hi) * 2;
                        const u32x2 lo = *(const LAS u32x2*)vp, hi2 = *(const LAS u32x2*)(vp + 16);
                        u32x4 vw; vw.x = lo.x; vw.y = lo.y; vw.z = hi2.x; vw.w = hi2.y;
                        o[dt] = __builtin_amdgcn_mfma_f32_32x32x16_bf16(pa, __builtin_bit_cast(bf16x8, vw), o[dt], 0, 0, 0);
                    }
                }
            }
            {
                LAS unsigned short* stg = (LAS unsigned short*)(lds + 102400 + wave * 4608);
#pragma unroll
                for (int r = 0; r < 16; ++r) { const int cr = crow(r, hi); const float iv = __shfl(inv, cr);
                    stg[cr * 72 + r32] = (unsigned short)(cvt_pk_bf16(o[0][r] * iv, 0.f) & 0xffffu); stg[cr * 72 + 32 + r32] = (unsigned short)(cvt_pk_bf16(o[1][r] * iv, 0.f) & 0xffffu); }
                asm volatile("s_waitcnt lgkmcnt(0)" ::: "memory");
                const int row = lane >> 1, hf = lane & 1; float sq = 0.f;
                bf16* dst = MG + (size_t)(tokb + q0 + row) * 1024 + 512 + h * 64 + hf * 32;
#pragma unroll
                for (int i = 0; i < 4; ++i) { const u32x4 w = *(const LAS u32x4*)(stg + row * 72 + hf * 32 + 8 * i);
                    const float a0 = bf_lo(w.x), a1 = bf_hi(w.x), a2 = bf_lo(w.y), a3 = bf_hi(w.y), a4 = bf_lo(w.z), a5 = bf_hi(w.z), a6 = bf_lo(w.w), a7 = bf_hi(w.w);
                    sq += ((a0 * a0 + a1 * a1) + (a2 * a2 + a3 * a3)) + ((a4 * a4 + a5 * a5) + (a6 * a6 + a7 * a7));
                    *(u32x4*)(dst + 8 * i) = w; }
                sq += __shfl_xor(sq, 1);
                if (hf == 0) __builtin_amdgcn_ds_faddf(rsq + 32 * sub + row, sq, 0, 0, false);
                asm volatile("s_waitcnt lgkmcnt(0)" ::: "memory");
            }
        }
        __syncthreads();
        if (tid < 64) ((float*)(ws + WS_RSQ))[NTOK + tokb + l0 + tid] = rsq[tid];
        __syncthreads();
    }
}

#define XB_TMO      128
#define XB_XCNT(j)  (256  + 64 * (j))
#define XB_XSUB(j)  (1280 + 64 * (j))
#define XB_XGEN(j)  (2304 + 64 * (j))
#define XB_TOP      3328
#define XB_TOPGEN   3392
#define XCD_BAR_WORDS 3456
#define XB_SPIN_CAP (1u << 18)

__device__ __forceinline__ unsigned xb_ld(unsigned* p)              { return __hip_atomic_load(p, __ATOMIC_RELAXED, __HIP_MEMORY_SCOPE_AGENT); }
__device__ __forceinline__ unsigned xb_add(unsigned* p, unsigned v) { return __hip_atomic_fetch_add(p, v, __ATOMIC_RELAXED, __HIP_MEMORY_SCOPE_AGENT); }
__device__ __forceinline__ unsigned xb_xcc_id() { return (unsigned)__builtin_amdgcn_s_getreg((3 << 11) | 20) & 0xFu; }
#define XB_SPIN(cond, bar) do { unsigned _sp = 0; while (cond) { __builtin_amdgcn_s_sleep(1); \
    if ((++_sp & 255u) == 0u) { if (xb_ld(&(bar)[XB_TMO])) break; if (_sp > XB_SPIN_CAP) { atomicAdd(&(bar)[XB_TMO], 1u); break; } } } } while (0)

struct XcdBarrier {
    unsigned* bar; unsigned x;
    volatile LAS unsigned* st;
};

__device__ __forceinline__ XcdBarrier xcd_barrier_post(unsigned* bar, volatile LAS unsigned* st) {
    XcdBarrier b; b.bar = bar; b.x = xb_xcc_id(); b.st = st;
    if (threadIdx.x == 0) (void)xb_add(&bar[XB_XCNT(b.x)], 1u);
    return b;
}
__device__ __forceinline__ void xcd_barrier_complete(unsigned* bar, unsigned x, unsigned& nloc, unsigned& nx) {
    const unsigned G = gridDim.x * gridDim.y * gridDim.z;
    unsigned sum, cnt, mine, sp = 0u;
    for (;;) {
        sum = 0u; cnt = 0u; mine = 0u;
#pragma unroll
        for (unsigned j = 0; j < 16; ++j) { const unsigned c = xb_ld(&bar[XB_XCNT(j)]); sum += c; cnt += (c > 0u) ? 1u : 0u; mine = (j == x) ? c : mine; }
        if (sum == G) break;
        __builtin_amdgcn_s_sleep(1);
        if ((++sp & 255u) == 0u) { if (xb_ld(&bar[XB_TMO])) break; if (sp > XB_SPIN_CAP) { atomicAdd(&bar[XB_TMO], 1u); break; } }
    }
    nloc = mine > 0u ? mine : 1u; nx = cnt > 0u ? cnt : 1u;
}

__device__ __forceinline__ void xcd_barrier(const XcdBarrier& b) {
    asm volatile("s_waitcnt vmcnt(0)" ::: "memory");
    __syncthreads();
    if (threadIdx.x == 0) {
        unsigned* bar = b.bar;
        __builtin_amdgcn_s_waitcnt(0);
        unsigned nloc = b.st[0], nx = b.st[1];
        if (nloc == 0u) { xcd_barrier_complete(bar, b.x, nloc, nx); b.st[0] = nloc; b.st[1] = nx; }
        const unsigned old = xb_add(&bar[XB_XSUB(b.x)], 1u);
        const unsigned gen = old / nloc;
        if (old + 1u == (gen + 1u) * nloc) {
            __builtin_amdgcn_fence(__ATOMIC_RELEASE, "agent");
            asm volatile("s_waitcnt vmcnt(0)" ::: "memory");
            const unsigned og = xb_add(&bar[XB_TOP], 1u);
            const unsigned tg = og / nx;
            if (og + 1u == (tg + 1u) * nx) xb_add(&bar[XB_TOPGEN], 1u);
            else XB_SPIN(xb_ld(&bar[XB_TOPGEN]) == tg, bar);
            __builtin_amdgcn_fence(__ATOMIC_ACQUIRE, "agent");
            xb_add(&bar[XB_XGEN(b.x)], 1u);
            asm volatile("s_waitcnt vmcnt(0)" ::: "memory");
        } else {
            XB_SPIN(xb_ld(&bar[XB_XGEN(b.x)]) == gen, bar);
            __builtin_amdgcn_fence(__ATOMIC_ACQUIRE, "agent");
            asm volatile("s_waitcnt vmcnt(0)" ::: "memory");
        }
    }
    __syncthreads();
}

__device__ __forceinline__ void quad_sync(unsigned* cnt, unsigned target, bool fast) {
    asm volatile("s_waitcnt vmcnt(0)" ::: "memory");
    __syncthreads();
    if (threadIdx.x == 0) {
        if (!fast) { __builtin_amdgcn_fence(__ATOMIC_RELEASE, "agent"); asm volatile("s_waitcnt vmcnt(0)" ::: "memory"); }
        (void)xb_add(cnt, 1u);
        unsigned sp = 0u; while (xb_ld(cnt) < target) { __builtin_amdgcn_s_sleep(1); if (++sp > (1u << 22)) break; }
        __builtin_amdgcn_fence(__ATOMIC_ACQUIRE, "agent");
        asm volatile("s_waitcnt vmcnt(0)" ::: "memory");
    }
    __syncthreads();
}

__global__ void __launch_bounds__(512, 2) fwd_megakernel(Params P) {
    extern __shared__ __attribute__((aligned(16))) unsigned char lds_raw[];
    LAS unsigned char* lds = (LAS unsigned char*)lds_raw;
    const int tid = threadIdx.x, lane = tid & 63, wave = __builtin_amdgcn_readfirstlane(tid >> 6);
    const int G = gridDim.x, blk = blockIdx.x;
    unsigned char* ws = P.ws;
    typedef pg8::bf16_t bt;

    if (tid < 4) ((LAS unsigned*)(lds + LDSCTL_OFF))[tid] = 0u;
    __syncthreads();
    const XcdBarrier bar = xcd_barrier_post((unsigned*)(ws + WS_BAR), (volatile LAS unsigned*)(lds + LDSCTL_OFF));
    if (tid == 0) __hip_atomic_store((unsigned*)(ws + WS_XT) + blk, bar.x, __ATOMIC_RELAXED, __HIP_MEMORY_SCOPE_AGENT);
    prologue_a(P, lds, tid, lane, wave);
    xcd_barrier(bar);
    {
        pg8::Gemm g{(const bt*)(ws + WS_XN), (const bt*)(ws + WS_WIN), NTOK, INW, DM, DM, DM}; pg8::StaticOrder S; S.init(NTOK, INW, G, blk);
        LAS float* ptab = (LAS float*)(lds + LDSCTL_OFF + 64);
        { pg8::Unit u0; if (S.next(0, u0) && tid < 256) { ptab[tid] = ((const float*)(ws + WS_RS0))[u0.pm * 256 + tid]; ptab[256 + tid] = (float)P.pos[u0.pm * 256 + tid]; } }
        __syncthreads();
        pg8::EpiInProj E{(bt*)(ws + WS_UX), (bt*)(ws + WS_Q), (bt*)(ws + WS_K), (bt*)(ws + WS_VT), ptab};
        pg8::gemm_phase<pg8::EpiInProj, pg8::StaticOrder, true, true>(lds, g, S, E);
    }
    if (G == 256) { if (blk >= 64) prologue_b(P, lds, tid, lane, wave, blk - 64, 192, 1); } else prologue_b(P, lds, tid, lane, wave, blk, G, 3);
    xcd_barrier(bar);
    ssm_pass_a(P, lane, wave);
    prologue_b(P, lds, tid, lane, wave, blk, G, 2, 2);
    xcd_barrier(bar);
    {
        pg8::Gemm g{(const bt*)(ws + WS_UX), (const bt*)(ws + WS_TW), NGRP * GROWS, NGRP * 512, KX, KX, KX}; pg8::SsmOrder S{blk};
        pg8::EpiSsmC E{(const bt*)(ws + WS_UX), P.ssm_d, (bt*)(ws + WS_Y)};
        pg8::gemm_phase<pg8::EpiSsmC, pg8::SsmOrder, true, true>(lds, g, S, E);
        if (G == 256) { if (blk >= 128) attn_phase(P, lds, tid, lane, wave, (blk - 128) * 2, 2); }
        else for (int u = blk; u < 256; u += G) attn_phase(P, lds, tid, lane, wave, u, 1);
    }
    xcd_barrier(bar);
    const bool quads = (G == 256);
    bool qfast = false; unsigned* qcnt = (unsigned*)(ws + WS_CNT) + 4096;
    if (quads) { const int x = blk & 7, p = (blk >> 3) & 7; unsigned* xt = (unsigned*)(ws + WS_XT);
        const unsigned x0 = xb_ld(xt + x + 8 * p), x1 = xb_ld(xt + x + 8 * (p + 8)), x2 = xb_ld(xt + x + 8 * (p + 16)), x3 = xb_ld(xt + x + 8 * (p + 24));
        qfast = (x0 == x1) && (x1 == x2) && (x2 == x3); qcnt += 64 * (8 * x + p); }
    {
        pg8::Gemm g{(const bt*)(ws + WS_Y), (const bt*)(ws + WS_WGLU), NTOK, 1024, 512, 512, 512}; pg8::StaticOrder S; S.init(NTOK, 1024, G, blk);
        pg8::EpiGated<0> E{(bt*)(ws + WS_MG), 1024, P.b_glu, (float*)(ws + WS_RSQ), nullptr};
        pg8::gemm_phase<pg8::EpiGated<0>, pg8::StaticOrder, true, true>(lds, g, S, E);
    }
    if (quads) quad_sync(qcnt, 4u, qfast); else xcd_barrier(bar);
    {
        pg8::Gemm g{(const bt*)(ws + WS_MG), (const bt*)(ws + WS_WOUT), NTOK, DM, DM, DM, DM}; pg8::StaticOrder S; S.init(NTOK, DM, G, blk);
        pg8::PanelSq st1{(float*)(ws + WS_XB), (unsigned*)(ws + WS_CNT), NORM_EPS};
        LAS float* tab = (LAS float*)(lds + LDSCTL_OFF + 64);
        { pg8::Unit u0; if (S.next(0, u0) && tid < 256) { const int row = u0.pm * 256 + tid; const float sa = ((const float*)(ws + WS_RSQ))[row] * (1.0f / 512.0f) + NORM_EPS, sb = ((const float*)(ws + WS_RSQ))[NTOK + row] * (1.0f / 512.0f) + NORM_EPS;
            tab[tid] = sqrtf(sb / sa); tab[256 + tid] = 1.0f / sqrtf(sb); } }
        __syncthreads();
        pg8::EpiNormResNorm E{(const bt*)(ws + WS_XN), (bt*)(ws + WS_HB), (float*)(ws + WS_RSQH), P.g_post_mix, st1, tab, 8};
        pg8::gemm_phase<pg8::EpiNormResNorm, pg8::StaticOrder, false, true>(lds, g, S, E);
    }
    if (quads) quad_sync(qcnt, 8u, qfast); else xcd_barrier(bar);
    {
        pg8::Gemm g{(const bt*)(ws + WS_HB), (const bt*)(ws + WS_WGU), NTOK, 2 * DFF, DM, DM, DM}; pg8::StaticOrder S; S.init(NTOK, 2 * DFF, G, blk);
        LAS float* rtab = (LAS float*)(lds + LDSCTL_OFF + 64);
        { pg8::Unit u0; if (S.next(0, u0) && tid < 256) rtab[tid] = 1.0f / sqrtf(((const float*)(ws + WS_RSQH))[u0.pm * 256 + tid] * (1.0f / 1024.0f) + NORM_EPS); }
        __syncthreads();
        pg8::EpiGated<1> E{(bt*)(ws + WS_ACT), DFF, nullptr, nullptr, rtab};
        pg8::gemm_phase<pg8::EpiGated<1>, pg8::StaticOrder, true, true>(lds, g, S, E);
    }
    if (quads) quad_sync(qcnt, 12u, qfast); else xcd_barrier(bar);
    {
        pg8::Gemm g{(const bt*)(ws + WS_ACT), (const bt*)(ws + WS_WDN), NTOK, DM, DFF, DFF, DFF}; pg8::StaticOrder S; S.init(NTOK, DM, G, blk);
        pg8::PanelSq st{(float*)(ws + WS_XB) + 2 * NTOK * 4, (unsigned*)(ws + WS_CNT) + 2 * 4096, NORM_EPS};
        pg8::EpiNormRes E{(const bt*)(ws + WS_HB), P.out, P.g_post_ffn, st};
        pg8::gemm_phase<pg8::EpiNormRes, pg8::StaticOrder, false, true>(lds, g, S, E);
    }
}

extern "C" void kernel_launch(void* const* d_in, const int* in_sizes, int n_in, void* d_out, int out_size, void* d_ws, size_t ws_size, hipStream_t stream) {
    static int grid_blocks = 0;
    if (grid_blocks == 0) {
        int dev = 0, cus = 0, per_cu = 0;
        hipGetDevice(&dev);
        hipDeviceGetAttribute(&cus, hipDeviceAttributeMultiprocessorCount, dev);
        hipFuncSetAttribute((const void*)fwd_megakernel, hipFuncAttributeMaxDynamicSharedMemorySize, LDS_BYTES);
        hipOccupancyMaxActiveBlocksPerMultiprocessor(&per_cu, (const void*)fwd_megakernel, 512, LDS_BYTES);
        if (per_cu < 1) { fprintf(stderr, "kernel_launch: occupancy query reports %d blocks per CU\n", per_cu); per_cu = 1; }
        grid_blocks = cus * 1;
        (void)hipGetLastError();
    }
    Params p{};
    p.x = (const float*)d_in[0]; p.pos = (const int*)d_in[1]; p.g_pre_mix = (const float*)d_in[2]; p.w_in = (const float*)d_in[3]; p.lam_re = (const float*)d_in[4]; p.lam_im = (const float*)d_in[5];
    p.log_dt = (const float*)d_in[6]; p.b_re = (const float*)d_in[7]; p.b_im = (const float*)d_in[8]; p.c_re = (const float*)d_in[9]; p.c_im = (const float*)d_in[10]; p.ssm_d = (const float*)d_in[11];
    p.w_glu = (const float*)d_in[12]; p.b_glu = (const float*)d_in[13]; p.sinks = (const float*)d_in[14]; p.g_ssm_out = (const float*)d_in[15]; p.g_attn_out = (const float*)d_in[16]; p.w_out = (const float*)d_in[17];
    p.g_post_mix = (const float*)d_in[18]; p.g_pre_ffn = (const float*)d_in[19]; p.w_gate_up = (const float*)d_in[20]; p.w_down = (const float*)d_in[21]; p.g_post_ffn = (const float*)d_in[22];
    p.out = (float*)d_out; p.ws = (unsigned char*)d_ws;
    (void)hipMemsetAsync(d_ws, 0, 65536, stream);
    void* args[] = {&p};
    hipError_t e = hipLaunchCooperativeKernel((const void*)fwd_megakernel, dim3(grid_blocks), dim3(512), args, LDS_BYTES, stream);
    if (e != hipSuccess) fprintf(stderr, "cooperative launch failed: %s (grid %d)\n", hipGetErrorString(e), grid_blocks);
}
```
